# Optimizing an MI355X kernel written in HIP

```python
import jax, jax.numpy as jnp
from jax import lax
import numpy as np

D_MODEL = 1024
BATCH = 32
SEQ = 256
DEPTH = 1
DEC_BATCH = 8
DEC_SEQ = 4096
PAST_LEN = 512

GRID_W = 64
CHUNK = 128
ROWS_PER_CHUNK = CHUNK // GRID_W
D_MIX = D_MODEL
D_A = D_MIX // 2
D_B = D_MIX - D_A
HEAD_A = 64
H_A = D_A // HEAD_A
H_B = 8
HEAD_B = D_B // H_B
LORA_W = 64
LORA_A = 64
D_IN = 3 * D_A + D_A + 2 * LORA_W + 2 * LORA_A + 3 * D_B
NORM_EPS = 1e-6
GN_EPS = 6.4e-4
DECAY_OFFSET = 0.5
L2_EPS = 1e-12

kernel_name = 'bidir_rwkv7_chunk_gmlp_hybrid_step'


def _rmsnorm(x, g):
    x32 = x.astype(jnp.float32)
    y = x32 * lax.rsqrt(jnp.mean(x32 * x32, axis=-1, keepdims=True) + NORM_EPS)
    return (y * g.astype(jnp.float32)).astype(x.dtype)


def _layernorm(x, g, b):
    x32 = x.astype(jnp.float32)
    mu = jnp.mean(x32, axis=-1, keepdims=True)
    var = jnp.mean(jnp.square(x32 - mu), axis=-1, keepdims=True)
    y = (x32 - mu) * lax.rsqrt(var + NORM_EPS)
    return (y * g.astype(jnp.float32) + b.astype(jnp.float32)).astype(x.dtype)


def _modulation(cvec, w_mod, b_mod):
    m = jax.nn.silu(cvec) @ w_mod + b_mod
    return jnp.split(m, 3, axis=-1)


def _split_proj(p):
    sizes = (3 * D_A, D_A, LORA_W, LORA_W, LORA_A, LORA_A, D_B, D_B, D_B)
    idx, acc = [], 0
    for s in sizes[:-1]:
        acc += s
        idx.append(acc)
    return jnp.split(p, idx, axis=-1)


def _token_shift(x, mu):
    x_prev = jnp.pad(x[:, :-1], ((0, 0), (1, 0), (0, 0)))
    x_next = jnp.pad(x[:, 1:], ((0, 0), (0, 1), (0, 0)))
    return x + mu[0] * (x_prev - x) + mu[1] * (x_next - x)


def _delta_scan(r, k, v, decay, kk, kka, s0, reverse):
    def step(s, inp):
        r_t, k_t, v_t, w_t, kk_t, b_t = inp
        sa = jnp.einsum('bhvk,bhk->bhv', s, -kk_t)
        s = (s * w_t[:, :, None, :] + sa[..., None] * b_t[:, :, None, :]
             + v_t[..., None] * k_t[:, :, None, :])
        return s, jnp.einsum('bhvk,bhk->bhv', s, r_t)
    xs = tuple(jnp.swapaxes(t, 0, 1) for t in (r, k, v, decay, kk, kka))
    s_final, ys = lax.scan(step, s0, xs, reverse=reverse)
    return jnp.swapaxes(ys, 0, 1), s_final


def _rwkv7_branch(rkv, wd, ad, s0, p):
    B, L, _ = rkv.shape
    f32 = jnp.float32
    heads = lambda t: t.reshape(B, L, H_A, HEAD_A).astype(f32)
    hv = lambda t: t.reshape(H_A, HEAD_A).astype(f32)
    r, k, v = (heads(t) for t in jnp.split(rkv, 3, axis=-1))
    y = jnp.zeros_like(r)
    bonus = jnp.zeros_like(r)
    finals = []
    for d in range(2):
        w_log = -jax.nn.softplus(-(p['w0'][d] + jnp.tanh(wd[d]) @ p['w_up'][d])) - DECAY_OFFSET
        decay = jnp.exp(-jnp.exp(heads(w_log)))
        a = heads(jax.nn.sigmoid(p['a0'][d] + ad[d] @ p['a_up'][d]))
        kk = k * hv(p['k_k'][d])
        kk = kk * lax.rsqrt(jnp.sum(kk * kk, axis=-1, keepdims=True) + L2_EPS)
        k_d = k * (1.0 + (a - 1.0) * hv(p['k_a'][d]))
        y_d, s_d = _delta_scan(r, k_d, v, decay, kk, kk * a, s0[d], reverse=(d == 1))
        y = y + y_d
        bonus = bonus + jnp.sum(r * k_d * p['r_k'][d].astype(f32), axis=-1, keepdims=True) * v
        finals.append(s_d)
    mu = jnp.mean(y, axis=-1, keepdims=True)
    var = jnp.mean(jnp.square(y - mu), axis=-1, keepdims=True)
    y = (y - mu) * lax.rsqrt(var + GN_EPS) * hv(p['gn_w']) + hv(p['gn_b']) + bonus
    return y.reshape(B, L, D_A).astype(rkv.dtype), finals[0], finals[1]


def _chunk_gmlp(u, vb, p):
    B, L, _ = u.shape
    rows = L // GRID_W
    n_chunks = rows // ROWS_PER_CHUNK
    vn = _layernorm(vb, p['sgu_ln_g'], p['sgu_ln_b']).reshape(B, n_chunks, CHUNK, H_B, HEAD_B)
    s = jnp.einsum('gpq,bnqgc->bnpgc', p['w_s'], vn) + p['b_s'].T[None, None, :, :, None]
    return u * s.reshape(B, L, D_B)


def _mixer_layer(x, mod, s0, p):
    shift, scale, gate = mod
    h = _rmsnorm(x, p['ln_pre']) * (1.0 + scale) + shift
    proj = h @ p['w_in']
    rkv, z_a, wd_f, wd_b, ad_f, ad_b, u, vb, z_b = _split_proj(proj)
    rkv = _token_shift(rkv, p['ts_mu'])
    y_a, s_f, s_b = _rwkv7_branch(rkv, (wd_f, wd_b), (ad_f, ad_b), s0, p)
    y_b = _chunk_gmlp(u, vb, p)
    mixed = jnp.concatenate([y_a * jax.nn.silu(z_a), y_b * jax.nn.silu(z_b)], axis=-1)
    out = mixed @ p['w_out']
    return x + _rmsnorm(out, p['ln_post']) * gate, s_f, s_b


def setup_inputs(seed: int = 0) -> dict:
    key = jax.random.key(seed)
    ks = jax.random.split(key, 32)
    f32 = jnp.float32
    nrm = lambda k, shape, s: s * jax.random.normal(k, shape, f32)
    st_shape = (DEC_BATCH, DEPTH, H_A, HEAD_A, HEAD_A)
    return {
        'x_prompt': nrm(ks[0], (BATCH, SEQ, D_MODEL), 1.0),
        'x_sample': nrm(ks[1], (DEC_BATCH, DEC_SEQ, D_MODEL), 1.0),
        'c': nrm(ks[2], (DEC_BATCH, D_MODEL), 1.0),
        'state_fwd': nrm(ks[3], st_shape, 1.0),
        'state_bwd': nrm(ks[4], st_shape, 1.0),
        'c_ctx': nrm(ks[5], (D_MODEL,), 1.0),
        'ln_pre': 1.0 + nrm(ks[6], (DEPTH, D_MODEL), 0.05),
        'ln_post': 1.0 + nrm(ks[7], (DEPTH, D_MODEL), 0.05),
        'w_mod': nrm(ks[8], (DEPTH, D_MODEL, 3 * D_MODEL), 0.5 * D_MODEL ** -0.5),
        'b_mod': nrm(ks[9], (DEPTH, 3 * D_MODEL), 0.02),
        'w_in': nrm(ks[10], (DEPTH, D_MODEL, D_IN), D_MODEL ** -0.5),
        'ts_mu': 0.25 + nrm(ks[11], (DEPTH, 2, 3 * D_A), 0.1),
        'w0': nrm(ks[12], (DEPTH, 2, D_A), 0.5),
        'w_up': nrm(ks[13], (DEPTH, 2, LORA_W, D_A), 0.5 * LORA_W ** -0.5),
        'a0': nrm(ks[14], (DEPTH, 2, D_A), 0.2),
        'a_up': nrm(ks[15], (DEPTH, 2, LORA_A, D_A), 0.5 * LORA_A ** -0.5),
        'k_k': 0.85 + nrm(ks[16], (DEPTH, 2, D_A), 0.05),
        'k_a': 1.0 + nrm(ks[17], (DEPTH, 2, D_A), 0.05),
        'r_k': nrm(ks[18], (DEPTH, 2, H_A, HEAD_A), 0.1),
        'gn_w': 1.0 + nrm(ks[19], (DEPTH, D_A), 0.05),
        'gn_b': nrm(ks[20], (DEPTH, D_A), 0.02),
        'sgu_ln_g': 1.0 + nrm(ks[21], (DEPTH, D_B), 0.05),
        'sgu_ln_b': nrm(ks[22], (DEPTH, D_B), 0.02),
        'w_s': nrm(ks[23], (DEPTH, H_B, CHUNK, CHUNK), CHUNK ** -0.5),
        'b_s': 1.0 + nrm(ks[24], (DEPTH, H_B, CHUNK), 0.1),
        'w_out': nrm(ks[25], (DEPTH, D_MIX, D_MODEL), D_MIX ** -0.5),
    }


def reference(x_prompt, x_sample, c, state_fwd, state_bwd, c_ctx,
              ln_pre, ln_post, w_mod, b_mod, w_in, ts_mu, w0, w_up, a0, a_up,
              k_k, k_a, r_k, gn_w, gn_b, sgu_ln_g, sgu_ln_b, w_s, b_s, w_out):
    f32 = jnp.float32
    y_prompt, y_sample = x_prompt, x_sample
    zero_state = jnp.zeros((x_prompt.shape[0], H_A, HEAD_A, HEAD_A), f32)
    new_f, new_b = [], []
    for l in range(DEPTH):
        p = {'ln_pre': ln_pre[l], 'ln_post': ln_post[l], 'w_in': w_in[l], 'ts_mu': ts_mu[l],
             'w0': w0[l], 'w_up': w_up[l], 'a0': a0[l], 'a_up': a_up[l], 'k_k': k_k[l],
             'k_a': k_a[l], 'r_k': r_k[l], 'gn_w': gn_w[l], 'gn_b': gn_b[l],
             'sgu_ln_g': sgu_ln_g[l], 'sgu_ln_b': sgu_ln_b[l], 'w_s': w_s[l], 'b_s': b_s[l],
             'w_out': w_out[l]}
        mod_ctx = tuple(m[None, None, :] for m in _modulation(c_ctx, w_mod[l], b_mod[l]))
        mod_lat = tuple(m[:, None, :] for m in _modulation(c, w_mod[l], b_mod[l]))
        y_prompt, s_f, s_b = _mixer_layer(y_prompt, mod_ctx, (zero_state, zero_state), p)
        new_f.append(s_f)
        new_b.append(s_b)
        s0_lat = (state_fwd[:, l].astype(f32), state_bwd[:, l].astype(f32))
        y_sample, _, _ = _mixer_layer(y_sample, mod_lat, s0_lat, p)
    new_state_fwd = jnp.stack(new_f, axis=1).astype(x_prompt.dtype)
    new_state_bwd = jnp.stack(new_b, axis=1).astype(x_prompt.dtype)
    return (y_prompt, y_sample, new_state_fwd, new_state_bwd)
```

```cpp
#include <hip/hip_runtime.h>
#include <hip/hip_cooperative_groups.h>
#include <cstdio>
#include <cstdint>
namespace cg = cooperative_groups;
namespace pg8 {
#define PG8_LAS __attribute__((address_space(3)))
typedef unsigned short bf16_t;
typedef short bf16x8 __attribute__((ext_vector_type(8)));
typedef float f32x4 __attribute__((ext_vector_type(4)));
typedef unsigned u32x4 __attribute__((ext_vector_type(4)));
constexpr int BM = 256, BK = 64, HALF = 128, HTB = HALF * BK * 2  , STAGE_BYTES = 8 * HTB, NXCD = 8, WGM = 8;

__host__ __device__ __forceinline__ int lds_byte(int r, int c) { const int st = (r >> 4) * 2 + (c >> 5), rr = r & 15, cc = c & 31, ob = rr * 64 + cc * 2; return st * 1024 + (ob ^ (((ob >> 9) & 1) << 5)); }
__host__ __device__ __forceinline__ void stage_rc(int b, int& R, int& C) { const int st = b / 1024, sb = b % 1024, swz = sb ^ (((sb >> 9) & 1) << 5); R = (st >> 1) * 16 + swz / 64; C = (st & 1) * 32 + (swz % 64) / 2; }
__host__ __device__ __forceinline__ int perm32(int rho) { const int n = rho >> 4, i = rho & 15; return 8 * (i >> 2) + 4 * n + (i & 3); }

struct Unit { int pm, pn; };
struct Gemm { const bf16_t* A; const bf16_t* Bt; int M, N, K; };

struct StaticOrder {
    int nM, nN, nwg, G, c;
    __host__ __device__ void init(int M, int N, int G_, int c_) { nM = M / BM; nN = N / BM; nwg = nM * nN; G = G_; c = c_; }
    __host__ __device__ bool next(int i, Unit& u) const {
        const long L = (long)i * G + c; if (L >= nwg) return false;
        int wgid = (int)L; { const int q = nwg / NXCD, r = nwg % NXCD, xcd = wgid % NXCD, off = wgid / NXCD; wgid = (xcd < r ? xcd * (q + 1) : r * (q + 1) + (xcd - r) * q) + off; }
        const int nig = WGM * nN, gid = wgid / nig, fm = gid * WGM, gsz = (nM - fm) < WGM ? (nM - fm) : WGM;
        u.pm = fm + ((wgid % nig) % gsz); u.pn = (wgid % nig) / gsz; return true;
    }
    __device__ __forceinline__ void a_ready(const Unit&) const {}
    __device__ __forceinline__ void done(const Unit&) const {}
};
__device__ __forceinline__ unsigned cvt_pk_bf16(float lo, float hi) { unsigned r; asm volatile("v_cvt_pk_bf16_f32 %0, %1, %2" : "=v"(r) : "v"(lo), "v"(hi)); return r; }
struct EpiBf16 {
    static constexpr bool PERM = true, AFTER_DRAIN = false;
    bf16_t* O; int ldc;
    __device__ __forceinline__ void operator()(const f32x4 (&acc)[2][2][4][2], const Unit& u, int wr, int wc, int fr, int fq) const {
        const int row0 = u.pm * BM + wr * 64 + fr, col0 = u.pn * BM + wc * 32 + 8 * fq;
#pragma unroll
        for (int ai = 0; ai < 2; ++ai)
#pragma unroll
            for (int m = 0; m < 4; ++m) { bf16_t* rowp = O + (size_t)(row0 + ai * HALF + m * 16) * ldc + col0;
#pragma unroll
                for (int bj = 0; bj < 2; ++bj) { const f32x4 v0 = acc[ai][bj][m][0], v1 = acc[ai][bj][m][1];
                    u32x4 w; w.x = cvt_pk_bf16(v0[0], v0[1]); w.y = cvt_pk_bf16(v0[2], v0[3]); w.z = cvt_pk_bf16(v1[0], v1[1]); w.w = cvt_pk_bf16(v1[2], v1[3]);
                    *(u32x4*)(rowp + bj * HALF) = w; } }
    }
};
struct EpiF32 {
    static constexpr bool PERM = false, AFTER_DRAIN = false;
    float* C; int ldc;
    __device__ __forceinline__ void operator()(const f32x4 (&acc)[2][2][4][2], const Unit& u, int wr, int wc, int fr, int fq) const {
        const int row0 = u.pm * BM + wr * 64 + fr, col0 = u.pn * BM + wc * 32 + 4 * fq;
#pragma unroll
        for (int ai = 0; ai < 2; ++ai)
#pragma unroll
            for (int m = 0; m < 4; ++m) { float* rowp = C + (size_t)(row0 + ai * HALF + m * 16) * ldc + col0;
#pragma unroll
                for (int bj = 0; bj < 2; ++bj)
#pragma unroll
                    for (int n = 0; n < 2; ++n) *(f32x4*)(rowp + bj * HALF + n * 16) = acc[ai][bj][m][n]; }
    }
};
template <class Epi, class Sched, bool ALIGN_EPI = false, bool SP2 = false>
__device__ __forceinline__ void gemm_phase(PG8_LAS unsigned char* lds, const Gemm g, const Sched& S, const Epi& E) {
    const int tid = threadIdx.x, wid = __builtin_amdgcn_readfirstlane(tid >> 6), lane = tid & 63, wr = wid >> 2, wc = wid & 3, fr = lane & 15, fq = lane >> 4;
    const int K = g.K, nt = K / BK;
    unsigned voffA[2], voffB[2];
#pragma unroll
    for (int i = 0; i < 2; ++i) { int R, C; stage_rc(tid * 16 + i * 8192, R, C); const int Rb = Epi::PERM ? ((R & ~31) + perm32(R & 31)) : R;
        voffA[i] = (unsigned)(R * K + C) * 2u; voffB[i] = (unsigned)(Rb * K + C) * 2u; }
    const size_t kstep = (size_t)(BK * 2);
    const size_t hstep = (size_t)HALF * K * 2;
    const size_t tstep = 2 * hstep;
    const unsigned ldsw = (unsigned)wid * 1024u;
    const int aoff = lds_byte(wr * 64 + fr, fq * 8), boff = lds_byte(wc * 32 + fr, fq * 8);
#define PG8_SA(b, h) (((b) * 2 + (h)) * HTB)
#define PG8_SB(b, h) ((4 + (b) * 2 + (h)) * HTB)
#define PG8_STAGE(bufoff, gbase, voff) do { _Pragma("unroll") for (int _i = 0; _i < 2; ++_i) \
        __builtin_amdgcn_global_load_lds((const unsigned*)((const char*)(gbase) + (voff)[_i]), (PG8_LAS unsigned*)(lds + (bufoff) + ldsw + _i * 8192), 16, 0, 0); } while (0)
#define PG8_LDA(dst, b, h) do { _Pragma("unroll") for (int m = 0; m < 4; ++m) _Pragma("unroll") for (int k = 0; k < 2; ++k) dst[m][k] = *(const PG8_LAS bf16x8*)(lds + PG8_SA(b, h) + aoff + m * 2048 + k * 1024); } while (0)
#define PG8_LDB(dst, b, h) do { _Pragma("unroll") for (int n = 0; n < 2; ++n) _Pragma("unroll") for (int k = 0; k < 2; ++k) dst[n][k] = *(const PG8_LAS bf16x8*)(lds + PG8_SB(b, h) + boff + n * 2048 + k * 1024); } while (0)
#define PG8_MMA(ai, bj, At, Bt) do { __builtin_amdgcn_s_setprio(1); _Pragma("unroll") for (int m = 0; m < 4; ++m) _Pragma("unroll") for (int n = 0; n < 2; ++n) _Pragma("unroll") for (int k = 0; k < 2; ++k) \
        acc[ai][bj][m][n] = __builtin_amdgcn_mfma_f32_16x16x32_bf16(Bt[n][k], At[m][k], acc[ai][bj][m][n], 0, 0, 0); __builtin_amdgcn_s_setprio(0); } while (0)
#define PG8_WAIT_V(n) asm volatile("s_waitcnt vmcnt(" #n ")" ::: "memory")
#define PG8_WAIT_L(n) asm volatile("s_waitcnt lgkmcnt(" #n ")" ::: "memory")
#define PG8_BAR __builtin_amdgcn_s_barrier()
#define PG8_SCHED __builtin_amdgcn_sched_barrier(0)
    Unit cur, nxt; int ui = 0;
    if (!S.next(0, cur)) return;
    f32x4 acc[2][2][4][2];
#pragma unroll
    for (int a = 0; a < 2; ++a)
#pragma unroll
        for (int b = 0; b < 2; ++b)
#pragma unroll
            for (int m = 0; m < 4; ++m)
#pragma unroll
                for (int n = 0; n < 2; ++n) acc[a][b][m][n] = (f32x4){0.f, 0.f, 0.f, 0.f};
    bf16x8 At[4][2], B0[2][2], B1[2][2];
    const char* cA = (const char*)g.A + (size_t)cur.pm * tstep; const char* cB = (const char*)g.Bt + (size_t)cur.pn * tstep;
    S.a_ready(cur);
    if constexpr (SP2) {
        PG8_STAGE(PG8_SB(0, 0), cB, voffB); PG8_STAGE(PG8_SB(0, 1), cB + hstep, voffB); PG8_STAGE(PG8_SA(0, 0), cA, voffA); PG8_STAGE(PG8_SA(0, 1), cA + hstep, voffA);
        if (wr == 1) PG8_BAR;
        PG8_WAIT_V(2); PG8_BAR;
        PG8_STAGE(PG8_SB(1, 0), cB + kstep, voffB); PG8_STAGE(PG8_SA(1, 0), cA + kstep, voffA); PG8_STAGE(PG8_SB(1, 1), cB + hstep + kstep, voffB);
        PG8_WAIT_V(6); PG8_BAR;
    } else {
        PG8_STAGE(PG8_SB(0, 0), cB, voffB); PG8_STAGE(PG8_SA(0, 0), cA, voffA); PG8_STAGE(PG8_SB(0, 1), cB + hstep, voffB); PG8_STAGE(PG8_SA(0, 1), cA + hstep, voffA);
        if (wr == 1) PG8_BAR;
        PG8_WAIT_V(4); PG8_BAR;
        PG8_STAGE(PG8_SB(1, 0), cB + kstep, voffB); PG8_STAGE(PG8_SA(1, 0), cA + kstep, voffA); PG8_STAGE(PG8_SB(1, 1), cB + hstep + kstep, voffB);
        PG8_WAIT_V(6); PG8_BAR;
    }
    for (;;) {
        const bool has_next = S.next(ui + 1, nxt);
        const char* nA = has_next ? (const char*)g.A + (size_t)nxt.pm * tstep : cA; const char* nB = has_next ? (const char*)g.Bt + (size_t)nxt.pn * tstep : cB;
        for (int t = 0; t < nt; t += 2) {
            const bool last = (t == nt - 2);
            const char* a1 = cA + (size_t)(t + 1) * kstep;
            const char* a2 = last ? nA : cA + (size_t)(t + 2) * kstep; const char* b2 = last ? nB : cB + (size_t)(t + 2) * kstep;
            const char* a3 = a2 + kstep; const char* b3 = b2 + kstep;
            if (last && has_next) S.a_ready(nxt);
            if constexpr (SP2) {
            PG8_LDB(B0, 0, 0); PG8_LDB(B1, 0, 1); PG8_SCHED; PG8_LDA(At, 0, 0); PG8_STAGE(PG8_SA(1, 1), a1 + hstep, voffA);
            PG8_WAIT_V(8); PG8_WAIT_L(0); PG8_BAR; PG8_MMA(0, 0, At, B0); PG8_MMA(0, 1, At, B1); PG8_BAR; PG8_SCHED;
            PG8_LDA(At, 0, 1); PG8_STAGE(PG8_SB(0, 0), b2, voffB); PG8_STAGE(PG8_SB(0, 1), b2 + hstep, voffB); PG8_STAGE(PG8_SA(0, 0), a2, voffA);
            PG8_WAIT_V(8); PG8_WAIT_L(0); PG8_BAR; PG8_MMA(1, 0, At, B0); PG8_MMA(1, 1, At, B1); PG8_BAR; PG8_SCHED;
            PG8_LDB(B0, 1, 0); PG8_LDB(B1, 1, 1); PG8_SCHED; PG8_LDA(At, 1, 0); PG8_STAGE(PG8_SA(0, 1), a2 + hstep, voffA);
            PG8_WAIT_V(8); PG8_WAIT_L(0); PG8_BAR; PG8_MMA(0, 0, At, B0); PG8_MMA(0, 1, At, B1); PG8_BAR; PG8_SCHED;
            PG8_LDA(At, 1, 1); PG8_STAGE(PG8_SB(1, 0), b3, voffB); PG8_STAGE(PG8_SB(1, 1), b3 + hstep, voffB); PG8_STAGE(PG8_SA(1, 0), a3, voffA);
            PG8_WAIT_V(8); PG8_WAIT_L(0); PG8_BAR; PG8_MMA(1, 0, At, B0); PG8_MMA(1, 1, At, B1); PG8_BAR; PG8_SCHED;
            } else {
            PG8_LDB(B0, 0, 0); PG8_SCHED; PG8_LDA(At, 0, 0); PG8_STAGE(PG8_SA(1, 1), a1 + hstep, voffA);
            PG8_WAIT_L(8); PG8_BAR; PG8_WAIT_L(0); PG8_MMA(0, 0, At, B0); PG8_BAR; PG8_SCHED;
            PG8_LDB(B1, 0, 1); PG8_STAGE(PG8_SB(0, 0), b2, voffB);
            PG8_BAR; PG8_WAIT_L(0); PG8_MMA(0, 1, At, B1); PG8_BAR;
            PG8_LDA(At, 0, 1); PG8_STAGE(PG8_SA(0, 0), a2, voffA);
            PG8_BAR; PG8_WAIT_L(0); PG8_MMA(1, 0, At, B0); PG8_BAR; PG8_SCHED;
            PG8_STAGE(PG8_SB(0, 1), b2 + hstep, voffB);
            PG8_WAIT_V(6); PG8_BAR; PG8_MMA(1, 1, At, B1); PG8_BAR;
            PG8_LDB(B0, 1, 0); PG8_SCHED; PG8_LDA(At, 1, 0); PG8_STAGE(PG8_SA(0, 1), a2 + hstep, voffA);
            PG8_WAIT_L(8); PG8_BAR; PG8_WAIT_L(0); PG8_MMA(0, 0, At, B0); PG8_BAR; PG8_SCHED;
            PG8_LDB(B1, 1, 1); PG8_STAGE(PG8_SB(1, 0), b3, voffB);
            PG8_BAR; PG8_WAIT_L(0); PG8_MMA(0, 1, At, B1); PG8_BAR;
            PG8_LDA(At, 1, 1); PG8_STAGE(PG8_SA(1, 0), a3, voffA);
            PG8_BAR; PG8_WAIT_L(0); PG8_MMA(1, 0, At, B0); PG8_BAR; PG8_SCHED;
            PG8_STAGE(PG8_SB(1, 1), b3 + hstep, voffB);
            PG8_WAIT_V(6); PG8_BAR; PG8_MMA(1, 1, At, B1); PG8_BAR;
            }
        }
        if constexpr (ALIGN_EPI) { if (wr == 0) PG8_BAR; }
        if constexpr (!Epi::AFTER_DRAIN) { E(acc, cur, wr, wc, fr, fq); S.done(cur); }
        if (!has_next) break;
#pragma unroll
        for (int a = 0; a < 2; ++a)
#pragma unroll
            for (int b = 0; b < 2; ++b)
#pragma unroll
                for (int m = 0; m < 4; ++m)
#pragma unroll
                    for (int n = 0; n < 2; ++n) acc[a][b][m][n] = (f32x4){0.f, 0.f, 0.f, 0.f};
        cur = nxt; cA = nA; cB = nB; ++ui;
        if constexpr (ALIGN_EPI) { if (wr == 1) PG8_BAR; }
    }
    PG8_WAIT_V(0);
    if constexpr (!ALIGN_EPI) { if (wr == 0) PG8_BAR; }
    PG8_BAR;
    if constexpr (Epi::AFTER_DRAIN) { E.fused(acc, cur, wr, wc, fr, fq, lds, wid, lane); S.done(cur); }
#undef PG8_SA
#undef PG8_SB
#undef PG8_STAGE
#undef PG8_LDA
#undef PG8_LDB
#undef PG8_MMA
#undef PG8_WAIT_V
#undef PG8_WAIT_L
#undef PG8_BAR
#undef PG8_SCHED
}
}

constexpr int D = 1024, M_CTX = 32 * 256, M_LAT = 8 * 4096, MT = M_CTX + M_LAT;
constexpr int L_CTX = 256, L_LAT = 4096, NB_CTX = 32, NB_LAT = 8;
constexpr int D_IN = 3840, D_A = 512, NH = 8, HD = 64;
constexpr int C_R = 0, C_K = 512, C_V = 1024, C_ZA = 1536, C_WD = 2048, C_AD = 2176, C_U = 2304, C_VB = 2816, C_ZB = 3328;
constexpr float NORM_EPS = 1e-6f, GN_EPS = 6.4e-4f;
constexpr size_t STATE_ELEMS = (size_t)NB_CTX * NH * HD * HD;

constexpr size_t MiB = 1u << 20;
constexpr size_t WS_CTL = 0, CTL_ZERO_BYTES = 1 * MiB;
constexpr size_t WS_MOD = 64 * 1024;
constexpr size_t WS_WIN = 1 * MiB;
constexpr size_t WS_WOUT = 9 * MiB;
constexpr size_t WS_WSB = 11 * MiB;
constexpr size_t WS_BS = 12 * MiB;
constexpr size_t WS_H = 16 * MiB;
constexpr size_t WS_PROJ = 96 * MiB;
constexpr size_t WS_END = WS_PROJ + (size_t)MT * D_IN * 2;
static_assert(WS_WIN + (size_t)D_IN * D * 2 <= WS_WOUT && WS_BS + (size_t)2 * MT * 8 * 4 <= WS_H && WS_H + (size_t)MT * D * 2 <= WS_PROJ, "ws map");

constexpr int LDS_BYTES = 147456;
constexpr int NWAVES = 8, NTHREADS = 512;

#define LAS __attribute__((address_space(3)))
#define GAS __attribute__((address_space(1)))
typedef unsigned short bf16;
typedef float f32x4 __attribute__((ext_vector_type(4)));
typedef short bf16x8 __attribute__((ext_vector_type(8)));
typedef unsigned u32x4v __attribute__((ext_vector_type(4)));
typedef unsigned u32x2v __attribute__((ext_vector_type(2)));

__device__ __forceinline__ float bf2f(unsigned b) { return __uint_as_float(b << 16); }
__device__ __forceinline__ unsigned f2bf(float f) { unsigned u = __float_as_uint(f); return (u + 0x7fffu + ((u >> 16) & 1u)) >> 16; }
__device__ __forceinline__ unsigned pk2(float lo, float hi) { return f2bf(lo) | (f2bf(hi) << 16); }
template <int CTRL> __device__ __forceinline__ float dpp_f(float v) { return __int_as_float(__builtin_amdgcn_update_dpp(0, __float_as_int(v), CTRL, 0xf, 0xf, true)); }
__device__ __forceinline__ float quad_sum4(float v) { v += dpp_f<0xB1>(v); v += dpp_f<0x4E>(v); return v; }
__device__ __forceinline__ float wave_sum(float v) {
    v += dpp_f<0xB1>(v); v += dpp_f<0x4E>(v);
    v += dpp_f<0x141>(v); v += dpp_f<0x140>(v);
    v += __int_as_float(__builtin_amdgcn_ds_swizzle(__float_as_int(v), 0x401F));
    return __int_as_float(__builtin_amdgcn_readlane(__float_as_int(v), 0)) + __int_as_float(__builtin_amdgcn_readlane(__float_as_int(v), 32));
}
__device__ __forceinline__ float silu_f(float x) { return x / (1.0f + __expf(-x)); }
__device__ __forceinline__ float sigmoid_f(float x) { return 1.0f / (1.0f + __expf(-x)); }

struct Params { const float* in[26]; float* out; unsigned char* ws; int ph_lo, ph_hi; };

enum { I_XP = 0, I_XS, I_C, I_SF, I_SB, I_CCTX, I_LNPRE, I_LNPOST, I_WMOD, I_BMOD, I_WIN, I_TSMU, I_W0, I_WUP, I_A0, I_AUP, I_KK, I_KA, I_RK, I_GNW, I_GNB, I_SLG, I_SLB, I_WS, I_BSS, I_WOUT };

__device__ __forceinline__ void transpose_item(const float* W, int K, int N, bf16* WT, LAS float* scr, int item, int lane) {
    const int nblk = N / 32, kb = item / nblk, nb = item % nblk, k0 = 64 * kb, n0 = 32 * nb;
#pragma unroll 8
    for (int i = 0; i < 32; ++i) { const int kk = 2 * i + (lane >> 5); scr[kk * 33 + (lane & 31)] = W[(size_t)(k0 + kk) * N + n0 + (lane & 31)]; }
    asm volatile("s_waitcnt lgkmcnt(0)" ::: "memory");
    const int c = lane & 7;
#pragma unroll
    for (int j = 0; j < 4; ++j) { const int n = (lane >> 3) + 8 * j; const LAS float* s = scr + (8 * c) * 33 + n;
        u32x4v o; o.x = pk2(s[0 * 33], s[1 * 33]); o.y = pk2(s[2 * 33], s[3 * 33]); o.z = pk2(s[4 * 33], s[5 * 33]); o.w = pk2(s[6 * 33], s[7 * 33]);
        *(u32x4v*)(WT + (size_t)(n0 + n) * K + k0 + 8 * c) = o; }
    asm volatile("s_waitcnt lgkmcnt(0)" ::: "memory");
}

__device__ __forceinline__ void phase0(const Params& P, LAS unsigned char* lds, int gw, int NGW, int wave, int lane) {
    unsigned char* ws = P.ws;
    float* mod = (float*)(ws + WS_MOD);
    const float* w_mod = P.in[I_WMOD]; const float* b_mod = P.in[I_BMOD]; const float* cc = P.in[I_C]; const float* cctx = P.in[I_CCTX];
    for (int task = gw; task < 12 * 32; task += NGW) {
        const int cgp = task % 12, rs = task / 12, col = cgp * 256 + lane * 4;
        f32x4 acc[9];
#pragma unroll
        for (int v = 0; v < 9; ++v) acc[v] = (f32x4){0.f, 0.f, 0.f, 0.f};
        for (int i = rs * 32; i < rs * 32 + 32; ++i) {
            const f32x4 w = *(const f32x4*)(w_mod + (size_t)i * 3072 + col);
#pragma unroll
            for (int v = 0; v < 9; ++v) { const float cv = (v == 0) ? cctx[i] : cc[(v - 1) * 1024 + i]; acc[v] += silu_f(cv) * w; }
        }
        if (rs == 0) { const f32x4 b = *(const f32x4*)(b_mod + col);
#pragma unroll
            for (int v = 0; v < 9; ++v) acc[v] += b; }
#pragma unroll
        for (int v = 0; v < 9; ++v)
#pragma unroll
            for (int e = 0; e < 4; ++e) atomicAdd(mod + v * 3072 + col + e, acc[v][e]);
    }
    LAS float* scr = (LAS float*)(lds + wave * 16384);
    constexpr int I_1 = (D / 64) * (D_IN / 32), I_2 = (D / 64) * (D / 32);
    for (int it = gw; it < I_1 + I_2; it += NGW) {
        if (it < I_1) transpose_item(P.in[I_WIN], D, D_IN, (bf16*)(ws + WS_WIN), scr, it, lane);
        else transpose_item(P.in[I_WOUT], D, D, (bf16*)(ws + WS_WOUT), scr, it - I_1, lane);
    }
    { const float* w_s = P.in[I_WS]; bf16* wsb = (bf16*)(ws + WS_WSB);
      for (int i = gw * 64 + lane; i < 8 * 128 * 128 / 4; i += NGW * 64) { const f32x4 v = *(const f32x4*)(w_s + (size_t)i * 4); u32x2v o; o.x = pk2(v[0], v[1]); o.y = pk2(v[2], v[3]); *(u32x2v*)(wsb + (size_t)i * 4) = o; } }
}

__device__ __forceinline__ const GAS float* x_row(const Params& P, int m) { return (const GAS float*)(m < M_CTX ? P.in[I_XP] + (size_t)m * D : P.in[I_XS] + (size_t)(m - M_CTX) * D); }
__device__ __forceinline__ int mod_index(int m) { return m < M_CTX ? 0 : 1 + (m - M_CTX) / L_LAT; }

__device__ __forceinline__ void phase1(const Params& P, int gw, int NGW, int lane) {
    const GAS float* mod = (const GAS float*)(P.ws + WS_MOD); const GAS float* ln_pre = (const GAS float*)P.in[I_LNPRE]; GAS bf16* H = (GAS bf16*)(P.ws + WS_H);
    for (int m = gw; m < MT; m += NGW) {
        const GAS f32x4* xr = (const GAS f32x4*)x_row(P, m) + lane; const GAS float* shift = mod + mod_index(m) * 3072; const GAS float* scale = shift + 1024;
        f32x4 v[4]; float ss = 0.f;
#pragma unroll
        for (int j = 0; j < 4; ++j) { v[j] = xr[64 * j]; ss += (v[j].x * v[j].x + v[j].y * v[j].y) + (v[j].z * v[j].z + v[j].w * v[j].w); }
        const float rstd = 1.0f / sqrtf(wave_sum(ss) * (1.0f / D) + NORM_EPS);
        GAS unsigned long long* o8 = (GAS unsigned long long*)(H + (size_t)m * D) + lane;
#pragma unroll
        for (int j = 0; j < 4; ++j) { const int col = 4 * (lane + 64 * j);
            const f32x4 g = *(const GAS f32x4*)(ln_pre + col), sc = *(const GAS f32x4*)(scale + col), sh = *(const GAS f32x4*)(shift + col);
            const f32x4 o = v[j] * rstd * g * (1.0f + sc) + sh;
            o8[64 * j] = (unsigned long long)pk2(o.x, o.y) | ((unsigned long long)pk2(o.z, o.w) << 32); }
    }
}

constexpr int TB = 32;
__device__ __forceinline__ void do_chain(const Params& P, LAS unsigned char* lds, int m0, int L, int h, int dir, const float* s0, float* sfin) {
    const int tid = threadIdx.x, lane = tid & 63, wave = __builtin_amdgcn_readfirstlane(tid >> 6);
    const GAS bf16* proj = (const GAS bf16*)(P.ws + WS_PROJ);
    GAS float* YD = (GAS float*)P.out; GAS float* BS = (GAS float*)(P.ws + WS_BS);
    LAS float* buf = (LAS float*)lds;
    LAS float* tl = (LAS float*)(lds + 98304);
    const int nb = L / TB;
    if (wave >= 4) {
        const int pw = wave - 4, j = lane, cj = h * 64 + j;
        const float* ts_mu = P.in[I_TSMU];
        const float mu0r = ts_mu[C_R + cj], mu1r = ts_mu[1536 + C_R + cj], mu0k = ts_mu[C_K + cj], mu1k = ts_mu[1536 + C_K + cj], mu0v = ts_mu[C_V + cj], mu1v = ts_mu[1536 + C_V + cj];
        const float w0j = P.in[I_W0][dir * 512 + cj], a0j = P.in[I_A0][dir * 512 + cj], kkj = P.in[I_KK][dir * 512 + cj], kaj = P.in[I_KA][dir * 512 + cj], rkj = P.in[I_RK][dir * 512 + cj];
        LAS float* wupL = (LAS float*)(lds + 98304 + 2048);
        LAS float* aupL = wupL + 4096;
        for (int i = pw; i < 64; i += 4) { wupL[i * 64 + j] = P.in[I_WUP][(size_t)(dir * 64 + i) * 512 + cj]; aupL[i * 64 + j] = P.in[I_AUP][(size_t)(dir * 64 + i) * 512 + cj]; }
        asm volatile("s_waitcnt lgkmcnt(0)" ::: "memory");
        __builtin_amdgcn_s_barrier();
        LAS float* tlw = tl + pw * 128;
        for (int bi = 0; bi <= nb; ++bi) {
            if (bi < nb) {
                LAS float* dst = buf + (bi & 1) * (6 * TB * 64);
#pragma unroll 1
                for (int hb = 0; hb < 2; ++hb) {
                unsigned raw[4][11];
#pragma unroll
                for (int i = 0; i < 4; ++i) {
                    const int p = bi * TB + pw * 8 + hb * 4 + i, t = dir ? (L - 1 - p) : p;
                    const GAS bf16* pr = proj + (size_t)(m0 + t) * D_IN;
                    const bool hp = t > 0, hn = t < L - 1;
                    raw[i][0] = pr[C_R + cj]; raw[i][1] = hp ? pr[C_R + cj - D_IN] : 0; raw[i][2] = hn ? pr[C_R + cj + D_IN] : 0;
                    raw[i][3] = pr[C_K + cj]; raw[i][4] = hp ? pr[C_K + cj - D_IN] : 0; raw[i][5] = hn ? pr[C_K + cj + D_IN] : 0;
                    raw[i][6] = pr[C_V + cj]; raw[i][7] = hp ? pr[C_V + cj - D_IN] : 0; raw[i][8] = hn ? pr[C_V + cj + D_IN] : 0;
                    raw[i][9] = pr[C_WD + dir * 64 + j]; raw[i][10] = pr[C_AD + dir * 64 + j];
                }
#pragma unroll
                for (int i = 0; i < 4; ++i) {
                    const int tok = pw * 8 + hb * 4 + i, p = bi * TB + tok, t = dir ? (L - 1 - p) : p;
                    const float rc = bf2f(raw[i][0]), rp = bf2f(raw[i][1]), rn = bf2f(raw[i][2]);
                    const float kc = bf2f(raw[i][3]), kp = bf2f(raw[i][4]), kn = bf2f(raw[i][5]);
                    const float vc = bf2f(raw[i][6]), vp = bf2f(raw[i][7]), vn = bf2f(raw[i][8]);
                    const float r = rc + mu0r * (rp - rc) + mu1r * (rn - rc);
                    const float k = kc + mu0k * (kp - kc) + mu1k * (kn - kc);
                    const float v = vc + mu0v * (vp - vc) + mu1v * (vn - vc);
                    tlw[j] = tanhf(bf2f(raw[i][9])); tlw[64 + j] = bf2f(raw[i][10]);
                    asm volatile("s_waitcnt lgkmcnt(0)" ::: "memory");
                    float wl = w0j, al = a0j;
#pragma unroll
                    for (int q = 0; q < 16; ++q) { const f32x4 t4 = *(const LAS f32x4*)(tlw + 4 * q), a4 = *(const LAS f32x4*)(tlw + 64 + 4 * q);
                        wl += t4.x * wupL[(4 * q) * 64 + j] + t4.y * wupL[(4 * q + 1) * 64 + j] + t4.z * wupL[(4 * q + 2) * 64 + j] + t4.w * wupL[(4 * q + 3) * 64 + j];
                        al += a4.x * aupL[(4 * q) * 64 + j] + a4.y * aupL[(4 * q + 1) * 64 + j] + a4.z * aupL[(4 * q + 2) * 64 + j] + a4.w * aupL[(4 * q + 3) * 64 + j]; }
                    asm volatile("s_waitcnt lgkmcnt(0)" ::: "memory");
                    const float nx = -wl, sp = fmaxf(nx, 0.f) + log1pf(__expf(-fabsf(nx)));
                    const float wdec = __expf(-__expf(-sp - 0.5f));
                    const float a = sigmoid_f(al);
                    float kk = k * kkj; const float n2 = wave_sum(kk * kk); kk *= 1.0f / sqrtf(n2 + 1e-12f);
                    const float kd = k * (1.0f + (a - 1.0f) * kaj), bb = kk * a;
                    const float bon = wave_sum(r * kd * rkj);
                    dst[(0 * TB + tok) * 64 + j] = r; dst[(1 * TB + tok) * 64 + j] = kd; dst[(2 * TB + tok) * 64 + j] = v;
                    dst[(3 * TB + tok) * 64 + j] = wdec; dst[(4 * TB + tok) * 64 + j] = -kk; dst[(5 * TB + tok) * 64 + j] = bb;
                    if (lane == 0) BS[((size_t)dir * MT + m0 + t) * 8 + h] = bon;
                }
                }
            }
            __syncthreads();
        }
    } else {
        const int cw = wave, vr = lane >> 2, kq = lane & 3, vrow = cw * 16 + vr;
        float S[16];
#pragma unroll
        for (int q = 0; q < 4; ++q) { f32x4 s4 = (f32x4){0.f, 0.f, 0.f, 0.f}; if (s0) s4 = *(const f32x4*)(s0 + vrow * 64 + kq * 16 + 4 * q);
            S[4 * q] = s4.x; S[4 * q + 1] = s4.y; S[4 * q + 2] = s4.z; S[4 * q + 3] = s4.w; }
        __builtin_amdgcn_s_barrier();
        __syncthreads();
        for (int bi = 0; bi < nb; ++bi) {
            const LAS float* src = buf + (bi & 1) * (6 * TB * 64);
#pragma unroll 2
            for (int tok = 0; tok < TB; ++tok) {
                const int p = bi * TB + tok, t = dir ? (L - 1 - p) : p;
                float rr[16], kd[16], ww[16], na[16], bb[16];
#pragma unroll
                for (int q = 0; q < 4; ++q) {
                    const f32x4 r4 = *(const LAS f32x4*)(src + (0 * TB + tok) * 64 + kq * 16 + 4 * q), k4 = *(const LAS f32x4*)(src + (1 * TB + tok) * 64 + kq * 16 + 4 * q);
                    const f32x4 w4 = *(const LAS f32x4*)(src + (3 * TB + tok) * 64 + kq * 16 + 4 * q), n4 = *(const LAS f32x4*)(src + (4 * TB + tok) * 64 + kq * 16 + 4 * q);
                    const f32x4 b4 = *(const LAS f32x4*)(src + (5 * TB + tok) * 64 + kq * 16 + 4 * q);
#pragma unroll
                    for (int e = 0; e < 4; ++e) { rr[4 * q + e] = r4[e]; kd[4 * q + e] = k4[e]; ww[4 * q + e] = w4[e]; na[4 * q + e] = n4[e]; bb[4 * q + e] = b4[e]; }
                }
                const float vv = src[(2 * TB + tok) * 64 + vrow];
                float sa = 0.f;
#pragma unroll
                for (int e = 0; e < 16; ++e) sa += S[e] * na[e];
                sa = quad_sum4(sa);
                float y = 0.f;
#pragma unroll
                for (int e = 0; e < 16; ++e) { S[e] = S[e] * ww[e] + (sa * bb[e] + vv * kd[e]); y += S[e] * rr[e]; }
                y = quad_sum4(y);
                if (kq == 0) YD[((size_t)dir * MT + m0 + t) * 512 + h * 64 + vrow] = y;
            }
            __syncthreads();
        }
        if (sfin) {
#pragma unroll
            for (int q = 0; q < 4; ++q) *(f32x4*)(sfin + vrow * 64 + kq * 16 + 4 * q) = (f32x4){S[4 * q], S[4 * q + 1], S[4 * q + 2], S[4 * q + 3]};
        }
    }
}

constexpr int VNT_LD = 136;
__device__ __forceinline__ void do_gmlp(const Params& P, LAS unsigned char* lds, int unit) {
    const int tid = threadIdx.x, lane = tid & 63, wave = __builtin_amdgcn_readfirstlane(tid >> 6);
    const GAS bf16* proj = (const GAS bf16*)(P.ws + WS_PROJ); GAS bf16* MIX = (GAS bf16*)(P.ws + WS_H); const GAS bf16* wsb = (const GAS bf16*)(P.ws + WS_WSB);
    LAS bf16* vnt = (LAS bf16*)lds;
    const int row0 = unit * 128;
    { const float* g = P.in[I_SLG]; const float* b = P.in[I_SLB];
      float gg[8], bb[8];
#pragma unroll
      for (int e = 0; e < 8; ++e) { gg[e] = g[lane * 8 + e]; bb[e] = b[lane * 8 + e]; }
#pragma unroll 2
      for (int i = 0; i < 16; ++i) { const int tok = wave * 16 + i;
        const u32x4v raw = *(const GAS u32x4v*)(proj + (size_t)(row0 + tok) * D_IN + C_VB + lane * 8);
        float x[8]; x[0] = bf2f(raw.x & 0xffffu); x[1] = bf2f(raw.x >> 16); x[2] = bf2f(raw.y & 0xffffu); x[3] = bf2f(raw.y >> 16); x[4] = bf2f(raw.z & 0xffffu); x[5] = bf2f(raw.z >> 16); x[6] = bf2f(raw.w & 0xffffu); x[7] = bf2f(raw.w >> 16);
        float s = 0.f;
#pragma unroll
        for (int e = 0; e < 8; ++e) s += x[e];
        const float mean = wave_sum(s) * (1.0f / 512.0f); float q = 0.f;
#pragma unroll
        for (int e = 0; e < 8; ++e) { x[e] -= mean; q += x[e] * x[e]; }
        const float rstd = 1.0f / sqrtf(wave_sum(q) * (1.0f / 512.0f) + NORM_EPS);
#pragma unroll
        for (int e = 0; e < 8; ++e) vnt[(lane * 8 + e) * VNT_LD + tok] = (bf16)f2bf(x[e] * rstd * gg[e] + bb[e]); } }
    __syncthreads();
    const int g = wave, fr = lane & 15, fq = lane >> 4;
    const float* b_s = P.in[I_BSS];
#pragma unroll 1
    for (int ah = 0; ah < 2; ++ah) {
        f32x4 acc[4][4];
#pragma unroll
        for (int a = 0; a < 4; ++a)
#pragma unroll
            for (int c = 0; c < 4; ++c) acc[a][c] = (f32x4){0.f, 0.f, 0.f, 0.f};
#pragma unroll
        for (int ks = 0; ks < 4; ++ks) {
            bf16x8 bfr[4];
#pragma unroll
            for (int c = 0; c < 4; ++c) bfr[c] = *(const LAS bf16x8*)(vnt + (g * 64 + c * 16 + fr) * VNT_LD + ks * 32 + 8 * fq);
#pragma unroll
            for (int a = 0; a < 4; ++a) { const bf16x8 afr = *(const GAS bf16x8*)(wsb + (size_t)(g * 128 + (ah * 4 + a) * 16 + fr) * 128 + ks * 32 + 8 * fq);
#pragma unroll
                for (int c = 0; c < 4; ++c) acc[a][c] = __builtin_amdgcn_mfma_f32_16x16x32_bf16(afr, bfr[c], acc[a][c], 0, 0, 0); }
        }
#pragma unroll
        for (int a = 0; a < 4; ++a)
#pragma unroll
            for (int e = 0; e < 4; ++e) { const int p = (ah * 4 + a) * 16 + fq * 4 + e; const float bsv = b_s[g * 128 + p]; const GAS bf16* pr = proj + (size_t)(row0 + p) * D_IN; asm volatile("" : "+v"(pr));
#pragma unroll
                for (int c = 0; c < 4; ++c) { const int ch = g * 64 + c * 16 + fr; const float u = bf2f(pr[C_U + ch]), zb = bf2f(pr[C_ZB + ch]);
                    MIX[(size_t)(row0 + p) * D + 512 + ch] = (bf16)f2bf(u * (acc[a][c][e] + bsv) * silu_f(zb)); }
                asm volatile("" ::: "memory"); }
    }
    __syncthreads();
}

__device__ __forceinline__ void phase3(const Params& P, LAS unsigned char* lds) {
    const int G = gridDim.x, bid = blockIdx.x;
    const int nit = (G >= 256) ? 4 : (640 + G - 1) / G;
    for (int it = 0; it < nit; ++it) {
        int c = -1;
        if (G >= 256) { if (bid < 128) c = (it == 0) ? bid : -1; else if (bid < 256) c = 128 + (bid - 128) * 4 + it; }
        else { c = bid + it * G; if (c >= 640) c = -1; }
        if (c < 0) continue;
        int m0, L, h, dir; const float* s0; float* sfin;
        if (c < 128) { const int b = c >> 4; h = (c >> 1) & 7; dir = c & 1; m0 = M_CTX + b * L_LAT; L = L_LAT;
            s0 = (dir ? P.in[I_SB] : P.in[I_SF]) + (size_t)(b * 8 + h) * 4096; sfin = nullptr; }
        else { const int cc = c - 128, b = cc >> 4; h = (cc >> 1) & 7; dir = cc & 1; m0 = b * L_CTX; L = L_CTX;
            s0 = nullptr; sfin = P.out + (size_t)MT * D + (size_t)dir * STATE_ELEMS + (size_t)(b * 8 + h) * 4096; }
        do_chain(P, lds, m0, L, h, dir, s0, sfin);
    }
    if (G >= 256) { if (bid >= 128 && bid < 256) for (int u = bid - 128; u < 320; u += 128) do_gmlp(P, lds, u); }
    else { for (int u = bid; u < 320; u += G) do_gmlp(P, lds, u); }
}

__device__ __forceinline__ void phase4(const Params& P, int gw, int NGW, int lane) {
    const GAS bf16* proj = (const GAS bf16*)(P.ws + WS_PROJ); GAS bf16* MIX = (GAS bf16*)(P.ws + WS_H); const GAS float* YD = (const GAS float*)P.out; const GAS float* BS = (const GAS float*)(P.ws + WS_BS);
    const float* ts_mu = P.in[I_TSMU]; const float* gn_w = P.in[I_GNW]; const float* gn_b = P.in[I_GNB];
    for (int task = gw; task < MT * 8; task += NGW) {
        const int m = task >> 3, h = task & 7, cj = h * 64 + lane;
        const int t = (m < M_CTX) ? (m & (L_CTX - 1)) : ((m - M_CTX) & (L_LAT - 1)), L = (m < M_CTX) ? L_CTX : L_LAT;
        const float y = YD[(size_t)m * 512 + cj] + YD[((size_t)MT + m) * 512 + cj];
        const float mean = wave_sum(y) * (1.0f / 64.0f), d = y - mean, var = wave_sum(d * d) * (1.0f / 64.0f);
        const float yn = d * (1.0f / sqrtf(var + GN_EPS)) * gn_w[cj] + gn_b[cj];
        const float bon = BS[(size_t)m * 8 + h] + BS[((size_t)MT + m) * 8 + h];
        const GAS bf16* pr = proj + (size_t)m * D_IN;
        const float vc = bf2f(pr[C_V + cj]), vp = (t > 0) ? bf2f(pr[C_V + cj - D_IN]) : 0.f, vn = (t < L - 1) ? bf2f(pr[C_V + cj + D_IN]) : 0.f;
        const float v = vc + ts_mu[C_V + cj] * (vp - vc) + ts_mu[1536 + C_V + cj] * (vn - vc);
        const float za = bf2f(pr[C_ZA + cj]);
        MIX[(size_t)m * D + cj] = (bf16)f2bf((yn + bon * v) * silu_f(za));
    }
}

__device__ __forceinline__ void phase6(const Params& P, int gw, int NGW, int lane) {
    const GAS float* mod = (const GAS float*)(P.ws + WS_MOD); const GAS float* ln_post = (const GAS float*)P.in[I_LNPOST];
    for (int m = gw; m < MT; m += NGW) {
        const GAS f32x4* xr = (const GAS f32x4*)x_row(P, m) + lane; GAS f32x4* orow = (GAS f32x4*)(P.out + (size_t)m * D) + lane; const GAS float* gate = mod + mod_index(m) * 3072 + 2048;
        f32x4 o[4]; float ss = 0.f;
#pragma unroll
        for (int j = 0; j < 4; ++j) { o[j] = orow[64 * j]; ss += (o[j].x * o[j].x + o[j].y * o[j].y) + (o[j].z * o[j].z + o[j].w * o[j].w); }
        const float rstd = 1.0f / sqrtf(wave_sum(ss) * (1.0f / D) + NORM_EPS);
#pragma unroll
        for (int j = 0; j < 4; ++j) { const int col = 4 * (lane + 64 * j);
            const f32x4 g = *(const GAS f32x4*)(ln_post + col), gt = *(const GAS f32x4*)(gate + col);
            orow[64 * j] = xr[64 * j] + o[j] * rstd * g * gt; }
    }
}

constexpr int N_PHASES = 7;
__global__ void __launch_bounds__(NTHREADS, 2) fwd_kernel(Params P) {
    extern __shared__ __attribute__((aligned(16))) unsigned char lds_raw[];
    LAS unsigned char* lds = (LAS unsigned char*)lds_raw;
    cg::grid_group grid = cg::this_grid();
    const int tid = threadIdx.x, lane = tid & 63, wave = __builtin_amdgcn_readfirstlane(tid >> 6);
    const int G = gridDim.x, gw = blockIdx.x * NWAVES + wave, NGW = G * NWAVES;
    const int lo = P.ph_lo, hi = P.ph_hi;
#define IN(k) (lo <= (k) && (k) < hi)
#define SEAM(k) do { if (IN(k) && IN((k) + 1)) grid.sync(); } while (0)
#define PP(name) const Params* name = (const Params*)__builtin_amdgcn_kernarg_segment_ptr(); asm volatile("" : "+s"(name))
    if (IN(0)) { PP(q); phase0(*q, lds, gw, NGW, wave, lane); }
    SEAM(0);
    if (IN(1)) { PP(q); phase1(*q, gw, NGW, lane); }
    SEAM(1);
    if (IN(2)) { PP(q); unsigned char* ws = q->ws;
        pg8::Gemm g{(const pg8::bf16_t*)(ws + WS_H), (const pg8::bf16_t*)(ws + WS_WIN), MT, D_IN, D}; pg8::StaticOrder S; S.init(MT, D_IN, G, (int)blockIdx.x);
        pg8::EpiBf16 E{(pg8::bf16_t*)(ws + WS_PROJ), D_IN};
        pg8::gemm_phase<pg8::EpiBf16, pg8::StaticOrder, true, true>(lds, g, S, E); }
    SEAM(2);
    if (IN(3)) { PP(q); phase3(*q, lds); }
    SEAM(3);
    if (IN(4)) { PP(q); phase4(*q, gw, NGW, lane); }
    SEAM(4);
    if (IN(5)) { PP(q); unsigned char* ws = q->ws; float* out = q->out;
        pg8::Gemm g{(const pg8::bf16_t*)(ws + WS_H), (const pg8::bf16_t*)(ws + WS_WOUT), MT, D, D}; pg8::StaticOrder S; S.init(MT, D, G, (int)blockIdx.x);
        pg8::EpiF32 E{out, D};
        pg8::gemm_phase<pg8::EpiF32, pg8::StaticOrder, true, true>(lds, g, S, E); }
    SEAM(5);
    if (IN(6)) { PP(q); phase6(*q, gw, NGW, lane); }
#undef PP
#undef IN
#undef SEAM
}

#ifndef N_LAUNCHES
#define N_LAUNCHES 7
#endif
extern "C" void kernel_launch(void* const* d_in, const int* in_sizes, int n_in, void* d_out, int out_size, void* d_ws, size_t ws_size, hipStream_t stream) {
    static int grid = 0;
    if (grid == 0) {
        if (n_in != 26 || ws_size < WS_END) { fprintf(stderr, "kernel_launch: unexpected n_in %d / ws_size %zu (need %zu)\n", n_in, ws_size, (size_t)WS_END); grid = -1; return; }
        int dev = 0, cus = 0, per_cu = 0;
        hipGetDevice(&dev); hipDeviceGetAttribute(&cus, hipDeviceAttributeMultiprocessorCount, dev);
        if (hipFuncSetAttribute((const void*)fwd_kernel, hipFuncAttributeMaxDynamicSharedMemorySize, LDS_BYTES) != hipSuccess) { fprintf(stderr, "kernel_launch: hipFuncSetAttribute failed\n"); grid = -1; return; }
        if (hipOccupancyMaxActiveBlocksPerMultiprocessor(&per_cu, (const void*)fwd_kernel, NTHREADS, LDS_BYTES) != hipSuccess || per_cu < 1) { fprintf(stderr, "kernel_launch: occupancy query says %d\n", per_cu); per_cu = 1; }
        (void)hipGetLastError();
        grid = cus * 1;
        fprintf(stderr, "kernel_launch: cus %d per_cu %d grid %d\n", cus, per_cu, grid);
    }
    if (grid < 0) return;
    hipMemsetAsync((char*)d_ws + WS_CTL, 0, CTL_ZERO_BYTES, stream);
    Params p{};
    for (int i = 0; i < 26; ++i) p.in[i] = (const float*)d_in[i];
    p.out = (float*)d_out; p.ws = (unsigned char*)d_ws;
    if (N_LAUNCHES == 1) {
        p.ph_lo = 0; p.ph_hi = N_PHASES;
        void* args[] = {&p};
        hipError_t e = hipLaunchCooperativeKernel((const void*)fwd_kernel, dim3(grid), dim3(NTHREADS), args, LDS_BYTES, stream);
        if (e != hipSuccess) fprintf(stderr, "cooperative launch failed: %s (grid %d)\n", hipGetErrorString(e), grid);
    } else {
        for (int ph = 0; ph < N_PHASES; ++ph) { p.ph_lo = ph; p.ph_hi = ph + 1; hipLaunchKernelGGL(fwd_kernel, dim3(grid), dim3(NTHREADS), LDS_BYTES, stream, p); }
    }
}
```

```cpp
#include <hip/hip_runtime.h>
#include <cstdio>
#include <cstdint>
namespace pg8 {
#define PG8_LAS __attribute__((address_space(3)))
typedef unsigned short bf16_t;
typedef short bf16x8 __attribute__((ext_vector_type(8)));
typedef float f32x4 __attribute__((ext_vector_type(4)));
typedef unsigned u32x4 __attribute__((ext_vector_type(4)));
constexpr int BM = 256, BK = 64, HALF = 128, HTB = HALF * BK * 2  , STAGE_BYTES = 8 * HTB, NXCD = 8, WGM = 8;

__host__ __device__ __forceinline__ int lds_byte(int r, int c) { const int st = (r >> 4) * 2 + (c >> 5), rr = r & 15, cc = c & 31, ob = rr * 64 + cc * 2; return st * 1024 + (ob ^ (((ob >> 9) & 1) << 5)); }
__host__ __device__ __forceinline__ void stage_rc(int b, int& R, int& C) { const int st = b / 1024, sb = b % 1024, swz = sb ^ (((sb >> 9) & 1) << 5); R = (st >> 1) * 16 + swz / 64; C = (st & 1) * 32 + (swz % 64) / 2; }
__host__ __device__ __forceinline__ int perm32(int rho) { const int n = rho >> 4, i = rho & 15; return 8 * (i >> 2) + 4 * n + (i & 3); }

struct Unit { int pm, pn; };
struct Gemm { const bf16_t* A; const bf16_t* Bt; int M, N, K; };

struct StaticOrder {
    int nM, nN, nwg, G, c;
    __host__ __device__ void init(int M, int N, int G_, int c_) { nM = M / BM; nN = N / BM; nwg = nM * nN; G = G_; c = c_; }
    __host__ __device__ bool next(int i, Unit& u) const {
        const long L = (long)i * G + c; if (L >= nwg) return false;
        int wgid = (int)L; { const int q = nwg / NXCD, r = nwg % NXCD, xcd = wgid % NXCD, off = wgid / NXCD; wgid = (xcd < r ? xcd * (q + 1) : r * (q + 1) + (xcd - r) * q) + off; }
        const int nig = WGM * nN, gid = wgid / nig, fm = gid * WGM, gsz = (nM - fm) < WGM ? (nM - fm) : WGM;
        u.pm = fm + ((wgid % nig) % gsz); u.pn = (wgid % nig) / gsz; return true;
    }
    __device__ __forceinline__ void a_ready(const Unit&) const {}
    __device__ __forceinline__ void done(const Unit&, int) const {}
};
typedef float f32x2p __attribute__((ext_vector_type(2)));
typedef __bf16 bf16x2p __attribute__((ext_vector_type(2)));
__device__ __forceinline__ unsigned cvt_pk_bf16(float lo, float hi) { f32x2p v; v.x = lo; v.y = hi; return __builtin_bit_cast(unsigned, __builtin_convertvector(v, bf16x2p)); }
struct EpiBf16 {
    static constexpr bool PERM = true, AFTER_DRAIN = false;
    bf16_t* O; int ldc; int tanh_pn;
    __device__ __forceinline__ void operator()(const f32x4 (&acc)[2][2][4][2], const Unit& u, int wr, int wc, int fr, int fq) const {
        const int row0 = u.pm * BM + wr * 64 + fr, col0 = u.pn * BM + wc * 32 + 8 * fq;
#pragma unroll
        for (int ai = 0; ai < 2; ++ai)
#pragma unroll
            for (int m = 0; m < 4; ++m) { bf16_t* rowp = O + (size_t)(row0 + ai * HALF + m * 16) * ldc + col0;
#pragma unroll
                for (int bj = 0; bj < 2; ++bj) { f32x4 v0 = acc[ai][bj][m][0], v1 = acc[ai][bj][m][1];
                    if (bj == 0 && u.pn == tanh_pn) {
#pragma unroll
                        for (int j = 0; j < 4; ++j) { v0[j] = 1.0f - 2.0f * __builtin_amdgcn_rcpf(1.0f + __builtin_amdgcn_exp2f(2.88539008f * v0[j])); v1[j] = 1.0f - 2.0f * __builtin_amdgcn_rcpf(1.0f + __builtin_amdgcn_exp2f(2.88539008f * v1[j])); } }
                    u32x4 w; w.x = cvt_pk_bf16(v0[0], v0[1]); w.y = cvt_pk_bf16(v0[2], v0[3]); w.z = cvt_pk_bf16(v1[0], v1[1]); w.w = cvt_pk_bf16(v1[2], v1[3]);
                    *(u32x4*)(rowp + bj * HALF) = w; } }
    }
};
struct EpiF32 {
    static constexpr bool PERM = false, AFTER_DRAIN = false;
    float* C; int ldc;
    __device__ __forceinline__ void operator()(const f32x4 (&acc)[2][2][4][2], const Unit& u, int wr, int wc, int fr, int fq) const {
        const int row0 = u.pm * BM + wr * 64 + fr, col0 = u.pn * BM + wc * 32 + 4 * fq;
#pragma unroll
        for (int ai = 0; ai < 2; ++ai)
#pragma unroll
            for (int m = 0; m < 4; ++m) { float* rowp = C + (size_t)(row0 + ai * HALF + m * 16) * ldc + col0;
#pragma unroll
                for (int bj = 0; bj < 2; ++bj)
#pragma unroll
                    for (int n = 0; n < 2; ++n) *(f32x4*)(rowp + bj * HALF + n * 16) = acc[ai][bj][m][n]; }
    }
};
template <class Epi, class Sched, bool ALIGN_EPI = false, bool SP2 = false>
__device__ __forceinline__ void gemm_phase(PG8_LAS unsigned char* lds, const Gemm g, const Sched& S, const Epi& E) {
    const int tid = threadIdx.x, wid = __builtin_amdgcn_readfirstlane(tid >> 6), lane = tid & 63, wr = wid >> 2, wc = wid & 3, fr = lane & 15, fq = lane >> 4;
    const int K = g.K, nt = K / BK;
    unsigned voffA[2], voffB[2];
#pragma unroll
    for (int i = 0; i < 2; ++i) { int R, C; stage_rc(tid * 16 + i * 8192, R, C); const int Rb = Epi::PERM ? ((R & ~31) + perm32(R & 31)) : R;
        voffA[i] = (unsigned)(R * K + C) * 2u; voffB[i] = (unsigned)(Rb * K + C) * 2u; }
    const size_t kstep = (size_t)(BK * 2);
    const size_t hstep = (size_t)HALF * K * 2;
    const size_t tstep = 2 * hstep;
    const unsigned ldsw = (unsigned)wid * 1024u;
    const int aoff = lds_byte(wr * 64 + fr, fq * 8), boff = lds_byte(wc * 32 + fr, fq * 8);
#define PG8_SA(b, h) (((b) * 2 + (h)) * HTB)
#define PG8_SB(b, h) ((4 + (b) * 2 + (h)) * HTB)
#define PG8_STAGE(bufoff, gbase, voff) do { _Pragma("unroll") for (int _i = 0; _i < 2; ++_i) \
        __builtin_amdgcn_global_load_lds((const unsigned*)((const char*)(gbase) + (voff)[_i]), (PG8_LAS unsigned*)(lds + (bufoff) + ldsw + _i * 8192), 16, 0, 0); } while (0)
#define PG8_LDA(dst, b, h) do { _Pragma("unroll") for (int m = 0; m < 4; ++m) _Pragma("unroll") for (int k = 0; k < 2; ++k) dst[m][k] = *(const PG8_LAS bf16x8*)(lds + PG8_SA(b, h) + aoff + m * 2048 + k * 1024); } while (0)
#define PG8_LDB(dst, b, h) do { _Pragma("unroll") for (int n = 0; n < 2; ++n) _Pragma("unroll") for (int k = 0; k < 2; ++k) dst[n][k] = *(const PG8_LAS bf16x8*)(lds + PG8_SB(b, h) + boff + n * 2048 + k * 1024); } while (0)
#define PG8_MMA(ai, bj, At, Bt) do { __builtin_amdgcn_s_setprio(1); _Pragma("unroll") for (int m = 0; m < 4; ++m) _Pragma("unroll") for (int n = 0; n < 2; ++n) _Pragma("unroll") for (int k = 0; k < 2; ++k) \
        acc[ai][bj][m][n] = __builtin_amdgcn_mfma_f32_16x16x32_bf16(Bt[n][k], At[m][k], acc[ai][bj][m][n], 0, 0, 0); __builtin_amdgcn_s_setprio(0); } while (0)
#define PG8_WAIT_V(n) asm volatile("s_waitcnt vmcnt(" #n ")" ::: "memory")
#define PG8_WAIT_L(n) asm volatile("s_waitcnt lgkmcnt(" #n ")" ::: "memory")
#define PG8_BAR __builtin_amdgcn_s_barrier()
#define PG8_SCHED __builtin_amdgcn_sched_barrier(0)
    Unit cur, nxt; int ui = 0;
    if (!S.next(0, cur)) return;
    f32x4 acc[2][2][4][2];
#pragma unroll
    for (int a = 0; a < 2; ++a)
#pragma unroll
        for (int b = 0; b < 2; ++b)
#pragma unroll
            for (int m = 0; m < 4; ++m)
#pragma unroll
                for (int n = 0; n < 2; ++n) acc[a][b][m][n] = (f32x4){0.f, 0.f, 0.f, 0.f};
    bf16x8 At[4][2], B0[2][2], B1[2][2];
    const char* cA = (const char*)g.A + (size_t)cur.pm * tstep; const char* cB = (const char*)g.Bt + (size_t)cur.pn * tstep;
    S.a_ready(cur);
    if constexpr (SP2) {
        PG8_STAGE(PG8_SB(0, 0), cB, voffB); PG8_STAGE(PG8_SB(0, 1), cB + hstep, voffB); PG8_STAGE(PG8_SA(0, 0), cA, voffA); PG8_STAGE(PG8_SA(0, 1), cA + hstep, voffA);
        if (wr == 1) PG8_BAR;
        PG8_WAIT_V(2); PG8_BAR;
        PG8_STAGE(PG8_SB(1, 0), cB + kstep, voffB); PG8_STAGE(PG8_SA(1, 0), cA + kstep, voffA); PG8_STAGE(PG8_SB(1, 1), cB + hstep + kstep, voffB);
        PG8_WAIT_V(6); PG8_BAR;
    } else {
        PG8_STAGE(PG8_SB(0, 0), cB, voffB); PG8_STAGE(PG8_SA(0, 0), cA, voffA); PG8_STAGE(PG8_SB(0, 1), cB + hstep, voffB); PG8_STAGE(PG8_SA(0, 1), cA + hstep, voffA);
        if (wr == 1) PG8_BAR;
        PG8_WAIT_V(4); PG8_BAR;
        PG8_STAGE(PG8_SB(1, 0), cB + kstep, voffB); PG8_STAGE(PG8_SA(1, 0), cA + kstep, voffA); PG8_STAGE(PG8_SB(1, 1), cB + hstep + kstep, voffB);
        PG8_WAIT_V(6); PG8_BAR;
    }
    for (;;) {
        const bool has_next = S.next(ui + 1, nxt);
        const char* nA = has_next ? (const char*)g.A + (size_t)nxt.pm * tstep : cA; const char* nB = has_next ? (const char*)g.Bt + (size_t)nxt.pn * tstep : cB;
        for (int t = 0; t < nt; t += 2) {
            const bool last = (t == nt - 2);
            const char* a1 = cA + (size_t)(t + 1) * kstep;
            const char* a2 = last ? nA : cA + (size_t)(t + 2) * kstep; const char* b2 = last ? nB : cB + (size_t)(t + 2) * kstep;
            const char* a3 = a2 + kstep; const char* b3 = b2 + kstep;
            if (last && has_next) S.a_ready(nxt);
            if constexpr (SP2) {
            PG8_LDB(B0, 0, 0); PG8_LDB(B1, 0, 1); PG8_SCHED; PG8_LDA(At, 0, 0); PG8_STAGE(PG8_SA(1, 1), a1 + hstep, voffA);
            PG8_WAIT_V(8); PG8_WAIT_L(0); PG8_BAR; PG8_MMA(0, 0, At, B0); PG8_MMA(0, 1, At, B1); PG8_BAR; PG8_SCHED;
            PG8_LDA(At, 0, 1); PG8_STAGE(PG8_SB(0, 0), b2, voffB); PG8_STAGE(PG8_SB(0, 1), b2 + hstep, voffB); PG8_STAGE(PG8_SA(0, 0), a2, voffA);
            PG8_WAIT_V(8); PG8_WAIT_L(0); PG8_BAR; PG8_MMA(1, 0, At, B0); PG8_MMA(1, 1, At, B1); PG8_BAR; PG8_SCHED;
            PG8_LDB(B0, 1, 0); PG8_LDB(B1, 1, 1); PG8_SCHED; PG8_LDA(At, 1, 0); PG8_STAGE(PG8_SA(0, 1), a2 + hstep, voffA);
            PG8_WAIT_V(8); PG8_WAIT_L(0); PG8_BAR; PG8_MMA(0, 0, At, B0); PG8_MMA(0, 1, At, B1); PG8_BAR; PG8_SCHED;
            PG8_LDA(At, 1, 1); PG8_STAGE(PG8_SB(1, 0), b3, voffB); PG8_STAGE(PG8_SB(1, 1), b3 + hstep, voffB); PG8_STAGE(PG8_SA(1, 0), a3, voffA);
            PG8_WAIT_V(8); PG8_WAIT_L(0); PG8_BAR; PG8_MMA(1, 0, At, B0); PG8_MMA(1, 1, At, B1); PG8_BAR; PG8_SCHED;
            } else {
            PG8_LDB(B0, 0, 0); PG8_SCHED; PG8_LDA(At, 0, 0); PG8_STAGE(PG8_SA(1, 1), a1 + hstep, voffA);
            PG8_WAIT_L(8); PG8_BAR; PG8_WAIT_L(0); PG8_MMA(0, 0, At, B0); PG8_BAR; PG8_SCHED;
            PG8_LDB(B1, 0, 1); PG8_STAGE(PG8_SB(0, 0), b2, voffB);
            PG8_BAR; PG8_WAIT_L(0); PG8_MMA(0, 1, At, B1); PG8_BAR;
            PG8_LDA(At, 0, 1); PG8_STAGE(PG8_SA(0, 0), a2, voffA);
            PG8_BAR; PG8_WAIT_L(0); PG8_MMA(1, 0, At, B0); PG8_BAR; PG8_SCHED;
            PG8_STAGE(PG8_SB(0, 1), b2 + hstep, voffB);
            PG8_WAIT_V(6); PG8_BAR; PG8_MMA(1, 1, At, B1); PG8_BAR;
            PG8_LDB(B0, 1, 0); PG8_SCHED; PG8_LDA(At, 1, 0); PG8_STAGE(PG8_SA(0, 1), a2 + hstep, voffA);
            PG8_WAIT_L(8); PG8_BAR; PG8_WAIT_L(0); PG8_MMA(0, 0, At, B0); PG8_BAR; PG8_SCHED;
            PG8_LDB(B1, 1, 1); PG8_STAGE(PG8_SB(1, 0), b3, voffB);
            PG8_BAR; PG8_WAIT_L(0); PG8_MMA(0, 1, At, B1); PG8_BAR;
            PG8_LDA(At, 1, 1); PG8_STAGE(PG8_SA(1, 0), a3, voffA);
            PG8_BAR; PG8_WAIT_L(0); PG8_MMA(1, 0, At, B0); PG8_BAR; PG8_SCHED;
            PG8_STAGE(PG8_SB(1, 1), b3 + hstep, voffB);
            PG8_WAIT_V(6); PG8_BAR; PG8_MMA(1, 1, At, B1); PG8_BAR;
            }
        }
        if constexpr (ALIGN_EPI) { if (wr == 0) PG8_BAR; }
        if constexpr (!Epi::AFTER_DRAIN) { E(acc, cur, wr, wc, fr, fq); S.done(cur, ui); }
        if (!has_next) break;
#pragma unroll
        for (int a = 0; a < 2; ++a)
#pragma unroll
            for (int b = 0; b < 2; ++b)
#pragma unroll
                for (int m = 0; m < 4; ++m)
#pragma unroll
                    for (int n = 0; n < 2; ++n) acc[a][b][m][n] = (f32x4){0.f, 0.f, 0.f, 0.f};
        cur = nxt; cA = nA; cB = nB; ++ui;
        if constexpr (ALIGN_EPI) { if (wr == 1) PG8_BAR; }
    }
    PG8_WAIT_V(0);
    if constexpr (!ALIGN_EPI) { if (wr == 0) PG8_BAR; }
    PG8_BAR;
    if constexpr (Epi::AFTER_DRAIN) { E.fused(acc, cur, wr, wc, fr, fq, lds, wid, lane); S.done(cur, ui); }
#undef PG8_SA
#undef PG8_SB
#undef PG8_STAGE
#undef PG8_LDA
#undef PG8_LDB
#undef PG8_MMA
#undef PG8_WAIT_V
#undef PG8_WAIT_L
#undef PG8_BAR
#undef PG8_SCHED
}
}

constexpr int D = 1024, M_CTX = 32 * 256, M_LAT = 8 * 4096, MT = M_CTX + M_LAT;
constexpr int L_CTX = 256, L_LAT = 4096, NB_CTX = 32, NB_LAT = 8;
constexpr int D_IN = 3840, D_A = 512, NH = 8, HD = 64;
constexpr int C_R = 0, C_K = 512, C_V = 1024, C_ZA = 1536, C_WD = 2048, C_AD = 2176, C_U = 2304, C_VB = 2816, C_ZB = 3328;
constexpr float NORM_EPS = 1e-6f, GN_EPS = 6.4e-4f;
constexpr size_t STATE_ELEMS = (size_t)NB_CTX * NH * HD * HD;

constexpr size_t MiB = 1u << 20;
constexpr size_t WS_CTL = 0, CTL_ZERO_BYTES = 192 * 1024;
constexpr size_t CW_QUEUE = 15 * 1024;
constexpr size_t CW_R1 = 16 * 1024, CW_RALL = 18 * 1024;
constexpr size_t WS_MOD = 64 * 1024;
constexpr size_t WS_WIN = 1 * MiB;
constexpr size_t WS_WOUT = 9 * MiB;
constexpr size_t WS_WSB = 11 * MiB;
constexpr size_t WS_BS = 12 * MiB;
constexpr size_t WS_H = 16 * MiB;
constexpr size_t WS_PROJ = 96 * MiB;
constexpr size_t WS_OUTB = WS_PROJ;
constexpr size_t WS_G = WS_PROJ + (size_t)MT * D_IN * 2;
constexpr size_t WS_HMID = WS_G + (size_t)128 * 2048 * 64 * 2;
constexpr size_t WS_CORR = WS_HMID + (size_t)128 * 4096 * 2;
constexpr size_t WS_END = WS_CORR + (size_t)M_LAT * 512 * 2;
static_assert(WS_WIN + (size_t)D_IN * D * 2 <= WS_WOUT && WS_BS + (size_t)2 * MT * 8 * 4 <= WS_H && WS_H + (size_t)MT * D * 2 <= WS_PROJ, "ws map");

constexpr int LDS_BYTES = 163840;
constexpr int NWAVES = 8, NTHREADS = 512;

#define LAS __attribute__((address_space(3)))
#define GAS __attribute__((address_space(1)))
typedef unsigned short bf16;
typedef float f32x4 __attribute__((ext_vector_type(4)));
typedef short bf16x8 __attribute__((ext_vector_type(8)));
typedef unsigned u32x4v __attribute__((ext_vector_type(4)));
typedef unsigned u32x2v __attribute__((ext_vector_type(2)));

__device__ __forceinline__ float bf2f(unsigned b) { return __uint_as_float(b << 16); }
__device__ __forceinline__ unsigned f2bf(float f) { unsigned u = __float_as_uint(f); return (u + 0x7fffu + ((u >> 16) & 1u)) >> 16; }
__device__ __forceinline__ unsigned pk2(float lo, float hi) { return f2bf(lo) | (f2bf(hi) << 16); }
template <int CTRL> __device__ __forceinline__ float dpp_f(float v) { return __int_as_float(__builtin_amdgcn_update_dpp(0, __float_as_int(v), CTRL, 0xf, 0xf, true)); }
__device__ __forceinline__ float quad_sum4(float v) { v += dpp_f<0xB1>(v); v += dpp_f<0x4E>(v); return v; }
__device__ __forceinline__ float wave_sum(float v) {
    v += dpp_f<0xB1>(v); v += dpp_f<0x4E>(v);
    v += dpp_f<0x141>(v); v += dpp_f<0x140>(v);
    v += __int_as_float(__builtin_amdgcn_ds_swizzle(__float_as_int(v), 0x401F));
    return __int_as_float(__builtin_amdgcn_readlane(__float_as_int(v), 0)) + __int_as_float(__builtin_amdgcn_readlane(__float_as_int(v), 32));
}
__device__ __forceinline__ float silu_f(float x) { return x / (1.0f + __expf(-x)); }
__device__ __forceinline__ float sigmoid_f(float x) { return 1.0f / (1.0f + __expf(-x)); }

struct Params { const float* in[26]; float* out; unsigned char* ws; int ph_lo, ph_hi; };

enum { I_XP = 0, I_XS, I_C, I_SF, I_SB, I_CCTX, I_LNPRE, I_LNPOST, I_WMOD, I_BMOD, I_WIN, I_TSMU, I_W0, I_WUP, I_A0, I_AUP, I_KK, I_KA, I_RK, I_GNW, I_GNB, I_SLG, I_SLB, I_WS, I_BSS, I_WOUT };

__device__ __forceinline__ void transpose_item(const float* W, int K, int N, bf16* WT, LAS float* scr, int item, int lane) {
    const int nblk = N / 32, kb = item / nblk, nb = item % nblk, k0 = 64 * kb, n0 = 32 * nb;
    float tv[32];
#pragma unroll
    for (int i = 0; i < 32; ++i) tv[i] = ((const GAS float*)W)[(size_t)(k0 + 2 * i + (lane >> 5)) * N + n0 + (lane & 31)];
#pragma unroll
    for (int i = 0; i < 32; ++i) scr[(2 * i + (lane >> 5)) * 33 + (lane & 31)] = tv[i];
    asm volatile("s_waitcnt lgkmcnt(0)" ::: "memory");
    const int c = lane & 7;
#pragma unroll
    for (int j = 0; j < 4; ++j) { const int n = (lane >> 3) + 8 * j; const LAS float* s = scr + (8 * c) * 33 + n;
        u32x4v o; o.x = pk2(s[0 * 33], s[1 * 33]); o.y = pk2(s[2 * 33], s[3 * 33]); o.z = pk2(s[4 * 33], s[5 * 33]); o.w = pk2(s[6 * 33], s[7 * 33]);
        *(u32x4v*)(WT + (size_t)(n0 + n) * K + k0 + 8 * c) = o; }
    asm volatile("s_waitcnt lgkmcnt(0)" ::: "memory");
}

__device__ __forceinline__ void phase0(const Params& P, LAS unsigned char* lds, int gw, int NGW, int wave, int lane) {
    unsigned char* ws = P.ws;
    float* mod = (float*)(ws + WS_MOD);
    const float* w_mod = P.in[I_WMOD]; const float* b_mod = P.in[I_BMOD]; const float* cc = P.in[I_C]; const float* cctx = P.in[I_CCTX];
    if (blockIdx.x < 96 && gridDim.x >= 96) {
        const int cgp = blockIdx.x % 12, rg = blockIdx.x / 12, col = cgp * 256 + lane * 4, r0 = rg * 128 + wave * 16;
        f32x4 acc[9];
#pragma unroll
        for (int v = 0; v < 9; ++v) acc[v] = (f32x4){0.f, 0.f, 0.f, 0.f};
        f32x4 w[16];
#pragma unroll
        for (int i = 0; i < 16; ++i) w[i] = *(const GAS f32x4*)((const GAS float*)w_mod + (size_t)(r0 + i) * 3072 + col);
#pragma unroll
        for (int i = 0; i < 16; ++i) {
#pragma unroll
            for (int v = 0; v < 9; ++v) { const float cv = (v == 0) ? cctx[r0 + i] : cc[(v - 1) * 1024 + r0 + i]; acc[v] += silu_f(cv) * w[i]; }
        }
        LAS f32x4* red = (LAS f32x4*)lds;
#pragma unroll
        for (int v = 0; v < 9; ++v) red[(wave * 9 + v) * 64 + lane] = acc[v];
        __syncthreads();
        for (int idx = wave * 64 + lane; idx < 9 * 64; idx += 512) {
            f32x4 s = red[idx];
#pragma unroll
            for (int w2 = 1; w2 < 8; ++w2) s += red[w2 * 576 + idx];
            const int v = idx >> 6, l = idx & 63, c2 = cgp * 256 + l * 4;
            if (rg == 0) s += *(const f32x4*)(b_mod + c2);
#pragma unroll
            for (int e = 0; e < 4; ++e) atomicAdd(mod + v * 3072 + c2 + e, s[e]);
        }
        __syncthreads();
    } else if (gridDim.x < 96) {
        for (int task = gw; task < 12 * 64; task += NGW) {
            const int cgp = task % 12, rs = task / 12, col = cgp * 256 + lane * 4;
            f32x4 acc[9];
#pragma unroll
            for (int v = 0; v < 9; ++v) acc[v] = (f32x4){0.f, 0.f, 0.f, 0.f};
            for (int i = rs * 16; i < rs * 16 + 16; ++i) { const f32x4 w = *(const GAS f32x4*)((const GAS float*)w_mod + (size_t)i * 3072 + col);
#pragma unroll
                for (int v = 0; v < 9; ++v) { const float cv = (v == 0) ? cctx[i] : cc[(v - 1) * 1024 + i]; acc[v] += silu_f(cv) * w; } }
            if (rs == 0) { const f32x4 b = *(const f32x4*)(b_mod + col);
#pragma unroll
                for (int v = 0; v < 9; ++v) acc[v] += b; }
#pragma unroll
            for (int v = 0; v < 9; ++v)
#pragma unroll
                for (int e = 0; e < 4; ++e) atomicAdd(mod + v * 3072 + col + e, acc[v][e]);
        }
    }
}

__device__ __forceinline__ void weight_copies(const Params& P, LAS unsigned char* lds, int gw, int NGW, int wave, int lane) {
    unsigned char* ws = P.ws;
    LAS float* scr = (LAS float*)(lds + wave * 16384);
    constexpr int I_1 = (D / 64) * (D_IN / 32), I_2 = (D / 64) * (D / 32);
    for (int it = gw; it < I_1 + I_2; it += NGW) {
        if (it < I_1) transpose_item(P.in[I_WIN], D, D_IN, (bf16*)(ws + WS_WIN), scr, it, lane);
        else transpose_item(P.in[I_WOUT], D, D, (bf16*)(ws + WS_WOUT), scr, it - I_1, lane);
    }
    { const float* w_s = P.in[I_WS]; bf16* wsb = (bf16*)(ws + WS_WSB);
      for (int i = gw * 64 + lane; i < 8 * 128 * 128 / 4; i += NGW * 64) { const f32x4 v = *(const f32x4*)(w_s + (size_t)i * 4); u32x2v o; o.x = pk2(v[0], v[1]); o.y = pk2(v[2], v[3]); *(u32x2v*)(wsb + (size_t)i * 4) = o; } }
}


__device__ __forceinline__ const GAS float* x_row(const Params& P, int m) { return (const GAS float*)(m < M_CTX ? P.in[I_XP] + (size_t)m * D : P.in[I_XS] + (size_t)(m - M_CTX) * D); }
__device__ __forceinline__ int mod_index(int m) { return m < M_CTX ? 0 : 1 + (m - M_CTX) / L_LAT; }

__device__ __forceinline__ void phase1(const Params& P, int gw, int NGW, int lane) {
    const GAS float* mod = (const GAS float*)(P.ws + WS_MOD); const GAS float* ln_pre = (const GAS float*)P.in[I_LNPRE]; GAS bf16* H = (GAS bf16*)(P.ws + WS_H);
#pragma unroll 1
    for (int seg = 0; seg < 9; ++seg) {
        const int m_lo = (seg == 0) ? 0 : M_CTX + (seg - 1) * L_LAT, m_hi = (seg == 0) ? M_CTX : m_lo + L_LAT;
        const GAS float* shift = mod + seg * 3072; const GAS float* scale = shift + 1024;
        f32x4 gs[4], sh[4];
#pragma unroll
        for (int j = 0; j < 4; ++j) { const int col = 4 * (lane + 64 * j); gs[j] = *(const GAS f32x4*)(ln_pre + col) * (1.0f + *(const GAS f32x4*)(scale + col)); sh[j] = *(const GAS f32x4*)(shift + col); }
        for (int m = m_lo + gw; m < m_hi; m += NGW) {
            const GAS f32x4* xr = (const GAS f32x4*)x_row(P, m) + lane;
            f32x4 v[4]; float ss = 0.f;
#pragma unroll
            for (int j = 0; j < 4; ++j) { v[j] = xr[64 * j]; ss += (v[j].x * v[j].x + v[j].y * v[j].y) + (v[j].z * v[j].z + v[j].w * v[j].w); }
            const float rstd = 1.0f / sqrtf(wave_sum(ss) * (1.0f / D) + NORM_EPS);
            GAS u32x2v* o8 = (GAS u32x2v*)(H + (size_t)m * D) + lane;
#pragma unroll
            for (int j = 0; j < 4; ++j) { const f32x4 o = v[j] * rstd * gs[j] + sh[j]; u32x2v w; w.x = pk2(o.x, o.y); w.y = pk2(o.z, o.w); o8[64 * j] = w; }
        }
    }
}

constexpr int CH_RKV_LD = 200, CH_TW_LD = 72, CH_I1_LD = 72, CH_I2_LD = 40, CH_G_LD = 40;
constexpr int CH_RKV = 0, CH_TW = 26400, CH_AD = 35616, CH_WUPT = 44832, CH_AUPT = 54048, CH_IMG = 63264, CH_IMG_STRIDE = 30720;
constexpr int CH_GRAM_STRIDE = 17920;
constexpr int CH_HF = 124704, CH_N2 = 141088, CH_EC = 141344, CH_BPART = 141856, CH_KTAB = 142880, CH_HF2 = 143648, CH_END = 160032;
static_assert(2 * CH_GRAM_STRIDE <= CH_WUPT && CH_IMG + 2 * CH_IMG_STRIDE == CH_HF && CH_END <= LDS_BYTES - 64, "chain LDS map");

typedef unsigned short us4 __attribute__((ext_vector_type(4)));
#define MFMA16(a, b, c) __builtin_amdgcn_mfma_f32_16x16x32_bf16((a), (b), (c), 0, 0, 0)
__device__ __forceinline__ bf16x8 ldfrag(const LAS bf16* img, int ld, int row0, int k0, int lane) { return *(const LAS bf16x8*)(img + (row0 + (lane & 15)) * ld + k0 + 8 * (lane >> 4)); }
typedef float f32x2c __attribute__((ext_vector_type(2)));
typedef __bf16 bf16x2c __attribute__((ext_vector_type(2)));
__device__ __forceinline__ unsigned cvtpk(float lo, float hi) { f32x2c v; v.x = lo; v.y = hi; return __builtin_bit_cast(unsigned, __builtin_convertvector(v, bf16x2c)); }
__device__ __forceinline__ void st_nm(LAS bf16* img, int ld, int n0, int m0, f32x4 c, int lane) {
    u32x2v o; o.x = cvtpk(c[0], c[1]); o.y = cvtpk(c[2], c[3]); *(LAS u32x2v*)(img + (n0 + (lane & 15)) * ld + m0 + 4 * (lane >> 4)) = o; }
__device__ __forceinline__ void st_mn(LAS bf16* img, int ld, int m0, int n0, f32x4 c, int lane) {
#pragma unroll
    for (int e = 0; e < 4; e += 2) { const unsigned w = cvtpk(c[e], c[e + 1]); LAS bf16* p = img + (m0 + 4 * (lane >> 4) + e) * ld + n0 + (lane & 15); p[0] = (bf16)(w & 0xffffu); p[ld] = (bf16)(w >> 16); } }
__device__ __forceinline__ float fast_sigmoid(float x) { return __builtin_amdgcn_rcpf(1.0f + __builtin_amdgcn_exp2f(-1.44269504f * x)); }
__device__ __forceinline__ float fast_tanh(float x) { return 1.0f - 2.0f * __builtin_amdgcn_rcpf(1.0f + __builtin_amdgcn_exp2f(2.88539008f * x)); }
__device__ __forceinline__ float row16_sum(float v) { v += dpp_f<0xB1>(v); v += dpp_f<0x4E>(v); v += dpp_f<0x141>(v); v += dpp_f<0x140>(v); return v; }
__device__ __forceinline__ float oct_sum(float v) { v += dpp_f<0xB1>(v); v += dpp_f<0x4E>(v); v += dpp_f<0x141>(v); return v; }

typedef short bf16x4 __attribute__((ext_vector_type(4)));
#define MF16(a, b, c) __builtin_amdgcn_mfma_f32_16x16x16bf16_1k((a), (b), (c), 0, 0, 0)
__device__ __forceinline__ bf16x4 frag4(f32x4 c) { u32x2v o; o.x = cvtpk(c[0], c[1]); o.y = cvtpk(c[2], c[3]); return __builtin_bit_cast(bf16x4, o); }
__device__ __forceinline__ bf16x4 ldfrag4(const LAS bf16* img, int ld, int row0, int k0, int lane) { return *(const LAS bf16x4*)(img + (row0 + (lane & 15)) * ld + k0 + 4 * (lane >> 4)); }
typedef short s16x4c __attribute__((ext_vector_type(4)));
__device__ __forceinline__ bf16x8 ldfrag_tr(const LAS bf16* img, int ld, int col0, int k0, int lane) {
    const LAS bf16* p = img + (k0 + 8 * (lane >> 4) + ((lane & 15) >> 2)) * ld + col0 + 4 * (lane & 3);
    const s16x4c lo = __builtin_amdgcn_ds_read_tr16_b64_v4i16((LAS s16x4c*)p), hi = __builtin_amdgcn_ds_read_tr16_b64_v4i16((LAS s16x4c*)(p + 4 * ld));
    return (bf16x8){lo[0], lo[1], lo[2], lo[3], hi[0], hi[1], hi[2], hi[3]}; }
__device__ __forceinline__ bf16x4 ldfrag4_tr(const LAS bf16* img, int ld, int col0, int k0, int lane) {
    const LAS bf16* p = img + (k0 + 4 * (lane >> 4) + ((lane & 15) >> 2)) * ld + col0 + 4 * (lane & 3);
    return __builtin_bit_cast(bf16x4, __builtin_amdgcn_ds_read_tr16_b64_v4i16((LAS s16x4c*)p)); }
#define OPQ(v) asm volatile("" : "+v"(v))
struct RawRegs { u32x4v v[6]; };
__device__ __forceinline__ void chain_prefetch(RawRegs& R, const GAS bf16* proj, int m0, int L, int h, int dir, int ss, int tid, int p0) {
    OPQ(tid);
    const int qm = tid >> 3, pc = tid & 7, p = p0 + ss * 64 + qm, t = dir ? (L - 1 - p) : p;
    const GAS bf16* row = proj + (size_t)(m0 + t) * D_IN;
#pragma unroll
    for (int x = 0; x < 3; ++x) R.v[x] = *(const GAS u32x4v*)(row + x * 512 + h * 64 + pc * 8);
    R.v[4] = *(const GAS u32x4v*)(row + C_WD + dir * 64 + pc * 8);
    R.v[5] = *(const GAS u32x4v*)(row + C_AD + dir * 64 + pc * 8);
    u32x4v hv = (u32x4v){0u, 0u, 0u, 0u};
    if (tid < 48) { const int hi = tid >= 24, rem = hi ? tid - 24 : tid, x = rem >> 3, pc2 = rem & 7, ph = hi ? p0 + ss * 64 + 64 : p0 + ss * 64 - 1;
        if (ph >= 0 && ph < L) { const int th = dir ? (L - 1 - ph) : ph; hv = *(const GAS u32x4v*)(proj + (size_t)(m0 + th) * D_IN + x * 512 + h * 64 + pc2 * 8); } }
    R.v[3] = hv;
}
__device__ __forceinline__ void chain_stage_raw(const RawRegs& R, LAS unsigned char* lds, int tid) {
    OPQ(tid);
    const int qm = tid >> 3, pc = tid & 7;
#pragma unroll
    for (int x = 0; x < 3; ++x) *(LAS u32x4v*)(lds + CH_RKV + ((qm + 1) * CH_RKV_LD + x * 64 + pc * 8) * 2) = R.v[x];
    if (tid < 48) { const int hi = tid >= 24, rem = hi ? tid - 24 : tid, x = rem >> 3, pc2 = rem & 7;
        *(LAS u32x4v*)(lds + CH_RKV + ((hi ? 65 : 0) * CH_RKV_LD + x * 64 + pc2 * 8) * 2) = R.v[3]; }
    *(LAS u32x4v*)(lds + CH_TW + (qm * CH_TW_LD + pc * 8) * 2) = R.v[4];
    *(LAS u32x4v*)(lds + CH_AD + (qm * CH_TW_LD + pc * 8) * 2) = R.v[5];
}

__device__ __forceinline__ void do_chain(const Params& P, LAS unsigned char* lds, int m0, int L, int h, int dir, const float* s0, float* sfin, int p0, int npt, int mode, int chain) {
    const int tid = threadIdx.x, lane0 = tid & 63, wave = __builtin_amdgcn_readfirstlane(tid >> 6);
    const int grp = wave >> 2, cc = wave & 3;
#define STAGE_LANE() int ln_ = lane0; OPQ(ln_); const int lane = ln_, lr = lane & 15, lg = lane >> 4, c = 16 * cc + lr, vcol = c; (void)lr; (void)lg; (void)c; (void)vcol
    const GAS bf16* proj = (const GAS bf16*)(P.ws + WS_PROJ);
    GAS bf16* YD = (GAS bf16*)P.out; GAS float* BS = (GAS float*)(P.ws + WS_BS);
    const int nss = npt / 64;
    const int cj = h * 64 + 16 * cc + (lane0 & 15);
    const GAS float* ts_mu = (const GAS float*)P.in[I_TSMU];
    const float mlo_r = ts_mu[(dir ? 1536 : 0) + C_R + cj], mhi_r = ts_mu[(dir ? 0 : 1536) + C_R + cj];
    const float mlo_k = ts_mu[(dir ? 1536 : 0) + C_K + cj], mhi_k = ts_mu[(dir ? 0 : 1536) + C_K + cj];
    const float mlo_v = ts_mu[(dir ? 1536 : 0) + C_V + cj], mhi_v = ts_mu[(dir ? 0 : 1536) + C_V + cj];
    const float mc_r = 1.0f - mlo_r - mhi_r, mc_k = 1.0f - mlo_k - mhi_k, mc_v = 1.0f - mlo_v - mhi_v;
    const float w0c = -1.44269504f * ((const GAS float*)P.in[I_W0])[dir * 512 + cj], a0c = -1.44269504f * ((const GAS float*)P.in[I_A0])[dir * 512 + cj];
    const float kkc = ((const GAS float*)P.in[I_KK])[dir * 512 + cj], kac = ((const GAS float*)P.in[I_KA])[dir * 512 + cj], rkc = ((const GAS float*)P.in[I_RK])[dir * 512 + cj], kac1 = 1.0f - kac;
    LAS float* ktab = (LAS float*)(lds + CH_KTAB);
    if (tid < 64) { const int c8 = h * 64 + tid; ktab[tid] = ((const GAS float*)P.in[I_KK])[dir * 512 + c8]; ktab[64 + tid] = ts_mu[(dir ? 1536 : 0) + C_K + c8]; ktab[128 + tid] = ts_mu[(dir ? 0 : 1536) + C_K + c8]; }
    { LAS bf16* wupt = (LAS bf16*)(lds + CH_WUPT); LAS bf16* aupt = (LAS bf16*)(lds + CH_AUPT);
      const GAS float* wu = (const GAS float*)P.in[I_WUP] + (size_t)dir * 64 * 512 + h * 64; const GAS float* au = (const GAS float*)P.in[I_AUP] + (size_t)dir * 64 * 512 + h * 64;
#pragma unroll 1
      for (int kb = 0; kb < 2; ++kb) { float wv[4], av[4];
#pragma unroll
          for (int k = 0; k < 4; ++k) { const int idx = tid + 512 * (4 * kb + k), i = idx >> 6, c2 = idx & 63; wv[k] = wu[(size_t)i * 512 + c2]; av[k] = au[(size_t)i * 512 + c2]; }
#pragma unroll
          for (int k = 0; k < 4; ++k) { const int idx = tid + 512 * (4 * kb + k), i = idx >> 6, c2 = idx & 63; wupt[c2 * CH_TW_LD + i] = (bf16)f2bf(wv[k]); aupt[c2 * CH_TW_LD + i] = (bf16)f2bf(av[k]); } } }
    if (grp == 0) { STAGE_LANE(); LAS f32x4* hf = (LAS f32x4*)(lds + CH_HF) + cc * 256 + lane;
#pragma unroll
        for (int mt = 0; mt < 4; ++mt) hf[64 * mt] = s0 ? *(const f32x4*)(s0 + vcol * 64 + 16 * mt + 4 * lg) : (f32x4){0.f, 0.f, 0.f, 0.f};
        if (mode == 2) { LAS f32x4* hf2 = (LAS f32x4*)(lds + CH_HF2) + cc * 256 + lane;
#pragma unroll
            for (int mt = 0; mt < 4; ++mt) { f32x4 id;
#pragma unroll
                for (int e = 0; e < 4; ++e) id[e] = (mt == cc && lr == 4 * lg + e) ? 1.f : 0.f;
                hf2[64 * mt] = id; } }
    }
    RawRegs RR;
    chain_prefetch(RR, proj, m0, L, h, dir, 0, tid, p0);
    chain_stage_raw(RR, lds, tid);
    __syncthreads();
    LAS unsigned char* img = lds + CH_IMG + grp * CH_IMG_STRIDE;
    LAS bf16* I2_A = (LAS bf16*)(img), *I2_B = (LAS bf16*)(img + 5120), *I2_K = (LAS bf16*)(img + 10240), *I2_V = (LAS bf16*)(img + 15360), *I2_R = (LAS bf16*)(img + 20480), *I2_Q = (LAS bf16*)(img + 25600);
    LAS unsigned char* gram = lds + grp * CH_GRAM_STRIDE;
    LAS bf16* GX = (LAS bf16*)(gram), *GXT = (LAS bf16*)(gram + 2560), *GYT = (LAS bf16*)(gram + 5120), *GT = (LAS bf16*)(gram + 7680);
    LAS bf16* GLAK = (LAS bf16*)(gram + 10240), *GMRB = (LAS bf16*)(gram + 12800), *GMRK = (LAS bf16*)(gram + 15360);
    LAS float* n2s = (LAS float*)(lds + CH_N2); LAS float* ecs = (LAS float*)(lds + CH_EC); LAS float* bpart = (LAS float*)(lds + CH_BPART);
    const LAS bf16* rkv = (const LAS bf16*)(lds + CH_RKV);
    const f32x4 z4 = (f32x4){0.f, 0.f, 0.f, 0.f};

    for (int ss = 0; ss < nss; ++ss) {
        { STAGE_LANE(); const int tk = lane >> 3, cg = lane & 7, q = 8 * wave + tk + 1;
          const LAS bf16* kp = rkv + q * CH_RKV_LD + 64 + 8 * cg;
          const u32x4v lo = *(const LAS u32x4v*)(kp - CH_RKV_LD), mi = *(const LAS u32x4v*)kp, hi = *(const LAS u32x4v*)(kp + CH_RKV_LD);
          float s = 0.f;
#pragma unroll
          for (int hh2 = 0; hh2 < 2; ++hh2) { const f32x4 ckk = *(const LAS f32x4*)(ktab + 8 * cg + 4 * hh2), clo = *(const LAS f32x4*)(ktab + 64 + 8 * cg + 4 * hh2), chi = *(const LAS f32x4*)(ktab + 128 + 8 * cg + 4 * hh2);
#pragma unroll
              for (int e2 = 0; e2 < 4; ++e2) { const int e = 4 * hh2 + e2; const unsigned sh = (e & 1) ? 16u : 0u; const float kl = bf2f((lo[e >> 1] >> sh) & 0xffffu), kc = bf2f((mi[e >> 1] >> sh) & 0xffffu), kh = bf2f((hi[e >> 1] >> sh) & 0xffffu);
                  const float k = (kc + clo[e2] * (kl - kc) + chi[e2] * (kh - kc)) * ckk[e2]; s += k * k; } }
          s = oct_sum(s);
          if (cg == 0) n2s[8 * wave + tk] = __builtin_amdgcn_rsqf(s + 1e-12f); }
        f32x4 wl[2], al[2];
        { STAGE_LANE(); const LAS bf16* tw = (const LAS bf16*)(lds + CH_TW); const LAS bf16* ad = (const LAS bf16*)(lds + CH_AD);
          const LAS bf16* wupt = (const LAS bf16*)(lds + CH_WUPT); const LAS bf16* aupt = (const LAS bf16*)(lds + CH_AUPT);
#pragma unroll
          for (int tt = 0; tt < 2; ++tt) { wl[tt] = z4; al[tt] = z4;
#pragma unroll
              for (int ks = 0; ks < 2; ++ks) {
                  wl[tt] = MFMA16(ldfrag(tw, CH_TW_LD, 32 * grp + 16 * tt, 32 * ks, lane), ldfrag(wupt, CH_TW_LD, 16 * cc, 32 * ks, lane), wl[tt]);
                  al[tt] = MFMA16(ldfrag(ad, CH_TW_LD, 32 * grp + 16 * tt, 32 * ks, lane), ldfrag(aupt, CH_TW_LD, 16 * cc, 32 * ks, lane), al[tt]); } } }
        __syncthreads();
        { STAGE_LANE(); float lw[2][4];
#pragma unroll
          for (int tt = 0; tt < 2; ++tt)
#pragma unroll
              for (int e = 0; e < 4; ++e) lw[tt][e] = -0.87506130f * __builtin_amdgcn_rcpf(1.0f + __builtin_amdgcn_exp2f(__builtin_fmaf(wl[tt][e], -1.44269504f, w0c)));
          float gin[2][4], run[2];
#pragma unroll
          for (int tt = 0; tt < 2; ++tt) { gin[tt][0] = lw[tt][0]; gin[tt][1] = gin[tt][0] + lw[tt][1]; gin[tt][2] = gin[tt][1] + lw[tt][2]; gin[tt][3] = gin[tt][2] + lw[tt][3]; run[tt] = gin[tt][3]; }
          float off[2], tot0;
          { float r1 = run[0]; float t1 = __shfl_up(r1, 16); if (lg >= 1) r1 += t1; float t2 = __shfl_up(r1, 32); if (lg >= 2) r1 += t2; off[0] = r1 - run[0]; tot0 = __shfl(r1, 48 + lr); }
          { float r1 = run[1]; float t1 = __shfl_up(r1, 16); if (lg >= 1) r1 += t1; float t2 = __shfl_up(r1, 32); if (lg >= 2) r1 += t2; off[1] = r1 - run[1] + tot0;
            const float tot = __shfl(r1, 48 + lr) + tot0; if (lg == 0) ecs[grp * 64 + c] = __builtin_amdgcn_exp2f(tot); }
#pragma unroll
          for (int tt = 0; tt < 2; ++tt) {
              const int q0 = 32 * grp + 16 * tt + 4 * lg;
              float xr[6], xk[6], xv[6];
              { const LAS bf16* tp = rkv + (q0 + (lr >> 2)) * CH_RKV_LD + 16 * cc + 4 * (lr & 3);
#pragma unroll
                for (int x = 0; x < 3; ++x) { const s16x4c lo = __builtin_amdgcn_ds_read_tr16_b64_v4i16((LAS s16x4c*)(tp + 64 * x)), hi = __builtin_amdgcn_ds_read_tr16_b64_v4i16((LAS s16x4c*)(tp + 64 * x + 4 * CH_RKV_LD));
                    float* dst = (x == 0) ? xr : (x == 1) ? xk : xv;
#pragma unroll
                    for (int e = 0; e < 4; ++e) dst[e] = bf2f((unsigned)(unsigned short)lo[e]);
                    dst[4] = bf2f((unsigned)(unsigned short)hi[0]); dst[5] = bf2f((unsigned)(unsigned short)hi[1]); } }
              const f32x4 n2 = *(const LAS f32x4*)(n2s + 32 * grp + 16 * tt + 4 * lg);
              f32x4 fa, fb, fk, fr, fv; float exprev = 1.f;
#pragma unroll
              for (int e = 0; e < 4; ++e) {
                  const float r = mc_r * xr[e + 1] + mlo_r * xr[e] + mhi_r * xr[e + 2];
                  const float k = mc_k * xk[e + 1] + mlo_k * xk[e] + mhi_k * xk[e + 2];
                  const float v = mc_v * xv[e + 1] + mlo_v * xv[e] + mhi_v * xv[e + 2];
                  const float a = __builtin_amdgcn_rcpf(1.0f + __builtin_amdgcn_exp2f(__builtin_fmaf(al[tt][e], -1.44269504f, a0c)));
                  const float kk = k * kkc * n2[e];
                  const float kdv = k * __builtin_fmaf(a, kac, kac1);
                  const float g = gin[tt][e] + off[tt];
                  const float ex = __builtin_amdgcn_exp2f(g), ie = __builtin_amdgcn_exp2f(-g), ep = (e == 0) ? __builtin_amdgcn_exp2f(g - lw[tt][e]) : exprev; exprev = ex;
                  fa[e] = -kk * ep; fb[e] = kk * a * ie; fk[e] = kdv * ie; fr[e] = r * ex; fv[e] = v; }
              const f32x4 fq = fr * rkc;
              const int t0 = 16 * tt + 4 * lg;
              u32x2v oa, ob, ok, orr, ov, oq; oq.x = cvtpk(fq[0], fq[1]); oq.y = cvtpk(fq[2], fq[3]);
              oa.x = cvtpk(fa[0], fa[1]); oa.y = cvtpk(fa[2], fa[3]); ob.x = cvtpk(fb[0], fb[1]); ob.y = cvtpk(fb[2], fb[3]); ok.x = cvtpk(fk[0], fk[1]); ok.y = cvtpk(fk[2], fk[3]);
              orr.x = cvtpk(fr[0], fr[1]); orr.y = cvtpk(fr[2], fr[3]); ov.x = cvtpk(fv[0], fv[1]); ov.y = cvtpk(fv[2], fv[3]);
              *(LAS u32x2v*)(I2_A + c * CH_I2_LD + t0) = oa; *(LAS u32x2v*)(I2_B + c * CH_I2_LD + t0) = ob; *(LAS u32x2v*)(I2_K + c * CH_I2_LD + t0) = ok; *(LAS u32x2v*)(I2_V + c * CH_I2_LD + t0) = ov; *(LAS u32x2v*)(I2_R + c * CH_I2_LD + t0) = orr; *(LAS u32x2v*)(I2_Q + c * CH_I2_LD + t0) = oq;
          } }
        __syncthreads();
        f32x4 kv[4];
        { STAGE_LANE();
          if (cc != 0) { const bf16x8 vb = ldfrag(I2_V, CH_I2_LD, 16 * cc, 0, lane);
#pragma unroll
            for (int mt = 0; mt < 4; ++mt) kv[mt] = MFMA16(ldfrag(I2_K, CH_I2_LD, 16 * mt, 0, lane), vb, z4); }
          if (cc != 0) {
              const LAS bf16* GA = (cc < 2) ? I2_A : I2_R; const LAS bf16* GB = (cc & 1) ? I2_K : I2_B;
              f32x4 g00 = z4, g10 = z4, g11 = z4;
              bf16x8 fa[2][2], fb[2][2];
#pragma unroll
              for (int ks = 0; ks < 2; ++ks) { fa[ks][0] = ldfrag_tr(GA, CH_I2_LD, 0, 32 * ks, lane); fa[ks][1] = ldfrag_tr(GA, CH_I2_LD, 16, 32 * ks, lane); fb[ks][0] = ldfrag_tr(GB, CH_I2_LD, 0, 32 * ks, lane); fb[ks][1] = ldfrag_tr(GB, CH_I2_LD, 16, 32 * ks, lane); }
#pragma unroll
              for (int ks = 0; ks < 2; ++ks) { g00 = MFMA16(fa[ks][0], fb[ks][0], g00); g10 = MFMA16(fa[ks][1], fb[ks][0], g10); g11 = MFMA16(fa[ks][1], fb[ks][1], g11); }
              const bool strict = cc < 2;
#pragma unroll
              for (int e = 0; e < 4; ++e) { const int m = 4 * lg + e; const bool keep = strict ? (lr < m) : (lr <= m); g00[e] = keep ? g00[e] : 0.f; g11[e] = keep ? g11[e] : 0.f; }
              if (cc == 3) {
                  f32x4 d0 = z4, d1 = z4;
#pragma unroll
                  for (int ks = 0; ks < 2; ++ks) { d0 = MFMA16(ldfrag_tr(I2_Q, CH_I2_LD, 0, 32 * ks, lane), ldfrag_tr(I2_K, CH_I2_LD, 0, 32 * ks, lane), d0);
                      d1 = MFMA16(ldfrag_tr(I2_Q, CH_I2_LD, 16, 32 * ks, lane), ldfrag_tr(I2_K, CH_I2_LD, 16, 32 * ks, lane), d1); }
                  if ((lr >> 2) == lg) { const int e = lr & 3; const float b0 = (e == 0) ? d0[0] : (e == 1) ? d0[1] : (e == 2) ? d0[2] : d0[3], b1 = (e == 0) ? d1[0] : (e == 1) ? d1[1] : (e == 2) ? d1[2] : d1[3];
                      const int p = p0 + ss * 64 + 32 * grp + lr, t = dir ? (L - 1 - p) : p, t2 = dir ? (t - 16) : (t + 16);
                      BS[((size_t)dir * MT + m0 + t) * 8 + h] = b0; BS[((size_t)dir * MT + m0 + t2) * 8 + h] = b1; }
              }
              LAS bf16* dst = (cc == 1) ? GLAK : (cc == 2) ? GMRB : GMRK;
              st_mn(dst, CH_G_LD, 0, 0, g00, lane); st_mn(dst, CH_G_LD, 16, 0, g10, lane); st_mn(dst, CH_G_LD, 16, 16, g11, lane); st_mn(dst, CH_G_LD, 0, 16, z4, lane);
          } else {
              f32x4 x00 = z4, x11 = z4, t00 = z4, t01 = z4, t11 = z4;
              { bf16x8 fa[2][2], fb[2][2];
#pragma unroll
                for (int ks = 0; ks < 2; ++ks) { fa[ks][0] = ldfrag_tr(I2_A, CH_I2_LD, 0, 32 * ks, lane); fa[ks][1] = ldfrag_tr(I2_A, CH_I2_LD, 16, 32 * ks, lane); fb[ks][0] = ldfrag_tr(I2_B, CH_I2_LD, 0, 32 * ks, lane); fb[ks][1] = ldfrag_tr(I2_B, CH_I2_LD, 16, 32 * ks, lane); }
#pragma unroll
                for (int ks = 0; ks < 2; ++ks) { x00 = MFMA16(fa[ks][0], fb[ks][0], x00); x11 = MFMA16(fa[ks][1], fb[ks][1], x11);
                    t00 = MFMA16(fb[ks][0], fa[ks][0], t00); t01 = MFMA16(fb[ks][0], fa[ks][1], t01); t11 = MFMA16(fb[ks][1], fa[ks][1], t11); } }
              f32x4 y00, y10, y11, yt11;
#pragma unroll
              for (int e = 0; e < 4; ++e) { const int m = 4 * lg + e; x00[e] = (lr < m) ? x00[e] : 0.f; x11[e] = (lr < m) ? x11[e] : 0.f; t00[e] = (m < lr) ? t00[e] : 0.f; t11[e] = (m < lr) ? t11[e] : 0.f; y00[e] = (lr == m) ? 1.f : 0.f; }
              y11 = y00; yt11 = y00;
#pragma unroll 1
              for (int lev = 0; lev < 4; ++lev) {
                  const bf16x4 fx00 = frag4(x00), fx11 = frag4(x11), ft00 = frag4(t00), ft11 = frag4(t11), fy00 = frag4(y00), fy11 = frag4(y11);
                  y00 = MF16(ft00, fy00, y00); y11 = MF16(ft11, fy11, y11); yt11 = MF16(fy11, ft11, yt11);
                  if (lev < 3) { const f32x4 n00 = MF16(ft00, fx00, z4), n11 = MF16(ft11, fx11, z4), m00 = MF16(fx00, ft00, z4), m11 = MF16(fx11, ft11, z4);
                      x00 = n00; x11 = n11; t00 = m00; t11 = m11; }
              }
              { const f32x4 zz = MF16(frag4(t01), frag4(y00), z4);
                y10 = MF16(frag4(yt11), frag4(zz), z4); }
              st_mn(GT, CH_G_LD, 0, 0, y00, lane); st_mn(GT, CH_G_LD, 16, 0, y10, lane); st_mn(GT, CH_G_LD, 16, 16, y11, lane); st_mn(GT, CH_G_LD, 0, 16, z4, lane);
              { const bf16x8 vb = ldfrag(I2_V, CH_I2_LD, 16 * cc, 0, lane);
#pragma unroll
                for (int mt = 0; mt < 4; ++mt) kv[mt] = MFMA16(ldfrag(I2_K, CH_I2_LD, 16 * mt, 0, lane), vb, z4); }
          } }
        if (ss + 1 < nss) chain_prefetch(RR, proj, m0, L, h, dir, ss + 1, tid, p0);
        __syncthreads();
        f32x4 y0[2], u0[2]; bf16x4 apf[2][4];
        { STAGE_LANE(); const bf16x8 vb = ldfrag(I2_V, CH_I2_LD, 16 * cc, 0, lane);
          const f32x4 w0 = MFMA16(ldfrag(GLAK, CH_G_LD, 0, 0, lane), vb, z4), w1 = MFMA16(ldfrag(GLAK, CH_G_LD, 16, 0, lane), vb, z4);
          y0[0] = MFMA16(ldfrag(GMRK, CH_G_LD, 0, 0, lane), vb, z4); y0[1] = MFMA16(ldfrag(GMRK, CH_G_LD, 16, 0, lane), vb, z4);
          { const bf16x8 ta0 = ldfrag(GT, CH_G_LD, 0, 0, lane), ta1 = ldfrag(GT, CH_G_LD, 16, 0, lane);
#pragma unroll
            for (int mt = 0; mt < 4; ++mt) { const bf16x8 at = ldfrag(I2_A, CH_I2_LD, 16 * mt, 0, lane); apf[0][mt] = frag4(MFMA16(at, ta0, z4)); apf[1][mt] = frag4(MFMA16(at, ta1, z4)); } }
          const bf16x4 fw0 = frag4(w0), fw1 = frag4(w1);
          u0[0] = MF16(ldfrag4(GT, CH_G_LD, 0, 0, lane), fw0, z4);
          u0[1] = MF16(ldfrag4(GT, CH_G_LD, 16, 16, lane), fw1, MF16(ldfrag4(GT, CH_G_LD, 16, 0, lane), fw0, z4)); }
        { STAGE_LANE(); LAS f32x4* hf = (LAS f32x4*)(lds + CH_HF) + cc * 256 + lane;
          bf16x4 rf[2][4], bfr[4][2], mbf[3]; f32x4 ecv[4];
#pragma unroll
          for (int mt = 0; mt < 4; ++mt) {
              bfr[mt][0] = ldfrag4(I2_B, CH_I2_LD, 16 * mt, 0, lane); bfr[mt][1] = ldfrag4(I2_B, CH_I2_LD, 16 * mt, 16, lane); ecv[mt] = *(const LAS f32x4*)(ecs + grp * 64 + 16 * mt + 4 * lg); }
#define LOAD_PART_B() do { _Pragma("unroll") for (int mt = 0; mt < 4; ++mt) { rf[0][mt] = ldfrag4_tr(I2_R, CH_I2_LD, 0, 16 * mt, lane); rf[1][mt] = ldfrag4_tr(I2_R, CH_I2_LD, 16, 16 * mt, lane); } \
          mbf[0] = ldfrag4(GMRB, CH_G_LD, 0, 0, lane); mbf[1] = ldfrag4(GMRB, CH_G_LD, 16, 0, lane); mbf[2] = ldfrag4(GMRB, CH_G_LD, 16, 16, lane); } while (0)
          if (grp == 1) LOAD_PART_B();
          bf16x4 fH[4], fU0, fU1, fHP[4], fUP0, fUP1;
#pragma unroll
          for (int mt = 0; mt < 4; ++mt) fHP[mt] = (bf16x4){0, 0, 0, 0};
          fUP0 = fUP1 = (bf16x4){0, 0, 0, 0};
#pragma unroll 1
          for (int sg = 0; sg < 2; ++sg) {
              if (grp == sg) {
                  f32x4 hh[4];
#pragma unroll
                  for (int mt = 0; mt < 4; ++mt) { hh[mt] = hf[64 * mt]; fH[mt] = frag4(hh[mt]); }
                  f32x4 uu0 = u0[0], uu1 = u0[1];
#pragma unroll
                  for (int mt = 0; mt < 4; ++mt) { uu0 = MF16(apf[0][mt], fH[mt], uu0); uu1 = MF16(apf[1][mt], fH[mt], uu1); }
                  fU0 = frag4(uu0); fU1 = frag4(uu1);
#pragma unroll
                  for (int mt = 0; mt < 4; ++mt) { f32x4 acc = hh[mt] + kv[mt]; acc = MF16(bfr[mt][0], fU0, acc); acc = MF16(bfr[mt][1], fU1, acc); hf[64 * mt] = acc * ecv[mt]; }
                  if (mode == 2) {
                      LAS f32x4* hf2 = (LAS f32x4*)(lds + CH_HF2) + cc * 256 + lane; f32x4 hp[4];
#pragma unroll
                      for (int mt = 0; mt < 4; ++mt) { hp[mt] = hf2[64 * mt]; fHP[mt] = frag4(hp[mt]); }
                      f32x4 up0 = z4, up1 = z4;
#pragma unroll
                      for (int mt = 0; mt < 4; ++mt) { up0 = MF16(apf[0][mt], fHP[mt], up0); up1 = MF16(apf[1][mt], fHP[mt], up1); }
                      fUP0 = frag4(up0); fUP1 = frag4(up1);
#pragma unroll
                      for (int mt = 0; mt < 4; ++mt) { f32x4 acc = MF16(bfr[mt][0], fUP0, hp[mt]); acc = MF16(bfr[mt][1], fUP1, acc); hf2[64 * mt] = acc * ecv[mt]; }
                  }
              }
              __syncthreads();
              if (grp == sg) {
                  if (sg == 0) LOAD_PART_B();
                  f32x4 yy0 = y0[0], yy1 = y0[1];
#pragma unroll
                  for (int mt = 0; mt < 4; ++mt) { yy0 = MF16(rf[0][mt], fH[mt], yy0); yy1 = MF16(rf[1][mt], fH[mt], yy1); }
                  yy0 = MF16(mbf[0], fU0, yy0); yy1 = MF16(mbf[2], fU1, MF16(mbf[1], fU0, yy1));
#pragma unroll
                  for (int e = 0; e < 4; ++e) { const int p = p0 + ss * 64 + 32 * sg + 4 * lg + e, t = dir ? (L - 1 - p) : p, t2 = dir ? (t - 16) : (t + 16);
                      YD[((size_t)dir * MT + m0 + t) * 512 + h * 64 + vcol] = (bf16)f2bf(yy0[e]); YD[((size_t)dir * MT + m0 + t2) * 512 + h * 64 + vcol] = (bf16)f2bf(yy1[e]); }
                  if (mode == 2) {
                      f32x4 g0 = z4, g1 = z4;
#pragma unroll
                      for (int mt = 0; mt < 4; ++mt) { g0 = MF16(rf[0][mt], fHP[mt], g0); g1 = MF16(rf[1][mt], fHP[mt], g1); }
                      g0 = MF16(mbf[0], fUP0, g0); g1 = MF16(mbf[2], fUP1, MF16(mbf[1], fUP0, g1));
                      GAS bf16* G = (GAS bf16*)(P.ws + WS_G) + ((size_t)chain * 2048 + (ss * 64 + 32 * sg + 4 * lg)) * 64 + vcol;
#pragma unroll
                      for (int e = 0; e < 4; e += 2) { const unsigned w0 = cvtpk(g0[e], g0[e + 1]), w1 = cvtpk(g1[e], g1[e + 1]);
                          G[(size_t)e * 64] = (bf16)(w0 & 0xffffu); G[(size_t)(e + 1) * 64] = (bf16)(w0 >> 16); G[(size_t)(e + 16) * 64] = (bf16)(w1 & 0xffffu); G[(size_t)(e + 17) * 64] = (bf16)(w1 >> 16); }
                  }
              }
          }
#undef LOAD_PART_B
        }
        if (ss + 1 < nss) { chain_stage_raw(RR, lds, tid); __syncthreads(); }
    }
    if (grp == 1 && (sfin || mode == 1)) { STAGE_LANE(); const LAS f32x4* hf = (const LAS f32x4*)(lds + CH_HF) + cc * 256 + lane;
        if (mode == 1) { GAS bf16* hm = (GAS bf16*)(P.ws + WS_HMID) + (size_t)chain * 4096 + vcol * 64;
#pragma unroll
            for (int mt = 0; mt < 4; ++mt) { const f32x4 hv = hf[64 * mt]; u32x2v o; o.x = cvtpk(hv[0], hv[1]); o.y = cvtpk(hv[2], hv[3]); *(GAS u32x2v*)(hm + 16 * mt + 4 * lg) = o; } }
        else {
#pragma unroll
            for (int mt = 0; mt < 4; ++mt) *(f32x4*)(sfin + vcol * 64 + 16 * mt + 4 * lg) = hf[64 * mt]; }
    }
    __syncthreads();
#undef STAGE_LANE
}
constexpr int VN_LD = 520;
constexpr int GM_STG = 128 * VN_LD * 2;
static_assert(GM_STG + 8 * 2048 <= LDS_BYTES - 64, "gMLP LDS map");
typedef short s16x4 __attribute__((ext_vector_type(4)));
__device__ __forceinline__ s16x4 tr16(const LAS bf16* p) { return __builtin_amdgcn_ds_read_tr16_b64_v4i16((LAS s16x4*)p); }
__device__ __forceinline__ void do_gmlp(const Params& P, LAS unsigned char* lds, int unit) {
    const int tid = threadIdx.x, lane = tid & 63, wave = __builtin_amdgcn_readfirstlane(tid >> 6);
    const GAS bf16* proj = (const GAS bf16*)(P.ws + WS_PROJ); GAS bf16* MIX = (GAS bf16*)(P.ws + WS_H); const GAS bf16* wsb = (const GAS bf16*)(P.ws + WS_WSB);
    LAS bf16* vn = (LAS bf16*)lds;
    const int row0 = unit * 128;
    { const GAS float* g = (const GAS float*)P.in[I_SLG]; const GAS float* b = (const GAS float*)P.in[I_SLB];
      float gg[8], bb[8];
#pragma unroll
      for (int e = 0; e < 8; ++e) { gg[e] = g[lane * 8 + e]; bb[e] = b[lane * 8 + e]; }
#pragma unroll 1
      for (int ib = 0; ib < 2; ++ib) {
        u32x4v rawv[8];
#pragma unroll
        for (int i = 0; i < 8; ++i) rawv[i] = *(const GAS u32x4v*)(proj + (size_t)(row0 + wave * 16 + ib * 8 + i) * D_IN + C_VB + lane * 8);
#pragma unroll
        for (int i = 0; i < 8; ++i) { const int tok = wave * 16 + ib * 8 + i; const u32x4v raw = rawv[i];
        float x[8]; x[0] = bf2f(raw.x & 0xffffu); x[1] = bf2f(raw.x >> 16); x[2] = bf2f(raw.y & 0xffffu); x[3] = bf2f(raw.y >> 16); x[4] = bf2f(raw.z & 0xffffu); x[5] = bf2f(raw.z >> 16); x[6] = bf2f(raw.w & 0xffffu); x[7] = bf2f(raw.w >> 16);
        float s = 0.f;
#pragma unroll
        for (int e = 0; e < 8; ++e) s += x[e];
        const float mean = wave_sum(s) * (1.0f / 512.0f); float q = 0.f;
#pragma unroll
        for (int e = 0; e < 8; ++e) { x[e] -= mean; q += x[e] * x[e]; }
        const float rstd = 1.0f / sqrtf(wave_sum(q) * (1.0f / 512.0f) + NORM_EPS);
        u32x4v o;
#pragma unroll
        for (int e = 0; e < 4; ++e) o[e] = cvtpk(x[2 * e] * rstd * gg[2 * e] + bb[2 * e], x[2 * e + 1] * rstd * gg[2 * e + 1] + bb[2 * e + 1]);
        *(LAS u32x4v*)(vn + tok * VN_LD + lane * 8) = o; } } }
    __syncthreads();
    const int g = wave, fr = lane & 15, fq = lane >> 4;
    const GAS float* b_s = (const GAS float*)P.in[I_BSS];
    LAS bf16* stg = (LAS bf16*)(lds + GM_STG + wave * 2048);
    const LAS bf16* trbase = vn + (8 * fq + (fr >> 2)) * VN_LD + g * 64 + 4 * (fr & 3);
#pragma unroll 1
    for (int ah = 0; ah < 2; ++ah) {
        f32x4 acc[4][4];
#pragma unroll
        for (int a = 0; a < 4; ++a)
#pragma unroll
            for (int c = 0; c < 4; ++c) acc[a][c] = (f32x4){0.f, 0.f, 0.f, 0.f};
        bf16x8 afr[4][4];
#pragma unroll
        for (int a = 0; a < 4; ++a)
#pragma unroll
            for (int ks = 0; ks < 4; ++ks) afr[a][ks] = *(const GAS bf16x8*)(wsb + (size_t)(g * 128 + (ah * 4 + a) * 16 + fr) * 128 + ks * 32 + 8 * fq);
#pragma unroll
        for (int ks = 0; ks < 4; ++ks) {
            bf16x8 bfr[4];
#pragma unroll
            for (int c = 0; c < 4; ++c) { const s16x4 lo = tr16(trbase + (32 * ks) * VN_LD + 16 * c), hi = tr16(trbase + (32 * ks + 4) * VN_LD + 16 * c);
                bfr[c] = (bf16x8){lo[0], lo[1], lo[2], lo[3], hi[0], hi[1], hi[2], hi[3]}; }
#pragma unroll
            for (int a = 0; a < 4; ++a)
#pragma unroll
                for (int c = 0; c < 4; ++c) acc[a][c] = __builtin_amdgcn_mfma_f32_16x16x32_bf16(afr[a][ks], bfr[c], acc[a][c], 0, 0, 0);
        }
        const int pr_ = lane >> 2, cq = lane & 3, ch = g * 64 + 16 * cq;
        u32x4v un0, un1, zn0, zn1; float bsn;
        { const GAS bf16* pr = proj + (size_t)(row0 + (ah * 4) * 16 + pr_) * D_IN;
          un0 = *(const GAS u32x4v*)(pr + C_U + ch); un1 = *(const GAS u32x4v*)(pr + C_U + ch + 8); zn0 = *(const GAS u32x4v*)(pr + C_ZB + ch); zn1 = *(const GAS u32x4v*)(pr + C_ZB + ch + 8); bsn = b_s[g * 128 + (ah * 4) * 16 + pr_]; }
#pragma unroll
        for (int a = 0; a < 4; ++a) {
#pragma unroll
            for (int c = 0; c < 4; ++c)
#pragma unroll
                for (int e = 0; e < 4; e += 2) { const unsigned w = cvtpk(acc[a][c][e], acc[a][c][e + 1]); LAS bf16* sp = stg + (4 * fq + e) * 64 + 16 * c + fr; sp[0] = (bf16)(w & 0xffffu); sp[64] = (bf16)(w >> 16); }
            const int p = (ah * 4 + a) * 16 + pr_;
            const u32x4v u0 = un0, u1 = un1, z0 = zn0, z1 = zn1; const float bsv = bsn;
            if (a < 3) { const GAS bf16* pr = proj + (size_t)(row0 + p + 16) * D_IN;
                un0 = *(const GAS u32x4v*)(pr + C_U + ch); un1 = *(const GAS u32x4v*)(pr + C_U + ch + 8); zn0 = *(const GAS u32x4v*)(pr + C_ZB + ch); zn1 = *(const GAS u32x4v*)(pr + C_ZB + ch + 8); bsn = b_s[g * 128 + p + 16]; }
            const u32x4v s0 = *(const LAS u32x4v*)(stg + pr_ * 64 + 16 * cq), s1 = *(const LAS u32x4v*)(stg + pr_ * 64 + 16 * cq + 8);
            u32x4v o0, o1;
#pragma unroll
            for (int e = 0; e < 4; ++e) {
                o0[e] = cvtpk(bf2f(u0[e] & 0xffffu) * (bf2f(s0[e] & 0xffffu) + bsv) * silu_f(bf2f(z0[e] & 0xffffu)), bf2f(u0[e] >> 16) * (bf2f(s0[e] >> 16) + bsv) * silu_f(bf2f(z0[e] >> 16)));
                o1[e] = cvtpk(bf2f(u1[e] & 0xffffu) * (bf2f(s1[e] & 0xffffu) + bsv) * silu_f(bf2f(z1[e] & 0xffffu)), bf2f(u1[e] >> 16) * (bf2f(s1[e] >> 16) + bsv) * silu_f(bf2f(z1[e] >> 16))); }
            GAS bf16* op = MIX + (size_t)(row0 + p) * D + 512 + ch;
            *(GAS u32x4v*)op = o0; *(GAS u32x4v*)(op + 8) = o1;
        }
    }
    __syncthreads();
}

__device__ __forceinline__ void wait_acquire(unsigned* ctr, unsigned target, unsigned* bar);
__device__ __forceinline__ int queue_pull(unsigned char* ws, size_t qoff, volatile LAS int* qslot) {
    if (threadIdx.x == 0) *qslot = (int)__hip_atomic_fetch_add((unsigned*)(ws + qoff), 1u, __ATOMIC_RELAXED, __HIP_MEMORY_SCOPE_AGENT);
    __syncthreads();
    const int t = *qslot;
    __syncthreads();
    return t;
}
__device__ __forceinline__ void phase3(const Params& P, LAS unsigned char* lds) {
    const int G = gridDim.x, bid = blockIdx.x;
    const bool bal = (G == 256);
    volatile LAS int* qslot = (volatile LAS int*)(lds + LDS_BYTES - 32);
    const int nit = bal ? 513 : (640 + G - 1) / G;
    for (int it = 0; it < nit; ++it) {
        int m0, L, h, dir, p0, npt, mode, chain; const float* s0; float* sfin;
        if (bal) {
            if (it == 0) { const int b = bid & 7, q = (bid >> 3) & 15; h = q >> 1; dir = q & 1; chain = b * 16 + q; m0 = M_CTX + b * L_LAT; L = L_LAT; sfin = nullptr;
                wait_acquire((unsigned*)(P.ws + CW_R1) + 64 * b, 32u, (unsigned*)P.ws);
                if (bid < 128) { mode = 1; p0 = 0; npt = 2048; s0 = (dir ? P.in[I_SB] : P.in[I_SF]) + (size_t)(b * 8 + h) * 4096; }
                else { mode = 2; p0 = 2048; npt = 2048; s0 = nullptr; } }
            else { if (it == 1) wait_acquire((unsigned*)(P.ws + CW_RALL), 256u, (unsigned*)P.ws);
                const int cc = queue_pull(P.ws, CW_QUEUE, qslot); if (cc >= 512) break;
                const int b = cc >> 4; chain = 0; h = (cc >> 1) & 7; dir = cc & 1; m0 = b * L_CTX; L = L_CTX; p0 = 0; npt = L_CTX; mode = 0;
                s0 = nullptr; sfin = P.out + (size_t)MT * D + (size_t)dir * STATE_ELEMS + (size_t)(b * 8 + h) * 4096; }
        } else {
            const int c = bid + it * G; if (c >= 640) continue;
            chain = 0; p0 = 0; mode = 0;
            if (c < 128) { const int b = c >> 4; h = (c >> 1) & 7; dir = c & 1; m0 = M_CTX + b * L_LAT; L = L_LAT; npt = L_LAT;
                s0 = (dir ? P.in[I_SB] : P.in[I_SF]) + (size_t)(b * 8 + h) * 4096; sfin = nullptr; }
            else { const int cc = c - 128, b = cc >> 4; h = (cc >> 1) & 7; dir = cc & 1; m0 = b * L_CTX; L = L_CTX; npt = L_CTX;
                s0 = nullptr; sfin = P.out + (size_t)MT * D + (size_t)dir * STATE_ELEMS + (size_t)(b * 8 + h) * 4096; }
        }
        do_chain(P, lds, m0, L, h, dir, s0, sfin, p0, npt, mode, chain);
    }
    if (bal) { for (;;) { const int u = queue_pull(P.ws, CW_QUEUE + 256, qslot); if (u >= 320) break; do_gmlp(P, lds, u); } }
    else { for (int u = bid; u < 320; u += G) do_gmlp(P, lds, u); }
}

__device__ __forceinline__ void phase35(const Params& P, LAS unsigned char* lds, int gw, int NGW, int wave, int lane) {
    if (gridDim.x != 256) return;
    const GAS bf16* Gm = (const GAS bf16*)(P.ws + WS_G); const GAS bf16* HM = (const GAS bf16*)(P.ws + WS_HMID); GAS bf16* CORR = (GAS bf16*)(P.ws + WS_CORR);
    const int lr = lane & 15, lg = lane >> 4;
    LAS bf16* stg = (LAS bf16*)(lds + wave * 2304);
    const int chain = gw >> 4, b = chain >> 4, h = (chain >> 1) & 7, dir = chain & 1;
    bf16x8 hb[4][2];
#pragma unroll
    for (int nt = 0; nt < 4; ++nt) { const GAS bf16* hp = HM + (size_t)chain * 4096 + (16 * nt + lr) * 64 + 8 * lg; hb[nt][0] = *(const GAS bf16x8*)hp; hb[nt][1] = *(const GAS bf16x8*)(hp + 32); }
    const GAS bf16* gp = Gm + ((size_t)chain * 2048 + (gw & 15) * 128 + lr) * 64 + 8 * lg;
    bf16x8 a0 = *(const GAS bf16x8*)gp, a1 = *(const GAS bf16x8*)(gp + 32);
#pragma unroll 1
    for (int i = 0; i < 8; ++i) {
        const bf16x8 c0 = a0, c1 = a1;
        if (i < 7) { a0 = *(const GAS bf16x8*)(gp + (size_t)(i + 1) * 1024); a1 = *(const GAS bf16x8*)(gp + (size_t)(i + 1) * 1024 + 32); }
#pragma unroll
        for (int nt = 0; nt < 4; ++nt) { f32x4 acc = MFMA16(c0, hb[nt][0], ((f32x4){0.f, 0.f, 0.f, 0.f})); acc = MFMA16(c1, hb[nt][1], acc);
            const unsigned w0 = cvtpk(acc[0], acc[1]), w1 = cvtpk(acc[2], acc[3]); LAS bf16* sp = stg + (4 * lg) * 72 + 16 * nt + lr;
            sp[0] = (bf16)(w0 & 0xffffu); sp[72] = (bf16)(w0 >> 16); sp[144] = (bf16)(w1 & 0xffffu); sp[216] = (bf16)(w1 >> 16); }
        const int tr = lane >> 2, vq = lane & 3, p = 2048 + ((gw & 15) * 8 + i) * 16 + tr, t = dir ? (L_LAT - 1 - p) : p;
        const u32x4v o0 = *(const LAS u32x4v*)(stg + tr * 72 + 16 * vq), o1 = *(const LAS u32x4v*)(stg + tr * 72 + 16 * vq + 8);
        GAS bf16* cp = CORR + ((size_t)(b * L_LAT + t)) * 512 + h * 64 + 16 * vq;
        *(GAS u32x4v*)cp = o0; *(GAS u32x4v*)(cp + 8) = o1;
    }
}

__device__ __forceinline__ void phase4(const Params& P, int gw, int NGW, int lane, int m_lo, int m_hi) {
    const GAS bf16* proj = (const GAS bf16*)(P.ws + WS_PROJ); GAS bf16* MIX = (GAS bf16*)(P.ws + WS_H); const GAS bf16* YD = (const GAS bf16*)P.out; const GAS float* BS = (const GAS float*)(P.ws + WS_BS);
    const GAS float* ts_mu = (const GAS float*)P.in[I_TSMU]; const GAS float* gn_w = (const GAS float*)P.in[I_GNW]; const GAS float* gn_b = (const GAS float*)P.in[I_GNB];
    const int ch = 8 * lane, hd = lane >> 3;
    float m0v[8], m1v[8], gw8[8], gb8[8];
#pragma unroll
    for (int e = 0; e < 8; ++e) { m0v[e] = ts_mu[C_V + ch + e]; m1v[e] = ts_mu[1536 + C_V + ch + e]; gw8[e] = gn_w[ch + e]; gb8[e] = gn_b[ch + e]; }
    for (int m = m_lo + gw; m < m_hi; m += NGW) {
        const int t = (m < M_CTX) ? (m & (L_CTX - 1)) : ((m - M_CTX) & (L_LAT - 1)), L = (m < M_CTX) ? L_CTX : L_LAT;
        const u32x4v yf = *(const GAS u32x4v*)(YD + (size_t)m * 512 + ch), yb = *(const GAS u32x4v*)(YD + ((size_t)MT + m) * 512 + ch);
        const GAS bf16* pr = proj + (size_t)m * D_IN;
        const u32x4v vc = *(const GAS u32x4v*)(pr + C_V + ch), za = *(const GAS u32x4v*)(pr + C_ZA + ch);
        u32x4v vp = (u32x4v){0u, 0u, 0u, 0u}, vn = (u32x4v){0u, 0u, 0u, 0u};
        if (t > 0) vp = *(const GAS u32x4v*)(pr + C_V + ch - D_IN);
        if (t < L - 1) vn = *(const GAS u32x4v*)(pr + C_V + ch + D_IN);
        const float bon = BS[(size_t)m * 8 + hd] + BS[((size_t)MT + m) * 8 + hd];
        u32x4v cr = (u32x4v){0u, 0u, 0u, 0u};
        if (m >= M_CTX && gridDim.x == 256) cr = *(const GAS u32x4v*)((const GAS bf16*)(P.ws + WS_CORR) + (size_t)(m - M_CTX) * 512 + ch);
        float y[8];
#pragma unroll
        for (int e = 0; e < 8; ++e) { const unsigned sh = (e & 1) ? 16u : 0u; y[e] = bf2f((yf[e >> 1] >> sh) & 0xffffu) + bf2f((yb[e >> 1] >> sh) & 0xffffu); }
        float s = 0.f;
#pragma unroll
        for (int e = 0; e < 8; ++e) { y[e] += bf2f((cr[e >> 1] >> ((e & 1) ? 16u : 0u)) & 0xffffu); s += y[e]; }
        const float mean = oct_sum(s) * (1.0f / 64.0f); float q = 0.f;
#pragma unroll
        for (int e = 0; e < 8; ++e) { y[e] -= mean; q += y[e] * y[e]; }
        const float rstd = 1.0f / sqrtf(oct_sum(q) * (1.0f / 64.0f) + GN_EPS);
        u32x4v o;
#pragma unroll
        for (int e2 = 0; e2 < 4; ++e2) { float r2[2];
#pragma unroll
            for (int hh = 0; hh < 2; ++hh) { const int e = 2 * e2 + hh; const unsigned sh = hh ? 16u : 0u;
                const float c0 = bf2f((vc[e2] >> sh) & 0xffffu), p0 = bf2f((vp[e2] >> sh) & 0xffffu), n0 = bf2f((vn[e2] >> sh) & 0xffffu), z = bf2f((za[e2] >> sh) & 0xffffu);
                const float v = c0 + m0v[e] * (p0 - c0) + m1v[e] * (n0 - c0);
                r2[hh] = (y[e] * rstd * gw8[e] + gb8[e] + bon * v) * silu_f(z); }
            o[e2] = cvtpk(r2[0], r2[1]); }
        *(GAS u32x4v*)(MIX + (size_t)m * D + ch) = o;
    }
}

__device__ __forceinline__ void phase45(const Params& P, LAS unsigned char* lds, int gw, int NGW, int wave, int lane) {
    phase4(P, gw, NGW, lane, 0, M_CTX);
    const GAS bf16* Gm = (const GAS bf16*)(P.ws + WS_G); const GAS bf16* HM = (const GAS bf16*)(P.ws + WS_HMID);
    const GAS bf16* proj = (const GAS bf16*)(P.ws + WS_PROJ); GAS bf16* MIX = (GAS bf16*)(P.ws + WS_H); const GAS bf16* YD = (const GAS bf16*)P.out; const GAS float* BS = (const GAS float*)(P.ws + WS_BS);
    const GAS float* ts_mu = (const GAS float*)P.in[I_TSMU]; const GAS float* gn_w = (const GAS float*)P.in[I_GNW]; const GAS float* gn_b = (const GAS float*)P.in[I_GNB];
    const int lr = lane & 15, lg = lane >> 4;
    LAS bf16* stg = (LAS bf16*)(lds + wave * 16640);
    const int tile = gw, b = tile >> 8, t0 = (tile & 255) * 16, dirs = (t0 >= 2048) ? 0 : 1;
    const int grow0 = (dirs ? (L_LAT - 1 - t0 - 15) : t0) - 2048;
#pragma unroll 1
    for (int hp2 = 0; hp2 < 4; ++hp2) {
        bf16x8 ga[2][2], hb[2][4][2];
#pragma unroll
        for (int q = 0; q < 2; ++q) { const int chain = b * 16 + (2 * hp2 + q) * 2 + dirs;
            const GAS bf16* gp = Gm + ((size_t)chain * 2048 + grow0 + lr) * 64 + 8 * lg; ga[q][0] = *(const GAS bf16x8*)gp; ga[q][1] = *(const GAS bf16x8*)(gp + 32);
#pragma unroll
            for (int nt = 0; nt < 4; ++nt) { const GAS bf16* hp = HM + (size_t)chain * 4096 + (16 * nt + lr) * 64 + 8 * lg; hb[q][nt][0] = *(const GAS bf16x8*)hp; hb[q][nt][1] = *(const GAS bf16x8*)(hp + 32); } }
#pragma unroll
        for (int q = 0; q < 2; ++q)
#pragma unroll
            for (int nt = 0; nt < 4; ++nt) { f32x4 acc = MFMA16(ga[q][0], hb[q][nt][0], ((f32x4){0.f, 0.f, 0.f, 0.f})); acc = MFMA16(ga[q][1], hb[q][nt][1], acc);
                const unsigned w0 = cvtpk(acc[0], acc[1]), w1 = cvtpk(acc[2], acc[3]); LAS bf16* sp = stg + (4 * lg) * 520 + (2 * hp2 + q) * 64 + 16 * nt + lr;
                sp[0] = (bf16)(w0 & 0xffffu); sp[520] = (bf16)(w0 >> 16); sp[1040] = (bf16)(w1 & 0xffffu); sp[1560] = (bf16)(w1 >> 16); }
    }
    const int ch = 8 * lane, hd = lane >> 3;
    float m0v[8], m1v[8], gw8[8], gb8[8];
#pragma unroll
    for (int e = 0; e < 8; ++e) { m0v[e] = ts_mu[C_V + ch + e]; m1v[e] = ts_mu[1536 + C_V + ch + e]; gw8[e] = gn_w[ch + e]; gb8[e] = gn_b[ch + e]; }
#pragma unroll 1
    for (int r = 0; r < 16; ++r) {
        const int t = t0 + r, m = M_CTX + b * L_LAT + t, pl = dirs ? (15 - r) : r;
        const u32x4v yf = *(const GAS u32x4v*)(YD + (size_t)m * 512 + ch), yb = *(const GAS u32x4v*)(YD + ((size_t)MT + m) * 512 + ch);
        const GAS bf16* pr = proj + (size_t)m * D_IN;
        const u32x4v vc = *(const GAS u32x4v*)(pr + C_V + ch), za = *(const GAS u32x4v*)(pr + C_ZA + ch);
        u32x4v vp = (u32x4v){0u, 0u, 0u, 0u}, vn = (u32x4v){0u, 0u, 0u, 0u};
        if (t > 0) vp = *(const GAS u32x4v*)(pr + C_V + ch - D_IN);
        if (t < L_LAT - 1) vn = *(const GAS u32x4v*)(pr + C_V + ch + D_IN);
        const float bon = BS[(size_t)m * 8 + hd] + BS[((size_t)MT + m) * 8 + hd];
        const u32x4v cr = *(const LAS u32x4v*)(stg + pl * 520 + ch);
        float y[8]; float s = 0.f;
#pragma unroll
        for (int e = 0; e < 8; ++e) { const unsigned sh = (e & 1) ? 16u : 0u; y[e] = bf2f((yf[e >> 1] >> sh) & 0xffffu) + bf2f((yb[e >> 1] >> sh) & 0xffffu) + bf2f((cr[e >> 1] >> sh) & 0xffffu); s += y[e]; }
        const float mean = oct_sum(s) * (1.0f / 64.0f); float q = 0.f;
#pragma unroll
        for (int e = 0; e < 8; ++e) { y[e] -= mean; q += y[e] * y[e]; }
        const float rstd = 1.0f / sqrtf(oct_sum(q) * (1.0f / 64.0f) + GN_EPS);
        u32x4v o;
#pragma unroll
        for (int e2 = 0; e2 < 4; ++e2) { float r2[2];
#pragma unroll
            for (int hh = 0; hh < 2; ++hh) { const int e = 2 * e2 + hh; const unsigned sh = hh ? 16u : 0u;
                const float c0 = bf2f((vc[e2] >> sh) & 0xffffu), p0 = bf2f((vp[e2] >> sh) & 0xffffu), n0 = bf2f((vn[e2] >> sh) & 0xffffu), z = bf2f((za[e2] >> sh) & 0xffffu);
                const float v = c0 + m0v[e] * (p0 - c0) + m1v[e] * (n0 - c0);
                r2[hh] = (y[e] * rstd * gw8[e] + gb8[e] + bon * v) * silu_f(z); }
            o[e2] = cvtpk(r2[0], r2[1]); }
        *(GAS u32x4v*)(MIX + (size_t)m * D + ch) = o;
    }
}

__device__ __forceinline__ void phase6(const Params& P, int gw, int NGW, int lane) {
    const GAS float* mod = (const GAS float*)(P.ws + WS_MOD); const GAS float* ln_post = (const GAS float*)P.in[I_LNPOST]; const GAS bf16* OB = (const GAS bf16*)(P.ws + WS_OUTB);
#pragma unroll 1
    for (int seg = 0; seg < 9; ++seg) {
        const int m_lo = (seg == 0) ? 0 : M_CTX + (seg - 1) * L_LAT, m_hi = (seg == 0) ? M_CTX : m_lo + L_LAT;
        const GAS float* gate = mod + seg * 3072 + 2048;
        f32x4 wg[4];
#pragma unroll
        for (int j = 0; j < 4; ++j) { const int col = 4 * (lane + 64 * j); wg[j] = *(const GAS f32x4*)(ln_post + col) * *(const GAS f32x4*)(gate + col); }
        for (int m = m_lo + gw; m < m_hi; m += NGW) {
            const GAS f32x4* xr = (const GAS f32x4*)x_row(P, m) + lane; GAS f32x4* orow = (GAS f32x4*)(P.out + (size_t)m * D) + lane;
            const GAS u32x2v* ob = (const GAS u32x2v*)(OB + (size_t)m * D) + lane;
            f32x4 o[4], xv[4]; float ss = 0.f;
#pragma unroll
            for (int j = 0; j < 4; ++j) { const u32x2v r = ob[64 * j]; xv[j] = xr[64 * j]; o[j][0] = bf2f(r.x & 0xffffu); o[j][1] = bf2f(r.x >> 16); o[j][2] = bf2f(r.y & 0xffffu); o[j][3] = bf2f(r.y >> 16);
                ss += (o[j][0] * o[j][0] + o[j][1] * o[j][1]) + (o[j][2] * o[j][2] + o[j][3] * o[j][3]); }
            const float rstd = 1.0f / sqrtf(wave_sum(ss) * (1.0f / D) + NORM_EPS);
#pragma unroll
            for (int j = 0; j < 4; ++j) orow[64 * j] = xv[j] + o[j] * rstd * wg[j];
        }
    }
}

#define XB_TMO      128
#define XB_XCNT(j)  (256  + 64 * (j))
#define XB_XSUB(j)  (1280 + 64 * (j))
#define XB_XGEN(j)  (2304 + 64 * (j))
#define XB_TOP      3328
#define XB_TOPGEN   3392
#define XCD_BAR_WORDS 3456
#define XB_SPIN_CAP (1u << 18)

__device__ __forceinline__ unsigned xb_ld(unsigned* p)              { return __hip_atomic_load(p, __ATOMIC_RELAXED, __HIP_MEMORY_SCOPE_AGENT); }
__device__ __forceinline__ unsigned xb_add(unsigned* p, unsigned v) { return __hip_atomic_fetch_add(p, v, __ATOMIC_RELAXED, __HIP_MEMORY_SCOPE_AGENT); }
__device__ __forceinline__ unsigned xb_xcc_id() { return (unsigned)__builtin_amdgcn_s_getreg((3 << 11) | 20) & 0xFu; }
#define XB_SPIN(cond, bar) do { unsigned _sp = 0; while (cond) { __builtin_amdgcn_s_sleep(1); \
    if ((++_sp & 255u) == 0u) { if (xb_ld(&(bar)[XB_TMO])) break; if (_sp > XB_SPIN_CAP) { atomicAdd(&(bar)[XB_TMO], 1u); break; } } } } while (0)

struct XcdBarrier {
    unsigned* bar; unsigned x;
    volatile LAS unsigned* st;
};

__device__ __forceinline__ XcdBarrier xcd_barrier_post(unsigned* bar, volatile LAS unsigned* st) {
    XcdBarrier b; b.bar = bar; b.x = xb_xcc_id(); b.st = st;
    if (threadIdx.x == 0) (void)xb_add(&bar[XB_XCNT(b.x)], 1u);
    return b;
}
__device__ __forceinline__ void xcd_barrier_complete(unsigned* bar, unsigned x, unsigned& nloc, unsigned& nx) {
    const unsigned G = gridDim.x * gridDim.y * gridDim.z;
    unsigned sum, cnt, mine, sp = 0u;
    for (;;) {
        sum = 0u; cnt = 0u; mine = 0u;
#pragma unroll
        for (unsigned j = 0; j < 16; ++j) { const unsigned c = xb_ld(&bar[XB_XCNT(j)]); sum += c; cnt += (c > 0u) ? 1u : 0u; mine = (j == x) ? c : mine; }
        if (sum == G) break;
        __builtin_amdgcn_s_sleep(1);
        if ((++sp & 255u) == 0u) { if (xb_ld(&bar[XB_TMO])) break; if (sp > XB_SPIN_CAP) { atomicAdd(&bar[XB_TMO], 1u); break; } }
    }
    nloc = mine > 0u ? mine : 1u; nx = cnt > 0u ? cnt : 1u;
}

__device__ __forceinline__ void xcd_barrier(const XcdBarrier& b) {
    asm volatile("s_waitcnt vmcnt(0)" ::: "memory");
    __syncthreads();
    if (threadIdx.x == 0) {
        unsigned* bar = b.bar;
        __builtin_amdgcn_s_waitcnt(0);
        unsigned nloc = b.st[0], nx = b.st[1];
        if (nloc == 0u) { xcd_barrier_complete(bar, b.x, nloc, nx); b.st[0] = nloc; b.st[1] = nx; }
        const unsigned old = xb_add(&bar[XB_XSUB(b.x)], 1u);
        const unsigned gen = old / nloc;
        if (old + 1u == (gen + 1u) * nloc) {
            __builtin_amdgcn_fence(__ATOMIC_RELEASE, "agent");
            asm volatile("s_waitcnt vmcnt(0)" ::: "memory");
            const unsigned og = xb_add(&bar[XB_TOP], 1u);
            const unsigned tg = og / nx;
            if (og + 1u == (tg + 1u) * nx) xb_add(&bar[XB_TOPGEN], 1u);
            else XB_SPIN(xb_ld(&bar[XB_TOPGEN]) == tg, bar);
            __builtin_amdgcn_fence(__ATOMIC_ACQUIRE, "agent");
            xb_add(&bar[XB_XGEN(b.x)], 1u);
            asm volatile("s_waitcnt vmcnt(0)" ::: "memory");
        } else {
            XB_SPIN(xb_ld(&bar[XB_XGEN(b.x)]) == gen, bar);
            __builtin_amdgcn_fence(__ATOMIC_ACQUIRE, "agent");
            asm volatile("s_waitcnt vmcnt(0)" ::: "memory");
        }
    }
    __syncthreads();
}

__device__ __forceinline__ void signal_release(unsigned* ctr) {
    __builtin_amdgcn_fence(__ATOMIC_RELEASE, "agent"); asm volatile("s_waitcnt vmcnt(0)" ::: "memory"); (void)xb_add(ctr, 1u);
}
__device__ __forceinline__ void wait_acquire(unsigned* ctr, unsigned target, unsigned* bar) {
    if (threadIdx.x == 0) { XB_SPIN(xb_ld(ctr) < target, bar); __builtin_amdgcn_fence(__ATOMIC_ACQUIRE, "agent"); asm volatile("s_waitcnt vmcnt(0)" ::: "memory"); }
    __syncthreads();
}

struct Gemm1Order {
    int G, c; pg8::StaticOrder so;
    __device__ __forceinline__ void init(int G_, int c_) { G = G_; c = c_; so.init(MT, D_IN, G_, c_); }
    __device__ __forceinline__ bool next(int i, pg8::Unit& u) const {
        if (G != 256) return so.next(i, u);
        const int j = 32 * i + (c >> 3), x = c & 7; if (j >= 300) return false;
        if (j < 240) { const int grp = (j >= 120) ? 1 : 0, idx = j - 120 * grp; u.pm = 32 + 16 * x + 8 * grp + (idx & 7); u.pn = idx >> 3; }
        else { const int jj = j - 240; u.pm = 4 * x + (jj & 3); u.pn = jj >> 2; }
        return true;
    }
    __device__ __forceinline__ void a_ready(const pg8::Unit&) const {}
    __device__ __forceinline__ void done(const pg8::Unit&, int ui) const {
        if (G == 256 && ui == 7) { asm volatile("s_waitcnt vmcnt(0)" ::: "memory"); __builtin_amdgcn_s_barrier();
            if (threadIdx.x == 0) signal_release((unsigned*)(ws + CW_R1) + 64 * (c & 7)); }
    }
    unsigned char* ws;
};

constexpr int N_PHASES = 8;
__global__ void __launch_bounds__(NTHREADS, 2) fwd_kernel(Params P) {
    extern __shared__ __attribute__((aligned(16))) unsigned char lds_raw[];
    LAS unsigned char* lds = (LAS unsigned char*)lds_raw;
    const int tid = threadIdx.x, lane = tid & 63, wave = __builtin_amdgcn_readfirstlane(tid >> 6);
    const int G = gridDim.x, gw = blockIdx.x * NWAVES + wave, NGW = G * NWAVES;
    const int lo = P.ph_lo, hi = P.ph_hi;
    volatile LAS unsigned* bst = (volatile LAS unsigned*)(lds + LDS_BYTES - 16);
    if (tid < 2) bst[tid] = 0u;
    __syncthreads();
    XcdBarrier bar = xcd_barrier_post((unsigned*)P.ws, bst);
#define IN(k) (lo <= (k) && (k) < hi)
#define SEAM(k) do { if (IN(k) && IN((k) + 1)) xcd_barrier(bar); } while (0)
#define PP(name) const Params* name = (const Params*)__builtin_amdgcn_kernarg_segment_ptr(); asm volatile("" : "+s"(name))
    if (IN(0)) { PP(q); phase0(*q, lds, gw, NGW, wave, lane);
        if (G > 96) { if ((int)blockIdx.x >= 96) weight_copies(*q, lds, gw - 96 * NWAVES, NGW - 96 * NWAVES, wave, lane); }
        else weight_copies(*q, lds, gw, NGW, wave, lane); }
    SEAM(0);
    if (IN(1)) { PP(q); phase1(*q, gw, NGW, lane); }
    SEAM(1);
    if (IN(2)) { PP(q); unsigned char* ws = q->ws;
        pg8::Gemm g{(const pg8::bf16_t*)(ws + WS_H), (const pg8::bf16_t*)(ws + WS_WIN), MT, D_IN, D}; Gemm1Order S; S.init(G, (int)blockIdx.x); S.ws = ws;
        pg8::EpiBf16 E{(pg8::bf16_t*)(ws + WS_PROJ), D_IN, C_WD / 256};
        pg8::gemm_phase<pg8::EpiBf16, Gemm1Order, true, true>(lds, g, S, E);
        if (G == 256 && tid == 0) signal_release((unsigned*)(ws + CW_RALL)); }
    if (G != 256) SEAM(2);
    if (IN(3)) { PP(q); phase3(*q, lds); }
    SEAM(3);
    if (G == 256) { if (IN(4)) { PP(q); phase45(*q, lds, gw, NGW, wave, lane); } }
    else { if (IN(4)) { PP(q); phase35(*q, lds, gw, NGW, wave, lane); }
        SEAM(4);
        if (IN(5)) { PP(q); phase4(*q, gw, NGW, lane, 0, MT); } }
    SEAM(5);
    if (IN(6)) { PP(q); unsigned char* ws = q->ws;
        pg8::Gemm g{(const pg8::bf16_t*)(ws + WS_H), (const pg8::bf16_t*)(ws + WS_WOUT), MT, D, D}; pg8::StaticOrder S; S.init(MT, D, G, (int)blockIdx.x);
        pg8::EpiBf16 E{(pg8::bf16_t*)(ws + WS_OUTB), D, -1};
        pg8::gemm_phase<pg8::EpiBf16, pg8::StaticOrder, true, true>(lds, g, S, E); }
    SEAM(6);
    if (IN(7)) { PP(q); phase6(*q, gw, NGW, lane); }
#undef PP
#undef IN
#undef SEAM
}

#ifndef N_LAUNCHES
#define N_LAUNCHES 1
#endif
extern "C" void kernel_launch(void* const* d_in, const int* in_sizes, int n_in, void* d_out, int out_size, void* d_ws, size_t ws_size, hipStream_t stream) {
    static int grid = 0;
    if (grid == 0) {
        if (n_in != 26 || ws_size < WS_END) { fprintf(stderr, "kernel_launch: unexpected n_in %d / ws_size %zu (need %zu)\n", n_in, ws_size, (size_t)WS_END); grid = -1; return; }
        int dev = 0, cus = 0, per_cu = 0;
        hipGetDevice(&dev); hipDeviceGetAttribute(&cus, hipDeviceAttributeMultiprocessorCount, dev);
        if (hipFuncSetAttribute((const void*)fwd_kernel, hipFuncAttributeMaxDynamicSharedMemorySize, LDS_BYTES) != hipSuccess) { fprintf(stderr, "kernel_launch: hipFuncSetAttribute failed\n"); grid = -1; return; }
        if (hipOccupancyMaxActiveBlocksPerMultiprocessor(&per_cu, (const void*)fwd_kernel, NTHREADS, LDS_BYTES) != hipSuccess || per_cu < 1) { fprintf(stderr, "kernel_launch: occupancy query says %d\n", per_cu); per_cu = 1; }
        (void)hipGetLastError();
        grid = cus * 1;
        fprintf(stderr, "kernel_launch: cus %d per_cu %d grid %d\n", cus, per_cu, grid);
    }
    if (grid < 0) return;
    hipMemsetAsync((char*)d_ws + WS_CTL, 0, CTL_ZERO_BYTES, stream);
    Params p{};
    for (int i = 0; i < 26; ++i) p.in[i] = (const float*)d_in[i];
    p.out = (float*)d_out; p.ws = (unsigned char*)d_ws;
    if (N_LAUNCHES == 1) {
        p.ph_lo = 0; p.ph_hi = N_PHASES;
        hipLaunchKernelGGL(fwd_kernel, dim3(grid), dim3(NTHREADS), LDS_BYTES, stream, p);
    } else {
        for (int ph = 0; ph < N_PHASES; ++ph) { p.ph_lo = ph; p.ph_hi = ph + 1; hipLaunchKernelGGL(fwd_kernel, dim3(grid), dim3(NTHREADS), LDS_BYTES, stream, p); }
    }
}
```

```cpp
#include <hip/hip_runtime.h>
#include <cstdio>
#include <cstdint>
namespace pg8 {
#define PG8_LAS __attribute__((address_space(3)))
typedef unsigned short bf16_t;
typedef short bf16x8 __attribute__((ext_vector_type(8)));
typedef float f32x4 __attribute__((ext_vector_type(4)));
typedef unsigned u32x4 __attribute__((ext_vector_type(4)));
constexpr int BM = 256, BK = 64, HALF = 128, HTB = HALF * BK * 2  , STAGE_BYTES = 8 * HTB, NXCD = 8, WGM = 8;

__host__ __device__ __forceinline__ int lds_byte(int r, int c) { const int st = (r >> 4) * 2 + (c >> 5), rr = r & 15, cc = c & 31, ob = rr * 64 + cc * 2; return st * 1024 + (ob ^ (((ob >> 9) & 1) << 5)); }
__host__ __device__ __forceinline__ void stage_rc(int b, int& R, int& C) { const int st = b / 1024, sb = b % 1024, swz = sb ^ (((sb >> 9) & 1) << 5); R = (st >> 1) * 16 + swz / 64; C = (st & 1) * 32 + (swz % 64) / 2; }
__host__ __device__ __forceinline__ int perm32(int rho) { const int n = rho >> 4, i = rho & 15; return 8 * (i >> 2) + 4 * n + (i & 3); }

struct Unit { int pm, pn; };
struct Gemm { const bf16_t* A; const bf16_t* Bt; int M, N, K; };

struct StaticOrder {
    int nM, nN, nwg, G, c;
    __host__ __device__ void init(int M, int N, int G_, int c_) { nM = M / BM; nN = N / BM; nwg = nM * nN; G = G_; c = c_; }
    __host__ __device__ bool next(int i, Unit& u) const {
        const long L = (long)i * G + c; if (L >= nwg) return false;
        int wgid = (int)L; { const int q = nwg / NXCD, r = nwg % NXCD, xcd = wgid % NXCD, off = wgid / NXCD; wgid = (xcd < r ? xcd * (q + 1) : r * (q + 1) + (xcd - r) * q) + off; }
        const int nig = WGM * nN, gid = wgid / nig, fm = gid * WGM, gsz = (nM - fm) < WGM ? (nM - fm) : WGM;
        u.pm = fm + ((wgid % nig) % gsz); u.pn = (wgid % nig) / gsz; return true;
    }
    __device__ __forceinline__ void a_ready(const Unit&) const {}
    __device__ __forceinline__ void done(const Unit&, int) const {}
};
typedef float f32x2p __attribute__((ext_vector_type(2)));
typedef __bf16 bf16x2p __attribute__((ext_vector_type(2)));
__device__ __forceinline__ unsigned cvt_pk_bf16(float lo, float hi) { f32x2p v; v.x = lo; v.y = hi; return __builtin_bit_cast(unsigned, __builtin_convertvector(v, bf16x2p)); }
struct EpiBf16 {
    static constexpr bool PERM = true, AFTER_DRAIN = false;
    bf16_t* O; int ldc; int tanh_pn;
    __device__ __forceinline__ void operator()(const f32x4 (&acc)[2][2][4][2], const Unit& u, int wr, int wc, int fr, int fq) const {
        const int row0 = u.pm * BM + wr * 64 + fr, col0 = u.pn * BM + wc * 32 + 8 * fq;
#pragma unroll
        for (int ai = 0; ai < 2; ++ai)
#pragma unroll
            for (int m = 0; m < 4; ++m) { bf16_t* rowp = O + (size_t)(row0 + ai * HALF + m * 16) * ldc + col0;
#pragma unroll
                for (int bj = 0; bj < 2; ++bj) { f32x4 v0 = acc[ai][bj][m][0], v1 = acc[ai][bj][m][1];
                    if (bj == 0 && u.pn == tanh_pn) {
#pragma unroll
                        for (int j = 0; j < 4; ++j) { v0[j] = 1.0f - 2.0f * __builtin_amdgcn_rcpf(1.0f + __builtin_amdgcn_exp2f(2.88539008f * v0[j])); v1[j] = 1.0f - 2.0f * __builtin_amdgcn_rcpf(1.0f + __builtin_amdgcn_exp2f(2.88539008f * v1[j])); } }
                    u32x4 w; w.x = cvt_pk_bf16(v0[0], v0[1]); w.y = cvt_pk_bf16(v0[2], v0[3]); w.z = cvt_pk_bf16(v1[0], v1[1]); w.w = cvt_pk_bf16(v1[2], v1[3]);
                    *(u32x4*)(rowp + bj * HALF) = w; } }
    }
};
struct EpiF32 {
    static constexpr bool PERM = false, AFTER_DRAIN = false;
    float* C; int ldc;
    __device__ __forceinline__ void operator()(const f32x4 (&acc)[2][2][4][2], const Unit& u, int wr, int wc, int fr, int fq) const {
        const int row0 = u.pm * BM + wr * 64 + fr, col0 = u.pn * BM + wc * 32 + 4 * fq;
#pragma unroll
        for (int ai = 0; ai < 2; ++ai)
#pragma unroll
            for (int m = 0; m < 4; ++m) { float* rowp = C + (size_t)(row0 + ai * HALF + m * 16) * ldc + col0;
#pragma unroll
                for (int bj = 0; bj < 2; ++bj)
#pragma unroll
                    for (int n = 0; n < 2; ++n) *(f32x4*)(rowp + bj * HALF + n * 16) = acc[ai][bj][m][n]; }
    }
};
template <class Epi, class Sched, bool ALIGN_EPI = false, bool SP2 = false>
__device__ __forceinline__ void gemm_phase(PG8_LAS unsigned char* lds, const Gemm g, const Sched& S, const Epi& E) {
    const int tid = threadIdx.x, wid = __builtin_amdgcn_readfirstlane(tid >> 6), lane = tid & 63, wr = wid >> 2, wc = wid & 3, fr = lane & 15, fq = lane >> 4;
    const int K = g.K, nt = K / BK;
    unsigned voffA[2], voffB[2];
#pragma unroll
    for (int i = 0; i < 2; ++i) { int R, C; stage_rc(tid * 16 + i * 8192, R, C); const int Rb = Epi::PERM ? ((R & ~31) + perm32(R & 31)) : R;
        voffA[i] = (unsigned)(R * K + C) * 2u; voffB[i] = (unsigned)(Rb * K + C) * 2u; }
    const size_t kstep = (size_t)(BK * 2);
    const size_t hstep = (size_t)HALF * K * 2;
    const size_t tstep = 2 * hstep;
    const unsigned ldsw = (unsigned)wid * 1024u;
    const int aoff = lds_byte(wr * 64 + fr, fq * 8), boff = lds_byte(wc * 32 + fr, fq * 8);
#define PG8_SA(b, h) (((b) * 2 + (h)) * HTB)
#define PG8_SB(b, h) ((4 + (b) * 2 + (h)) * HTB)
#define PG8_STAGE(bufoff, gbase, voff) do { _Pragma("unroll") for (int _i = 0; _i < 2; ++_i) \
        __builtin_amdgcn_global_load_lds((const unsigned*)((const char*)(gbase) + (voff)[_i]), (PG8_LAS unsigned*)(lds + (bufoff) + ldsw + _i * 8192), 16, 0, 0); } while (0)
#define PG8_LDA(dst, b, h) do { _Pragma("unroll") for (int m = 0; m < 4; ++m) _Pragma("unroll") for (int k = 0; k < 2; ++k) dst[m][k] = *(const PG8_LAS bf16x8*)(lds + PG8_SA(b, h) + aoff + m * 2048 + k * 1024); } while (0)
#define PG8_LDB(dst, b, h) do { _Pragma("unroll") for (int n = 0; n < 2; ++n) _Pragma("unroll") for (int k = 0; k < 2; ++k) dst[n][k] = *(const PG8_LAS bf16x8*)(lds + PG8_SB(b, h) + boff + n * 2048 + k * 1024); } while (0)
#define PG8_MMA(ai, bj, At, Bt) do { __builtin_amdgcn_s_setprio(1); _Pragma("unroll") for (int m = 0; m < 4; ++m) _Pragma("unroll") for (int n = 0; n < 2; ++n) _Pragma("unroll") for (int k = 0; k < 2; ++k) \
        acc[ai][bj][m][n] = __builtin_amdgcn_mfma_f32_16x16x32_bf16(Bt[n][k], At[m][k], acc[ai][bj][m][n], 0, 0, 0); __builtin_amdgcn_s_setprio(0); } while (0)
#define PG8_WAIT_V(n) asm volatile("s_waitcnt vmcnt(" #n ")" ::: "memory")
#define PG8_WAIT_L(n) asm volatile("s_waitcnt lgkmcnt(" #n ")" ::: "memory")
#define PG8_BAR __builtin_amdgcn_s_barrier()
#define PG8_SCHED __builtin_amdgcn_sched_barrier(0)
    Unit cur, nxt; int ui = 0;
    if (!S.next(0, cur)) return;
    f32x4 acc[2][2][4][2];
#pragma unroll
    for (int a = 0; a < 2; ++a)
#pragma unroll
        for (int b = 0; b < 2; ++b)
#pragma unroll
            for (int m = 0; m < 4; ++m)
#pragma unroll
                for (int n = 0; n < 2; ++n) acc[a][b][m][n] = (f32x4){0.f, 0.f, 0.f, 0.f};
    bf16x8 At[4][2], B0[2][2], B1[2][2];
    const char* cA = (const char*)g.A + (size_t)cur.pm * tstep; const char* cB = (const char*)g.Bt + (size_t)cur.pn * tstep;
    S.a_ready(cur);
    if constexpr (SP2) {
        PG8_STAGE(PG8_SB(0, 0), cB, voffB); PG8_STAGE(PG8_SB(0, 1), cB + hstep, voffB); PG8_STAGE(PG8_SA(0, 0), cA, voffA); PG8_STAGE(PG8_SA(0, 1), cA + hstep, voffA);
        if (wr == 1) PG8_BAR;
        PG8_WAIT_V(2); PG8_BAR;
        PG8_STAGE(PG8_SB(1, 0), cB + kstep, voffB); PG8_STAGE(PG8_SA(1, 0), cA + kstep, voffA); PG8_STAGE(PG8_SB(1, 1), cB + hstep + kstep, voffB);
        PG8_WAIT_V(6); PG8_BAR;
    } else {
        PG8_STAGE(PG8_SB(0, 0), cB, voffB); PG8_STAGE(PG8_SA(0, 0), cA, voffA); PG8_STAGE(PG8_SB(0, 1), cB + hstep, voffB); PG8_STAGE(PG8_SA(0, 1), cA + hstep, voffA);
        if (wr == 1) PG8_BAR;
        PG8_WAIT_V(4); PG8_BAR;
        PG8_STAGE(PG8_SB(1, 0), cB + kstep, voffB); PG8_STAGE(PG8_SA(1, 0), cA + kstep, voffA); PG8_STAGE(PG8_SB(1, 1), cB + hstep + kstep, voffB);
        PG8_WAIT_V(6); PG8_BAR;
    }
    for (;;) {
        const bool has_next = S.next(ui + 1, nxt);
        const char* nA = has_next ? (const char*)g.A + (size_t)nxt.pm * tstep : cA; const char* nB = has_next ? (const char*)g.Bt + (size_t)nxt.pn * tstep : cB;
        for (int t = 0; t < nt; t += 2) {
            const bool last = (t == nt - 2);
            const char* a1 = cA + (size_t)(t + 1) * kstep;
            const char* a2 = last ? nA : cA + (size_t)(t + 2) * kstep; const char* b2 = last ? nB : cB + (size_t)(t + 2) * kstep;
            const char* a3 = a2 + kstep; const char* b3 = b2 + kstep;
            if (last && has_next) S.a_ready(nxt);
            if constexpr (SP2) {
            PG8_LDB(B0, 0, 0); PG8_LDB(B1, 0, 1); PG8_SCHED; PG8_LDA(At, 0, 0); PG8_STAGE(PG8_SA(1, 1), a1 + hstep, voffA);
            PG8_WAIT_V(8); PG8_WAIT_L(0); PG8_BAR; PG8_MMA(0, 0, At, B0); PG8_MMA(0, 1, At, B1); PG8_BAR; PG8_SCHED;
            PG8_LDA(At, 0, 1); PG8_STAGE(PG8_SB(0, 0), b2, voffB); PG8_STAGE(PG8_SB(0, 1), b2 + hstep, voffB); PG8_STAGE(PG8_SA(0, 0), a2, voffA);
            PG8_WAIT_V(8); PG8_WAIT_L(0); PG8_BAR; PG8_MMA(1, 0, At, B0); PG8_MMA(1, 1, At, B1); PG8_BAR; PG8_SCHED;
            PG8_LDB(B0, 1, 0); PG8_LDB(B1, 1, 1); PG8_SCHED; PG8_LDA(At, 1, 0); PG8_STAGE(PG8_SA(0, 1), a2 + hstep, voffA);
            PG8_WAIT_V(8); PG8_WAIT_L(0); PG8_BAR; PG8_MMA(0, 0, At, B0); PG8_MMA(0, 1, At, B1); PG8_BAR; PG8_SCHED;
            PG8_LDA(At, 1, 1); PG8_STAGE(PG8_SB(1, 0), b3, voffB); PG8_STAGE(PG8_SB(1, 1), b3 + hstep, voffB); PG8_STAGE(PG8_SA(1, 0), a3, voffA);
            PG8_WAIT_V(8); PG8_WAIT_L(0); PG8_BAR; PG8_MMA(1, 0, At, B0); PG8_MMA(1, 1, At, B1); PG8_BAR; PG8_SCHED;
            } else {
            PG8_LDB(B0, 0, 0); PG8_SCHED; PG8_LDA(At, 0, 0); PG8_STAGE(PG8_SA(1, 1), a1 + hstep, voffA);
            PG8_WAIT_L(8); PG8_BAR; PG8_WAIT_L(0); PG8_MMA(0, 0, At, B0); PG8_BAR; PG8_SCHED;
            PG8_LDB(B1, 0, 1); PG8_STAGE(PG8_SB(0, 0), b2, voffB);
            PG8_BAR; PG8_WAIT_L(0); PG8_MMA(0, 1, At, B1); PG8_BAR;
            PG8_LDA(At, 0, 1); PG8_STAGE(PG8_SA(0, 0), a2, voffA);
            PG8_BAR; PG8_WAIT_L(0); PG8_MMA(1, 0, At, B0); PG8_BAR; PG8_SCHED;
            PG8_STAGE(PG8_SB(0, 1), b2 + hstep, voffB);
            PG8_WAIT_V(6); PG8_BAR; PG8_MMA(1, 1, At, B1); PG8_BAR;
            PG8_LDB(B0, 1, 0); PG8_SCHED; PG8_LDA(At, 1, 0); PG8_STAGE(PG8_SA(0, 1), a2 + hstep, voffA);
            PG8_WAIT_L(8); PG8_BAR; PG8_WAIT_L(0); PG8_MMA(0, 0, At, B0); PG8_BAR; PG8_SCHED;
            PG8_LDB(B1, 1, 1); PG8_STAGE(PG8_SB(1, 0), b3, voffB);
            PG8_BAR; PG8_WAIT_L(0); PG8_MMA(0, 1, At, B1); PG8_BAR;
            PG8_LDA(At, 1, 1); PG8_STAGE(PG8_SA(1, 0), a3, voffA);
            PG8_BAR; PG8_WAIT_L(0); PG8_MMA(1, 0, At, B0); PG8_BAR; PG8_SCHED;
            PG8_STAGE(PG8_SB(1, 1), b3 + hstep, voffB);
            PG8_WAIT_V(6); PG8_BAR; PG8_MMA(1, 1, At, B1); PG8_BAR;
            }
        }
        if constexpr (ALIGN_EPI) { if (wr == 0) PG8_BAR; }
        if constexpr (!Epi::AFTER_DRAIN) { E(acc, cur, wr, wc, fr, fq); S.done(cur, ui); }
        if (!has_next) break;
#pragma unroll
        for (int a = 0; a < 2; ++a)
#pragma unroll
            for (int b = 0; b < 2; ++b)
#pragma unroll
                for (int m = 0; m < 4; ++m)
#pragma unroll
                    for (int n = 0; n < 2; ++n) acc[a][b][m][n] = (f32x4){0.f, 0.f, 0.f, 0.f};
        cur = nxt; cA = nA; cB = nB; ++ui;
        if constexpr (ALIGN_EPI) { if (wr == 1) PG8_BAR; }
    }
    PG8_WAIT_V(0);
    if constexpr (!ALIGN_EPI) { if (wr == 0) PG8_BAR; }
    PG8_BAR;
    if constexpr (Epi::AFTER_DRAIN) { E.fused(acc, cur, wr, wc, fr, fq, lds, wid, lane); S.done(cur, ui); }
#undef PG8_SA
#undef PG8_SB
#undef PG8_STAGE
#undef PG8_LDA
#undef PG8_LDB
#undef PG8_MMA
#undef PG8_WAIT_V
#undef PG8_WAIT_L
#undef PG8_BAR
#undef PG8_SCHED
}
}

constexpr int D = 1024, M_CTX = 32 * 256, M_LAT = 8 * 4096, MT = M_CTX + M_LAT;
constexpr int L_CTX = 256, L_LAT = 4096, NB_CTX = 32, NB_LAT = 8;
constexpr int D_IN = 3840, D_A = 512, NH = 8, HD = 64;
constexpr int C_R = 0, C_K = 512, C_V = 1024, C_ZA = 1536, C_WD = 2048, C_AD = 2176, C_U = 2304, C_VB = 2816, C_ZB = 3328;
constexpr float NORM_EPS = 1e-6f, GN_EPS = 6.4e-4f;
constexpr size_t STATE_ELEMS = (size_t)NB_CTX * NH * HD * HD;

constexpr size_t MiB = 1u << 20;
constexpr size_t WS_CTL = 0, CTL_ZERO_BYTES = 192 * 1024;
constexpr size_t CW_QUEUE = 15 * 1024;
constexpr size_t WS_MOD = 64 * 1024;
constexpr size_t WS_WIN = 1 * MiB;
constexpr size_t WS_WOUT = 9 * MiB;
constexpr size_t WS_WSB = 11 * MiB;
constexpr size_t WS_BS = 12 * MiB;
constexpr size_t WS_H = 16 * MiB;
constexpr size_t WS_PROJ = 96 * MiB;
constexpr size_t WS_OUTB = WS_PROJ;
constexpr size_t WS_G = WS_PROJ + (size_t)MT * D_IN * 2;
constexpr size_t WS_HMID = WS_G + (size_t)128 * 2048 * 64 * 2;
constexpr size_t WS_CORR = WS_HMID + (size_t)128 * 4096 * 2;
constexpr size_t WS_END = WS_CORR + (size_t)M_LAT * 512 * 2;
static_assert(WS_WIN + (size_t)D_IN * D * 2 <= WS_WOUT && WS_BS + (size_t)2 * MT * 8 * 4 <= WS_H && WS_H + (size_t)MT * D * 2 <= WS_PROJ, "ws map");

constexpr int LDS_BYTES = 163840;
constexpr int NWAVES = 8, NTHREADS = 512;

#define LAS __attribute__((address_space(3)))
#define GAS __attribute__((address_space(1)))
typedef unsigned short bf16;
typedef float f32x4 __attribute__((ext_vector_type(4)));
typedef short bf16x8 __attribute__((ext_vector_type(8)));
typedef unsigned u32x4v __attribute__((ext_vector_type(4)));
typedef unsigned u32x2v __attribute__((ext_vector_type(2)));

__device__ __forceinline__ float bf2f(unsigned b) { return __uint_as_float(b << 16); }
__device__ __forceinline__ unsigned f2bf(float f) { unsigned u = __float_as_uint(f); return (u + 0x7fffu + ((u >> 16) & 1u)) >> 16; }
__device__ __forceinline__ unsigned pk2(float lo, float hi) { return f2bf(lo) | (f2bf(hi) << 16); }
template <int CTRL> __device__ __forceinline__ float dpp_f(float v) { return __int_as_float(__builtin_amdgcn_update_dpp(0, __float_as_int(v), CTRL, 0xf, 0xf, true)); }
__device__ __forceinline__ float quad_sum4(float v) { v += dpp_f<0xB1>(v); v += dpp_f<0x4E>(v); return v; }
__device__ __forceinline__ float wave_sum(float v) {
    v += dpp_f<0xB1>(v); v += dpp_f<0x4E>(v);
    v += dpp_f<0x141>(v); v += dpp_f<0x140>(v);
    v += __int_as_float(__builtin_amdgcn_ds_swizzle(__float_as_int(v), 0x401F));
    return __int_as_float(__builtin_amdgcn_readlane(__float_as_int(v), 0)) + __int_as_float(__builtin_amdgcn_readlane(__float_as_int(v), 32));
}
__device__ __forceinline__ float silu_f(float x) { return x / (1.0f + __expf(-x)); }
__device__ __forceinline__ float sigmoid_f(float x) { return 1.0f / (1.0f + __expf(-x)); }

struct Params { const float* in[26]; float* out; unsigned char* ws; int ph_lo, ph_hi; };

enum { I_XP = 0, I_XS, I_C, I_SF, I_SB, I_CCTX, I_LNPRE, I_LNPOST, I_WMOD, I_BMOD, I_WIN, I_TSMU, I_W0, I_WUP, I_A0, I_AUP, I_KK, I_KA, I_RK, I_GNW, I_GNB, I_SLG, I_SLB, I_WS, I_BSS, I_WOUT };

__device__ __forceinline__ void transpose_item(const float* W, int K, int N, bf16* WT, LAS float* scr, int item, int lane) {
    const int nblk = N / 32, kb = item / nblk, nb = item % nblk, k0 = 64 * kb, n0 = 32 * nb;
    float tv[32];
#pragma unroll
    for (int i = 0; i < 32; ++i) tv[i] = ((const GAS float*)W)[(size_t)(k0 + 2 * i + (lane >> 5)) * N + n0 + (lane & 31)];
#pragma unroll
    for (int i = 0; i < 32; ++i) scr[(2 * i + (lane >> 5)) * 33 + (lane & 31)] = tv[i];
    asm volatile("s_waitcnt lgkmcnt(0)" ::: "memory");
    const int c = lane & 7;
#pragma unroll
    for (int j = 0; j < 4; ++j) { const int n = (lane >> 3) + 8 * j; const LAS float* s = scr + (8 * c) * 33 + n;
        u32x4v o; o.x = pk2(s[0 * 33], s[1 * 33]); o.y = pk2(s[2 * 33], s[3 * 33]); o.z = pk2(s[4 * 33], s[5 * 33]); o.w = pk2(s[6 * 33], s[7 * 33]);
        *(u32x4v*)(WT + (size_t)(n0 + n) * K + k0 + 8 * c) = o; }
    asm volatile("s_waitcnt lgkmcnt(0)" ::: "memory");
}

__device__ __forceinline__ void phase0(const Params& P, LAS unsigned char* lds, int gw, int NGW, int wave, int lane) {
    unsigned char* ws = P.ws;
    float* mod = (float*)(ws + WS_MOD);
    const float* w_mod = P.in[I_WMOD]; const float* b_mod = P.in[I_BMOD]; const float* cc = P.in[I_C]; const float* cctx = P.in[I_CCTX];
    if (blockIdx.x < 96 && gridDim.x >= 96) {
        const int cgp = blockIdx.x % 12, rg = blockIdx.x / 12, col = cgp * 256 + lane * 4, r0 = rg * 128 + wave * 16;
        f32x4 acc[9];
#pragma unroll
        for (int v = 0; v < 9; ++v) acc[v] = (f32x4){0.f, 0.f, 0.f, 0.f};
        f32x4 w[16];
#pragma unroll
        for (int i = 0; i < 16; ++i) w[i] = *(const GAS f32x4*)((const GAS float*)w_mod + (size_t)(r0 + i) * 3072 + col);
#pragma unroll
        for (int i = 0; i < 16; ++i) {
#pragma unroll
            for (int v = 0; v < 9; ++v) { const float cv = (v == 0) ? cctx[r0 + i] : cc[(v - 1) * 1024 + r0 + i]; acc[v] += silu_f(cv) * w[i]; }
        }
        LAS f32x4* red = (LAS f32x4*)lds;
#pragma unroll
        for (int v = 0; v < 9; ++v) red[(wave * 9 + v) * 64 + lane] = acc[v];
        __syncthreads();
        for (int idx = wave * 64 + lane; idx < 9 * 64; idx += 512) {
            f32x4 s = red[idx];
#pragma unroll
            for (int w2 = 1; w2 < 8; ++w2) s += red[w2 * 576 + idx];
            const int v = idx >> 6, l = idx & 63, c2 = cgp * 256 + l * 4;
            if (rg == 0) s += *(const f32x4*)(b_mod + c2);
#pragma unroll
            for (int e = 0; e < 4; ++e) atomicAdd(mod + v * 3072 + c2 + e, s[e]);
        }
        __syncthreads();
    } else if (gridDim.x < 96) {
        for (int task = gw; task < 12 * 64; task += NGW) {
            const int cgp = task % 12, rs = task / 12, col = cgp * 256 + lane * 4;
            f32x4 acc[9];
#pragma unroll
            for (int v = 0; v < 9; ++v) acc[v] = (f32x4){0.f, 0.f, 0.f, 0.f};
            for (int i = rs * 16; i < rs * 16 + 16; ++i) { const f32x4 w = *(const GAS f32x4*)((const GAS float*)w_mod + (size_t)i * 3072 + col);
#pragma unroll
                for (int v = 0; v < 9; ++v) { const float cv = (v == 0) ? cctx[i] : cc[(v - 1) * 1024 + i]; acc[v] += silu_f(cv) * w; } }
            if (rs == 0) { const f32x4 b = *(const f32x4*)(b_mod + col);
#pragma unroll
                for (int v = 0; v < 9; ++v) acc[v] += b; }
#pragma unroll
            for (int v = 0; v < 9; ++v)
#pragma unroll
                for (int e = 0; e < 4; ++e) atomicAdd(mod + v * 3072 + col + e, acc[v][e]);
        }
    }
}

__device__ __forceinline__ void weight_copies(const Params& P, LAS unsigned char* lds, int gw, int NGW, int wave, int lane) {
    unsigned char* ws = P.ws;
    LAS float* scr = (LAS float*)(lds + wave * 16384);
    constexpr int I_1 = (D / 64) * (D_IN / 32), I_2 = (D / 64) * (D / 32);
    for (int it = gw; it < I_1 + I_2; it += NGW) {
        if (it < I_1) transpose_item(P.in[I_WIN], D, D_IN, (bf16*)(ws + WS_WIN), scr, it, lane);
        else transpose_item(P.in[I_WOUT], D, D, (bf16*)(ws + WS_WOUT), scr, it - I_1, lane);
    }
    { const float* w_s = P.in[I_WS]; bf16* wsb = (bf16*)(ws + WS_WSB);
      for (int i = gw * 64 + lane; i < 8 * 128 * 128 / 4; i += NGW * 64) { const f32x4 v = *(const f32x4*)(w_s + (size_t)i * 4); u32x2v o; o.x = pk2(v[0], v[1]); o.y = pk2(v[2], v[3]); *(u32x2v*)(wsb + (size_t)i * 4) = o; } }
}


__device__ __forceinline__ const GAS float* x_row(const Params& P, int m) { return (const GAS float*)(m < M_CTX ? P.in[I_XP] + (size_t)m * D : P.in[I_XS] + (size_t)(m - M_CTX) * D); }
__device__ __forceinline__ int mod_index(int m) { return m < M_CTX ? 0 : 1 + (m - M_CTX) / L_LAT; }

__device__ __forceinline__ void phase1(const Params& P, int gw, int NGW, int lane) {
    const GAS float* mod = (const GAS float*)(P.ws + WS_MOD); const GAS float* ln_pre = (const GAS float*)P.in[I_LNPRE]; GAS bf16* H = (GAS bf16*)(P.ws + WS_H);
#pragma unroll 1
    for (int seg = 0; seg < 9; ++seg) {
        const int m_lo = (seg == 0) ? 0 : M_CTX + (seg - 1) * L_LAT, m_hi = (seg == 0) ? M_CTX : m_lo + L_LAT;
        const GAS float* shift = mod + seg * 3072; const GAS float* scale = shift + 1024;
        f32x4 gs[4], sh[4];
#pragma unroll
        for (int j = 0; j < 4; ++j) { const int col = 4 * (lane + 64 * j); gs[j] = *(const GAS f32x4*)(ln_pre + col) * (1.0f + *(const GAS f32x4*)(scale + col)); sh[j] = *(const GAS f32x4*)(shift + col); }
        for (int m = m_lo + gw; m < m_hi; m += NGW) {
            const GAS f32x4* xr = (const GAS f32x4*)x_row(P, m) + lane;
            f32x4 v[4]; float ss = 0.f;
#pragma unroll
            for (int j = 0; j < 4; ++j) { v[j] = xr[64 * j]; ss += (v[j].x * v[j].x + v[j].y * v[j].y) + (v[j].z * v[j].z + v[j].w * v[j].w); }
            const float rstd = 1.0f / sqrtf(wave_sum(ss) * (1.0f / D) + NORM_EPS);
            GAS u32x2v* o8 = (GAS u32x2v*)(H + (size_t)m * D) + lane;
#pragma unroll
            for (int j = 0; j < 4; ++j) { const f32x4 o = v[j] * rstd * gs[j] + sh[j]; u32x2v w; w.x = pk2(o.x, o.y); w.y = pk2(o.z, o.w); o8[64 * j] = w; }
        }
    }
}

constexpr int CH_RKV_LD = 200, CH_TW_LD = 72, CH_I1_LD = 72, CH_I2_LD = 40, CH_G_LD = 40;
constexpr int CH_RKV = 0, CH_TW = 26400, CH_AD = 35616, CH_WUPT = 44832, CH_AUPT = 54048, CH_IMG = 63264, CH_IMG_STRIDE = 30720;
constexpr int CH_GRAM_STRIDE = 17920;
constexpr int CH_HF = 124704, CH_N2 = 141088, CH_EC = 141344, CH_BPART = 141856, CH_KTAB = 142880, CH_HF2 = 143648, CH_END = 160032;
static_assert(2 * CH_GRAM_STRIDE <= CH_WUPT && CH_IMG + 2 * CH_IMG_STRIDE == CH_HF && CH_END <= LDS_BYTES - 64, "chain LDS map");

typedef unsigned short us4 __attribute__((ext_vector_type(4)));
#define MFMA16(a, b, c) __builtin_amdgcn_mfma_f32_16x16x32_bf16((a), (b), (c), 0, 0, 0)
__device__ __forceinline__ bf16x8 ldfrag(const LAS bf16* img, int ld, int row0, int k0, int lane) { return *(const LAS bf16x8*)(img + (row0 + (lane & 15)) * ld + k0 + 8 * (lane >> 4)); }
typedef float f32x2c __attribute__((ext_vector_type(2)));
typedef __bf16 bf16x2c __attribute__((ext_vector_type(2)));
__device__ __forceinline__ unsigned cvtpk(float lo, float hi) { f32x2c v; v.x = lo; v.y = hi; return __builtin_bit_cast(unsigned, __builtin_convertvector(v, bf16x2c)); }
__device__ __forceinline__ void st_nm(LAS bf16* img, int ld, int n0, int m0, f32x4 c, int lane) {
    u32x2v o; o.x = cvtpk(c[0], c[1]); o.y = cvtpk(c[2], c[3]); *(LAS u32x2v*)(img + (n0 + (lane & 15)) * ld + m0 + 4 * (lane >> 4)) = o; }
__device__ __forceinline__ void st_mn(LAS bf16* img, int ld, int m0, int n0, f32x4 c, int lane) {
#pragma unroll
    for (int e = 0; e < 4; e += 2) { const unsigned w = cvtpk(c[e], c[e + 1]); LAS bf16* p = img + (m0 + 4 * (lane >> 4) + e) * ld + n0 + (lane & 15); p[0] = (bf16)(w & 0xffffu); p[ld] = (bf16)(w >> 16); } }
__device__ __forceinline__ float fast_sigmoid(float x) { return __builtin_amdgcn_rcpf(1.0f + __builtin_amdgcn_exp2f(-1.44269504f * x)); }
__device__ __forceinline__ float fast_tanh(float x) { return 1.0f - 2.0f * __builtin_amdgcn_rcpf(1.0f + __builtin_amdgcn_exp2f(2.88539008f * x)); }
__device__ __forceinline__ float row16_sum(float v) { v += dpp_f<0xB1>(v); v += dpp_f<0x4E>(v); v += dpp_f<0x141>(v); v += dpp_f<0x140>(v); return v; }
__device__ __forceinline__ float oct_sum(float v) { v += dpp_f<0xB1>(v); v += dpp_f<0x4E>(v); v += dpp_f<0x141>(v); return v; }

typedef short bf16x4 __attribute__((ext_vector_type(4)));
#define MF16(a, b, c) __builtin_amdgcn_mfma_f32_16x16x16bf16_1k((a), (b), (c), 0, 0, 0)
__device__ __forceinline__ bf16x4 frag4(f32x4 c) { u32x2v o; o.x = cvtpk(c[0], c[1]); o.y = cvtpk(c[2], c[3]); return __builtin_bit_cast(bf16x4, o); }
__device__ __forceinline__ bf16x4 ldfrag4(const LAS bf16* img, int ld, int row0, int k0, int lane) { return *(const LAS bf16x4*)(img + (row0 + (lane & 15)) * ld + k0 + 4 * (lane >> 4)); }
typedef short s16x4c __attribute__((ext_vector_type(4)));
__device__ __forceinline__ bf16x8 ldfrag_tr(const LAS bf16* img, int ld, int col0, int k0, int lane) {
    const LAS bf16* p = img + (k0 + 8 * (lane >> 4) + ((lane & 15) >> 2)) * ld + col0 + 4 * (lane & 3);
    const s16x4c lo = __builtin_amdgcn_ds_read_tr16_b64_v4i16((LAS s16x4c*)p), hi = __builtin_amdgcn_ds_read_tr16_b64_v4i16((LAS s16x4c*)(p + 4 * ld));
    return (bf16x8){lo[0], lo[1], lo[2], lo[3], hi[0], hi[1], hi[2], hi[3]}; }
__device__ __forceinline__ bf16x4 ldfrag4_tr(const LAS bf16* img, int ld, int col0, int k0, int lane) {
    const LAS bf16* p = img + (k0 + 4 * (lane >> 4) + ((lane & 15) >> 2)) * ld + col0 + 4 * (lane & 3);
    return __builtin_bit_cast(bf16x4, __builtin_amdgcn_ds_read_tr16_b64_v4i16((LAS s16x4c*)p)); }
#define OPQ(v) asm volatile("" : "+v"(v))
struct RawRegs { u32x4v v[6]; };
__device__ __forceinline__ void chain_prefetch(RawRegs& R, const GAS bf16* proj, int m0, int L, int h, int dir, int ss, int tid, int p0) {
    OPQ(tid);
    const int qm = tid >> 3, pc = tid & 7, p = p0 + ss * 64 + qm, t = dir ? (L - 1 - p) : p;
    const GAS bf16* row = proj + (size_t)(m0 + t) * D_IN;
#pragma unroll
    for (int x = 0; x < 3; ++x) R.v[x] = *(const GAS u32x4v*)(row + x * 512 + h * 64 + pc * 8);
    R.v[4] = *(const GAS u32x4v*)(row + C_WD + dir * 64 + pc * 8);
    R.v[5] = *(const GAS u32x4v*)(row + C_AD + dir * 64 + pc * 8);
    u32x4v hv = (u32x4v){0u, 0u, 0u, 0u};
    if (tid < 48) { const int hi = tid >= 24, rem = hi ? tid - 24 : tid, x = rem >> 3, pc2 = rem & 7, ph = hi ? p0 + ss * 64 + 64 : p0 + ss * 64 - 1;
        if (ph >= 0 && ph < L) { const int th = dir ? (L - 1 - ph) : ph; hv = *(const GAS u32x4v*)(proj + (size_t)(m0 + th) * D_IN + x * 512 + h * 64 + pc2 * 8); } }
    R.v[3] = hv;
}
__device__ __forceinline__ void chain_stage_raw(const RawRegs& R, LAS unsigned char* lds, int tid) {
    OPQ(tid);
    const int qm = tid >> 3, pc = tid & 7;
#pragma unroll
    for (int x = 0; x < 3; ++x) *(LAS u32x4v*)(lds + CH_RKV + ((qm + 1) * CH_RKV_LD + x * 64 + pc * 8) * 2) = R.v[x];
    if (tid < 48) { const int hi = tid >= 24, rem = hi ? tid - 24 : tid, x = rem >> 3, pc2 = rem & 7;
        *(LAS u32x4v*)(lds + CH_RKV + ((hi ? 65 : 0) * CH_RKV_LD + x * 64 + pc2 * 8) * 2) = R.v[3]; }
    *(LAS u32x4v*)(lds + CH_TW + (qm * CH_TW_LD + pc * 8) * 2) = R.v[4];
    *(LAS u32x4v*)(lds + CH_AD + (qm * CH_TW_LD + pc * 8) * 2) = R.v[5];
}

__device__ __forceinline__ void do_chain(const Params& P, LAS unsigned char* lds, int m0, int L, int h, int dir, const float* s0, float* sfin, int p0, int npt, int mode, int chain) {
    const int tid = threadIdx.x, lane0 = tid & 63, wave = __builtin_amdgcn_readfirstlane(tid >> 6);
    const int grp = wave >> 2, cc = wave & 3;
#define STAGE_LANE() int ln_ = lane0; OPQ(ln_); const int lane = ln_, lr = lane & 15, lg = lane >> 4, c = 16 * cc + lr, vcol = c; (void)lr; (void)lg; (void)c; (void)vcol
    const GAS bf16* proj = (const GAS bf16*)(P.ws + WS_PROJ);
    GAS bf16* YD = (GAS bf16*)P.out; GAS float* BS = (GAS float*)(P.ws + WS_BS);
    const int nss = npt / 64;
    const int cj = h * 64 + 16 * cc + (lane0 & 15);
    const GAS float* ts_mu = (const GAS float*)P.in[I_TSMU];
    const float mlo_r = ts_mu[(dir ? 1536 : 0) + C_R + cj], mhi_r = ts_mu[(dir ? 0 : 1536) + C_R + cj];
    const float mlo_k = ts_mu[(dir ? 1536 : 0) + C_K + cj], mhi_k = ts_mu[(dir ? 0 : 1536) + C_K + cj];
    const float mlo_v = ts_mu[(dir ? 1536 : 0) + C_V + cj], mhi_v = ts_mu[(dir ? 0 : 1536) + C_V + cj];
    const float mc_r = 1.0f - mlo_r - mhi_r, mc_k = 1.0f - mlo_k - mhi_k, mc_v = 1.0f - mlo_v - mhi_v;
    const float w0c = -1.44269504f * ((const GAS float*)P.in[I_W0])[dir * 512 + cj], a0c = -1.44269504f * ((const GAS float*)P.in[I_A0])[dir * 512 + cj];
    const float kkc = ((const GAS float*)P.in[I_KK])[dir * 512 + cj], kac = ((const GAS float*)P.in[I_KA])[dir * 512 + cj], rkc = ((const GAS float*)P.in[I_RK])[dir * 512 + cj], kac1 = 1.0f - kac;
    LAS float* ktab = (LAS float*)(lds + CH_KTAB);
    if (tid < 64) { const int c8 = h * 64 + tid; ktab[tid] = ((const GAS float*)P.in[I_KK])[dir * 512 + c8]; ktab[64 + tid] = ts_mu[(dir ? 1536 : 0) + C_K + c8]; ktab[128 + tid] = ts_mu[(dir ? 0 : 1536) + C_K + c8]; }
    { LAS bf16* wupt = (LAS bf16*)(lds + CH_WUPT); LAS bf16* aupt = (LAS bf16*)(lds + CH_AUPT);
      const GAS float* wu = (const GAS float*)P.in[I_WUP] + (size_t)dir * 64 * 512 + h * 64; const GAS float* au = (const GAS float*)P.in[I_AUP] + (size_t)dir * 64 * 512 + h * 64;
#pragma unroll 1
      for (int kb = 0; kb < 2; ++kb) { float wv[4], av[4];
#pragma unroll
          for (int k = 0; k < 4; ++k) { const int idx = tid + 512 * (4 * kb + k), i = idx >> 6, c2 = idx & 63; wv[k] = wu[(size_t)i * 512 + c2]; av[k] = au[(size_t)i * 512 + c2]; }
#pragma unroll
          for (int k = 0; k < 4; ++k) { const int idx = tid + 512 * (4 * kb + k), i = idx >> 6, c2 = idx & 63; wupt[c2 * CH_TW_LD + i] = (bf16)f2bf(wv[k]); aupt[c2 * CH_TW_LD + i] = (bf16)f2bf(av[k]); } } }
    if (grp == 0) { STAGE_LANE(); LAS f32x4* hf = (LAS f32x4*)(lds + CH_HF) + cc * 256 + lane;
#pragma unroll
        for (int mt = 0; mt < 4; ++mt) hf[64 * mt] = s0 ? *(const f32x4*)(s0 + vcol * 64 + 16 * mt + 4 * lg) : (f32x4){0.f, 0.f, 0.f, 0.f};
        if (mode == 2) { LAS f32x4* hf2 = (LAS f32x4*)(lds + CH_HF2) + cc * 256 + lane;
#pragma unroll
            for (int mt = 0; mt < 4; ++mt) { f32x4 id;
#pragma unroll
                for (int e = 0; e < 4; ++e) id[e] = (mt == cc && lr == 4 * lg + e) ? 1.f : 0.f;
                hf2[64 * mt] = id; } }
    }
    RawRegs RR;
    chain_prefetch(RR, proj, m0, L, h, dir, 0, tid, p0);
    chain_stage_raw(RR, lds, tid);
    __syncthreads();
    LAS unsigned char* img = lds + CH_IMG + grp * CH_IMG_STRIDE;
    LAS bf16* I2_A = (LAS bf16*)(img), *I2_B = (LAS bf16*)(img + 5120), *I2_K = (LAS bf16*)(img + 10240), *I2_V = (LAS bf16*)(img + 15360), *I2_R = (LAS bf16*)(img + 20480), *I2_Q = (LAS bf16*)(img + 25600);
    LAS unsigned char* gram = lds + grp * CH_GRAM_STRIDE;
    LAS bf16* GX = (LAS bf16*)(gram), *GXT = (LAS bf16*)(gram + 2560), *GYT = (LAS bf16*)(gram + 5120), *GT = (LAS bf16*)(gram + 7680);
    LAS bf16* GLAK = (LAS bf16*)(gram + 10240), *GMRB = (LAS bf16*)(gram + 12800), *GMRK = (LAS bf16*)(gram + 15360);
    LAS float* n2s = (LAS float*)(lds + CH_N2); LAS float* ecs = (LAS float*)(lds + CH_EC); LAS float* bpart = (LAS float*)(lds + CH_BPART);
    const LAS bf16* rkv = (const LAS bf16*)(lds + CH_RKV);
    const f32x4 z4 = (f32x4){0.f, 0.f, 0.f, 0.f};

    for (int ss = 0; ss < nss; ++ss) {
        { STAGE_LANE(); const int tk = lane >> 3, cg = lane & 7, q = 8 * wave + tk + 1;
          const LAS bf16* kp = rkv + q * CH_RKV_LD + 64 + 8 * cg;
          const u32x4v lo = *(const LAS u32x4v*)(kp - CH_RKV_LD), mi = *(const LAS u32x4v*)kp, hi = *(const LAS u32x4v*)(kp + CH_RKV_LD);
          float s = 0.f;
#pragma unroll
          for (int hh2 = 0; hh2 < 2; ++hh2) { const f32x4 ckk = *(const LAS f32x4*)(ktab + 8 * cg + 4 * hh2), clo = *(const LAS f32x4*)(ktab + 64 + 8 * cg + 4 * hh2), chi = *(const LAS f32x4*)(ktab + 128 + 8 * cg + 4 * hh2);
#pragma unroll
              for (int e2 = 0; e2 < 4; ++e2) { const int e = 4 * hh2 + e2; const unsigned sh = (e & 1) ? 16u : 0u; const float kl = bf2f((lo[e >> 1] >> sh) & 0xffffu), kc = bf2f((mi[e >> 1] >> sh) & 0xffffu), kh = bf2f((hi[e >> 1] >> sh) & 0xffffu);
                  const float k = (kc + clo[e2] * (kl - kc) + chi[e2] * (kh - kc)) * ckk[e2]; s += k * k; } }
          s = oct_sum(s);
          if (cg == 0) n2s[8 * wave + tk] = __builtin_amdgcn_rsqf(s + 1e-12f); }
        f32x4 wl[2], al[2];
        { STAGE_LANE(); const LAS bf16* tw = (const LAS bf16*)(lds + CH_TW); const LAS bf16* ad = (const LAS bf16*)(lds + CH_AD);
          const LAS bf16* wupt = (const LAS bf16*)(lds + CH_WUPT); const LAS bf16* aupt = (const LAS bf16*)(lds + CH_AUPT);
#pragma unroll
          for (int tt = 0; tt < 2; ++tt) { wl[tt] = z4; al[tt] = z4;
#pragma unroll
              for (int ks = 0; ks < 2; ++ks) {
                  wl[tt] = MFMA16(ldfrag(tw, CH_TW_LD, 32 * grp + 16 * tt, 32 * ks, lane), ldfrag(wupt, CH_TW_LD, 16 * cc, 32 * ks, lane), wl[tt]);
                  al[tt] = MFMA16(ldfrag(ad, CH_TW_LD, 32 * grp + 16 * tt, 32 * ks, lane), ldfrag(aupt, CH_TW_LD, 16 * cc, 32 * ks, lane), al[tt]); } } }
        __syncthreads();
        { STAGE_LANE(); float lw[2][4];
#pragma unroll
          for (int tt = 0; tt < 2; ++tt)
#pragma unroll
              for (int e = 0; e < 4; ++e) lw[tt][e] = -0.87506130f * __builtin_amdgcn_rcpf(1.0f + __builtin_amdgcn_exp2f(__builtin_fmaf(wl[tt][e], -1.44269504f, w0c)));
          float gin[2][4], run[2];
#pragma unroll
          for (int tt = 0; tt < 2; ++tt) { gin[tt][0] = lw[tt][0]; gin[tt][1] = gin[tt][0] + lw[tt][1]; gin[tt][2] = gin[tt][1] + lw[tt][2]; gin[tt][3] = gin[tt][2] + lw[tt][3]; run[tt] = gin[tt][3]; }
          float off[2], tot0;
          { float r1 = run[0]; float t1 = __shfl_up(r1, 16); if (lg >= 1) r1 += t1; float t2 = __shfl_up(r1, 32); if (lg >= 2) r1 += t2; off[0] = r1 - run[0]; tot0 = __shfl(r1, 48 + lr); }
          { float r1 = run[1]; float t1 = __shfl_up(r1, 16); if (lg >= 1) r1 += t1; float t2 = __shfl_up(r1, 32); if (lg >= 2) r1 += t2; off[1] = r1 - run[1] + tot0;
            const float tot = __shfl(r1, 48 + lr) + tot0; if (lg == 0) ecs[grp * 64 + c] = __builtin_amdgcn_exp2f(tot); }
#pragma unroll
          for (int tt = 0; tt < 2; ++tt) {
              const int q0 = 32 * grp + 16 * tt + 4 * lg;
              float xr[6], xk[6], xv[6];
              { const LAS bf16* tp = rkv + (q0 + (lr >> 2)) * CH_RKV_LD + 16 * cc + 4 * (lr & 3);
#pragma unroll
                for (int x = 0; x < 3; ++x) { const s16x4c lo = __builtin_amdgcn_ds_read_tr16_b64_v4i16((LAS s16x4c*)(tp + 64 * x)), hi = __builtin_amdgcn_ds_read_tr16_b64_v4i16((LAS s16x4c*)(tp + 64 * x + 4 * CH_RKV_LD));
                    float* dst = (x == 0) ? xr : (x == 1) ? xk : xv;
#pragma unroll
                    for (int e = 0; e < 4; ++e) dst[e] = bf2f((unsigned)(unsigned short)lo[e]);
                    dst[4] = bf2f((unsigned)(unsigned short)hi[0]); dst[5] = bf2f((unsigned)(unsigned short)hi[1]); } }
              const f32x4 n2 = *(const LAS f32x4*)(n2s + 32 * grp + 16 * tt + 4 * lg);
              f32x4 fa, fb, fk, fr, fv; float exprev = 1.f;
#pragma unroll
              for (int e = 0; e < 4; ++e) {
                  const float r = mc_r * xr[e + 1] + mlo_r * xr[e] + mhi_r * xr[e + 2];
                  const float k = mc_k * xk[e + 1] + mlo_k * xk[e] + mhi_k * xk[e + 2];
                  const float v = mc_v * xv[e + 1] + mlo_v * xv[e] + mhi_v * xv[e + 2];
                  const float a = __builtin_amdgcn_rcpf(1.0f + __builtin_amdgcn_exp2f(__builtin_fmaf(al[tt][e], -1.44269504f, a0c)));
                  const float kk = k * kkc * n2[e];
                  const float kdv = k * __builtin_fmaf(a, kac, kac1);
                  const float g = gin[tt][e] + off[tt];
                  const float ex = __builtin_amdgcn_exp2f(g), ie = __builtin_amdgcn_exp2f(-g), ep = (e == 0) ? __builtin_amdgcn_exp2f(g - lw[tt][e]) : exprev; exprev = ex;
                  fa[e] = -kk * ep; fb[e] = kk * a * ie; fk[e] = kdv * ie; fr[e] = r * ex; fv[e] = v; }
              const f32x4 fq = fr * rkc;
              const int t0 = 16 * tt + 4 * lg;
              u32x2v oa, ob, ok, orr, ov, oq; oq.x = cvtpk(fq[0], fq[1]); oq.y = cvtpk(fq[2], fq[3]);
              oa.x = cvtpk(fa[0], fa[1]); oa.y = cvtpk(fa[2], fa[3]); ob.x = cvtpk(fb[0], fb[1]); ob.y = cvtpk(fb[2], fb[3]); ok.x = cvtpk(fk[0], fk[1]); ok.y = cvtpk(fk[2], fk[3]);
              orr.x = cvtpk(fr[0], fr[1]); orr.y = cvtpk(fr[2], fr[3]); ov.x = cvtpk(fv[0], fv[1]); ov.y = cvtpk(fv[2], fv[3]);
              *(LAS u32x2v*)(I2_A + c * CH_I2_LD + t0) = oa; *(LAS u32x2v*)(I2_B + c * CH_I2_LD + t0) = ob; *(LAS u32x2v*)(I2_K + c * CH_I2_LD + t0) = ok; *(LAS u32x2v*)(I2_V + c * CH_I2_LD + t0) = ov; *(LAS u32x2v*)(I2_R + c * CH_I2_LD + t0) = orr; *(LAS u32x2v*)(I2_Q + c * CH_I2_LD + t0) = oq;
          } }
        __syncthreads();
        f32x4 kv[4];
        { STAGE_LANE();
          if (cc != 0) { const bf16x8 vb = ldfrag(I2_V, CH_I2_LD, 16 * cc, 0, lane);
#pragma unroll
            for (int mt = 0; mt < 4; ++mt) kv[mt] = MFMA16(ldfrag(I2_K, CH_I2_LD, 16 * mt, 0, lane), vb, z4); }
          if (cc != 0) {
              const LAS bf16* GA = (cc < 2) ? I2_A : I2_R; const LAS bf16* GB = (cc & 1) ? I2_K : I2_B;
              f32x4 g00 = z4, g10 = z4, g11 = z4;
              bf16x8 fa[2][2], fb[2][2];
#pragma unroll
              for (int ks = 0; ks < 2; ++ks) { fa[ks][0] = ldfrag_tr(GA, CH_I2_LD, 0, 32 * ks, lane); fa[ks][1] = ldfrag_tr(GA, CH_I2_LD, 16, 32 * ks, lane); fb[ks][0] = ldfrag_tr(GB, CH_I2_LD, 0, 32 * ks, lane); fb[ks][1] = ldfrag_tr(GB, CH_I2_LD, 16, 32 * ks, lane); }
#pragma unroll
              for (int ks = 0; ks < 2; ++ks) { g00 = MFMA16(fa[ks][0], fb[ks][0], g00); g10 = MFMA16(fa[ks][1], fb[ks][0], g10); g11 = MFMA16(fa[ks][1], fb[ks][1], g11); }
              const bool strict = cc < 2;
#pragma unroll
              for (int e = 0; e < 4; ++e) { const int m = 4 * lg + e; const bool keep = strict ? (lr < m) : (lr <= m); g00[e] = keep ? g00[e] : 0.f; g11[e] = keep ? g11[e] : 0.f; }
              if (cc == 3) {
                  f32x4 d0 = z4, d1 = z4;
#pragma unroll
                  for (int ks = 0; ks < 2; ++ks) { d0 = MFMA16(ldfrag_tr(I2_Q, CH_I2_LD, 0, 32 * ks, lane), ldfrag_tr(I2_K, CH_I2_LD, 0, 32 * ks, lane), d0);
                      d1 = MFMA16(ldfrag_tr(I2_Q, CH_I2_LD, 16, 32 * ks, lane), ldfrag_tr(I2_K, CH_I2_LD, 16, 32 * ks, lane), d1); }
                  if ((lr >> 2) == lg) { const int e = lr & 3; const float b0 = (e == 0) ? d0[0] : (e == 1) ? d0[1] : (e == 2) ? d0[2] : d0[3], b1 = (e == 0) ? d1[0] : (e == 1) ? d1[1] : (e == 2) ? d1[2] : d1[3];
                      const int p = p0 + ss * 64 + 32 * grp + lr, t = dir ? (L - 1 - p) : p, t2 = dir ? (t - 16) : (t + 16);
                      BS[((size_t)dir * MT + m0 + t) * 8 + h] = b0; BS[((size_t)dir * MT + m0 + t2) * 8 + h] = b1; }
              }
              LAS bf16* dst = (cc == 1) ? GLAK : (cc == 2) ? GMRB : GMRK;
              st_mn(dst, CH_G_LD, 0, 0, g00, lane); st_mn(dst, CH_G_LD, 16, 0, g10, lane); st_mn(dst, CH_G_LD, 16, 16, g11, lane); st_mn(dst, CH_G_LD, 0, 16, z4, lane);
          } else {
              f32x4 x00 = z4, x11 = z4, t00 = z4, t01 = z4, t11 = z4;
              { bf16x8 fa[2][2], fb[2][2];
#pragma unroll
                for (int ks = 0; ks < 2; ++ks) { fa[ks][0] = ldfrag_tr(I2_A, CH_I2_LD, 0, 32 * ks, lane); fa[ks][1] = ldfrag_tr(I2_A, CH_I2_LD, 16, 32 * ks, lane); fb[ks][0] = ldfrag_tr(I2_B, CH_I2_LD, 0, 32 * ks, lane); fb[ks][1] = ldfrag_tr(I2_B, CH_I2_LD, 16, 32 * ks, lane); }
#pragma unroll
                for (int ks = 0; ks < 2; ++ks) { x00 = MFMA16(fa[ks][0], fb[ks][0], x00); x11 = MFMA16(fa[ks][1], fb[ks][1], x11);
                    t00 = MFMA16(fb[ks][0], fa[ks][0], t00); t01 = MFMA16(fb[ks][0], fa[ks][1], t01); t11 = MFMA16(fb[ks][1], fa[ks][1], t11); } }
              f32x4 y00, y10, y11, yt11;
#pragma unroll
              for (int e = 0; e < 4; ++e) { const int m = 4 * lg + e; x00[e] = (lr < m) ? x00[e] : 0.f; x11[e] = (lr < m) ? x11[e] : 0.f; t00[e] = (m < lr) ? t00[e] : 0.f; t11[e] = (m < lr) ? t11[e] : 0.f; y00[e] = (lr == m) ? 1.f : 0.f; }
              y11 = y00; yt11 = y00;
#pragma unroll 1
              for (int lev = 0; lev < 4; ++lev) {
                  const bf16x4 fx00 = frag4(x00), fx11 = frag4(x11), ft00 = frag4(t00), ft11 = frag4(t11), fy00 = frag4(y00), fy11 = frag4(y11);
                  y00 = MF16(ft00, fy00, y00); y11 = MF16(ft11, fy11, y11); yt11 = MF16(fy11, ft11, yt11);
                  if (lev < 3) { const f32x4 n00 = MF16(ft00, fx00, z4), n11 = MF16(ft11, fx11, z4), m00 = MF16(fx00, ft00, z4), m11 = MF16(fx11, ft11, z4);
                      x00 = n00; x11 = n11; t00 = m00; t11 = m11; }
              }
              { const f32x4 zz = MF16(frag4(t01), frag4(y00), z4);
                y10 = MF16(frag4(yt11), frag4(zz), z4); }
              st_mn(GT, CH_G_LD, 0, 0, y00, lane); st_mn(GT, CH_G_LD, 16, 0, y10, lane); st_mn(GT, CH_G_LD, 16, 16, y11, lane); st_mn(GT, CH_G_LD, 0, 16, z4, lane);
              { const bf16x8 vb = ldfrag(I2_V, CH_I2_LD, 16 * cc, 0, lane);
#pragma unroll
                for (int mt = 0; mt < 4; ++mt) kv[mt] = MFMA16(ldfrag(I2_K, CH_I2_LD, 16 * mt, 0, lane), vb, z4); }
          } }
        if (ss + 1 < nss) chain_prefetch(RR, proj, m0, L, h, dir, ss + 1, tid, p0);
        __syncthreads();
        f32x4 y0[2], u0[2]; bf16x4 apf[2][4];
        { STAGE_LANE(); const bf16x8 vb = ldfrag(I2_V, CH_I2_LD, 16 * cc, 0, lane);
          const f32x4 w0 = MFMA16(ldfrag(GLAK, CH_G_LD, 0, 0, lane), vb, z4), w1 = MFMA16(ldfrag(GLAK, CH_G_LD, 16, 0, lane), vb, z4);
          y0[0] = MFMA16(ldfrag(GMRK, CH_G_LD, 0, 0, lane), vb, z4); y0[1] = MFMA16(ldfrag(GMRK, CH_G_LD, 16, 0, lane), vb, z4);
          { const bf16x8 ta0 = ldfrag(GT, CH_G_LD, 0, 0, lane), ta1 = ldfrag(GT, CH_G_LD, 16, 0, lane);
#pragma unroll
            for (int mt = 0; mt < 4; ++mt) { const bf16x8 at = ldfrag(I2_A, CH_I2_LD, 16 * mt, 0, lane); apf[0][mt] = frag4(MFMA16(at, ta0, z4)); apf[1][mt] = frag4(MFMA16(at, ta1, z4)); } }
          const bf16x4 fw0 = frag4(w0), fw1 = frag4(w1);
          u0[0] = MF16(ldfrag4(GT, CH_G_LD, 0, 0, lane), fw0, z4);
          u0[1] = MF16(ldfrag4(GT, CH_G_LD, 16, 16, lane), fw1, MF16(ldfrag4(GT, CH_G_LD, 16, 0, lane), fw0, z4)); }
        { STAGE_LANE(); LAS f32x4* hf = (LAS f32x4*)(lds + CH_HF) + cc * 256 + lane;
          bf16x4 rf[2][4], bfr[4][2], mbf[3]; f32x4 ecv[4];
#pragma unroll
          for (int mt = 0; mt < 4; ++mt) {
              bfr[mt][0] = ldfrag4(I2_B, CH_I2_LD, 16 * mt, 0, lane); bfr[mt][1] = ldfrag4(I2_B, CH_I2_LD, 16 * mt, 16, lane); ecv[mt] = *(const LAS f32x4*)(ecs + grp * 64 + 16 * mt + 4 * lg); }
#define LOAD_PART_B() do { _Pragma("unroll") for (int mt = 0; mt < 4; ++mt) { rf[0][mt] = ldfrag4_tr(I2_R, CH_I2_LD, 0, 16 * mt, lane); rf[1][mt] = ldfrag4_tr(I2_R, CH_I2_LD, 16, 16 * mt, lane); } \
          mbf[0] = ldfrag4(GMRB, CH_G_LD, 0, 0, lane); mbf[1] = ldfrag4(GMRB, CH_G_LD, 16, 0, lane); mbf[2] = ldfrag4(GMRB, CH_G_LD, 16, 16, lane); } while (0)
          if (grp == 1) LOAD_PART_B();
          bf16x4 fH[4], fU0, fU1, fHP[4], fUP0, fUP1;
#pragma unroll
          for (int mt = 0; mt < 4; ++mt) fHP[mt] = (bf16x4){0, 0, 0, 0};
          fUP0 = fUP1 = (bf16x4){0, 0, 0, 0};
#pragma unroll 1
          for (int sg = 0; sg < 2; ++sg) {
              if (grp == sg) {
                  f32x4 hh[4];
#pragma unroll
                  for (int mt = 0; mt < 4; ++mt) { hh[mt] = hf[64 * mt]; fH[mt] = frag4(hh[mt]); }
                  f32x4 uu0 = u0[0], uu1 = u0[1];
#pragma unroll
                  for (int mt = 0; mt < 4; ++mt) { uu0 = MF16(apf[0][mt], fH[mt], uu0); uu1 = MF16(apf[1][mt], fH[mt], uu1); }
                  fU0 = frag4(uu0); fU1 = frag4(uu1);
#pragma unroll
                  for (int mt = 0; mt < 4; ++mt) { f32x4 acc = hh[mt] + kv[mt]; acc = MF16(bfr[mt][0], fU0, acc); acc = MF16(bfr[mt][1], fU1, acc); hf[64 * mt] = acc * ecv[mt]; }
                  if (mode == 2) {
                      LAS f32x4* hf2 = (LAS f32x4*)(lds + CH_HF2) + cc * 256 + lane; f32x4 hp[4];
#pragma unroll
                      for (int mt = 0; mt < 4; ++mt) { hp[mt] = hf2[64 * mt]; fHP[mt] = frag4(hp[mt]); }
                      f32x4 up0 = z4, up1 = z4;
#pragma unroll
                      for (int mt = 0; mt < 4; ++mt) { up0 = MF16(apf[0][mt], fHP[mt], up0); up1 = MF16(apf[1][mt], fHP[mt], up1); }
                      fUP0 = frag4(up0); fUP1 = frag4(up1);
#pragma unroll
                      for (int mt = 0; mt < 4; ++mt) { f32x4 acc = MF16(bfr[mt][0], fUP0, hp[mt]); acc = MF16(bfr[mt][1], fUP1, acc); hf2[64 * mt] = acc * ecv[mt]; }
                  }
              }
              __syncthreads();
              if (grp == sg) {
                  if (sg == 0) LOAD_PART_B();
                  f32x4 yy0 = y0[0], yy1 = y0[1];
#pragma unroll
                  for (int mt = 0; mt < 4; ++mt) { yy0 = MF16(rf[0][mt], fH[mt], yy0); yy1 = MF16(rf[1][mt], fH[mt], yy1); }
                  yy0 = MF16(mbf[0], fU0, yy0); yy1 = MF16(mbf[2], fU1, MF16(mbf[1], fU0, yy1));
#pragma unroll
                  for (int e = 0; e < 4; ++e) { const int p = p0 + ss * 64 + 32 * sg + 4 * lg + e, t = dir ? (L - 1 - p) : p, t2 = dir ? (t - 16) : (t + 16);
                      YD[((size_t)dir * MT + m0 + t) * 512 + h * 64 + vcol] = (bf16)f2bf(yy0[e]); YD[((size_t)dir * MT + m0 + t2) * 512 + h * 64 + vcol] = (bf16)f2bf(yy1[e]); }
                  if (mode == 2) {
                      f32x4 g0 = z4, g1 = z4;
#pragma unroll
                      for (int mt = 0; mt < 4; ++mt) { g0 = MF16(rf[0][mt], fHP[mt], g0); g1 = MF16(rf[1][mt], fHP[mt], g1); }
                      g0 = MF16(mbf[0], fUP0, g0); g1 = MF16(mbf[2], fUP1, MF16(mbf[1], fUP0, g1));
                      GAS bf16* G = (GAS bf16*)(P.ws + WS_G) + ((size_t)chain * 2048 + (ss * 64 + 32 * sg + 4 * lg)) * 64 + vcol;
#pragma unroll
                      for (int e = 0; e < 4; e += 2) { const unsigned w0 = cvtpk(g0[e], g0[e + 1]), w1 = cvtpk(g1[e], g1[e + 1]);
                          G[(size_t)e * 64] = (bf16)(w0 & 0xffffu); G[(size_t)(e + 1) * 64] = (bf16)(w0 >> 16); G[(size_t)(e + 16) * 64] = (bf16)(w1 & 0xffffu); G[(size_t)(e + 17) * 64] = (bf16)(w1 >> 16); }
                  }
              }
          }
#undef LOAD_PART_B
        }
        if (ss + 1 < nss) { chain_stage_raw(RR, lds, tid); __syncthreads(); }
    }
    if (grp == 1 && (sfin || mode == 1)) { STAGE_LANE(); const LAS f32x4* hf = (const LAS f32x4*)(lds + CH_HF) + cc * 256 + lane;
        if (mode == 1) { GAS bf16* hm = (GAS bf16*)(P.ws + WS_HMID) + (size_t)chain * 4096 + vcol * 64;
#pragma unroll
            for (int mt = 0; mt < 4; ++mt) { const f32x4 hv = hf[64 * mt]; u32x2v o; o.x = cvtpk(hv[0], hv[1]); o.y = cvtpk(hv[2], hv[3]); *(GAS u32x2v*)(hm + 16 * mt + 4 * lg) = o; } }
        else {
#pragma unroll
            for (int mt = 0; mt < 4; ++mt) *(f32x4*)(sfin + vcol * 64 + 16 * mt + 4 * lg) = hf[64 * mt]; }
    }
    __syncthreads();
#undef STAGE_LANE
}
constexpr int VN_LD = 520;
constexpr int GM_STG = 128 * VN_LD * 2;
static_assert(GM_STG + 8 * 2048 <= LDS_BYTES - 64, "gMLP LDS map");
typedef short s16x4 __attribute__((ext_vector_type(4)));
__device__ __forceinline__ s16x4 tr16(const LAS bf16* p) { return __builtin_amdgcn_ds_read_tr16_b64_v4i16((LAS s16x4*)p); }
__device__ __forceinline__ void do_gmlp(const Params& P, LAS unsigned char* lds, int unit) {
    const int tid = threadIdx.x, lane = tid & 63, wave = __builtin_amdgcn_readfirstlane(tid >> 6);
    const GAS bf16* proj = (const GAS bf16*)(P.ws + WS_PROJ); GAS bf16* MIX = (GAS bf16*)(P.ws + WS_H); const GAS bf16* wsb = (const GAS bf16*)(P.ws + WS_WSB);
    LAS bf16* vn = (LAS bf16*)lds;
    const int row0 = unit * 128;
    { const GAS float* g = (const GAS float*)P.in[I_SLG]; const GAS float* b = (const GAS float*)P.in[I_SLB];
      float gg[8], bb[8];
#pragma unroll
      for (int e = 0; e < 8; ++e) { gg[e] = g[lane * 8 + e]; bb[e] = b[lane * 8 + e]; }
#pragma unroll 1
      for (int ib = 0; ib < 2; ++ib) {
        u32x4v rawv[8];
#pragma unroll
        for (int i = 0; i < 8; ++i) rawv[i] = *(const GAS u32x4v*)(proj + (size_t)(row0 + wave * 16 + ib * 8 + i) * D_IN + C_VB + lane * 8);
#pragma unroll
        for (int i = 0; i < 8; ++i) { const int tok = wave * 16 + ib * 8 + i; const u32x4v raw = rawv[i];
        float x[8]; x[0] = bf2f(raw.x & 0xffffu); x[1] = bf2f(raw.x >> 16); x[2] = bf2f(raw.y & 0xffffu); x[3] = bf2f(raw.y >> 16); x[4] = bf2f(raw.z & 0xffffu); x[5] = bf2f(raw.z >> 16); x[6] = bf2f(raw.w & 0xffffu); x[7] = bf2f(raw.w >> 16);
        float s = 0.f;
#pragma unroll
        for (int e = 0; e < 8; ++e) s += x[e];
        const float mean = wave_sum(s) * (1.0f / 512.0f); float q = 0.f;
#pragma unroll
        for (int e = 0; e < 8; ++e) { x[e] -= mean; q += x[e] * x[e]; }
        const float rstd = 1.0f / sqrtf(wave_sum(q) * (1.0f / 512.0f) + NORM_EPS);
        u32x4v o;
#pragma unroll
        for (int e = 0; e < 4; ++e) o[e] = cvtpk(x[2 * e] * rstd * gg[2 * e] + bb[2 * e], x[2 * e + 1] * rstd * gg[2 * e + 1] + bb[2 * e + 1]);
        *(LAS u32x4v*)(vn + tok * VN_LD + lane * 8) = o; } } }
    __syncthreads();
    const int g = wave, fr = lane & 15, fq = lane >> 4;
    const GAS float* b_s = (const GAS float*)P.in[I_BSS];
    LAS bf16* stg = (LAS bf16*)(lds + GM_STG + wave * 2048);
    const LAS bf16* trbase = vn + (8 * fq + (fr >> 2)) * VN_LD + g * 64 + 4 * (fr & 3);
#pragma unroll 1
    for (int ah = 0; ah < 2; ++ah) {
        f32x4 acc[4][4];
#pragma unroll
        for (int a = 0; a < 4; ++a)
#pragma unroll
            for (int c = 0; c < 4; ++c) acc[a][c] = (f32x4){0.f, 0.f, 0.f, 0.f};
        bf16x8 afr[4][4];
#pragma unroll
        for (int a = 0; a < 4; ++a)
#pragma unroll
            for (int ks = 0; ks < 4; ++ks) afr[a][ks] = *(const GAS bf16x8*)(wsb + (size_t)(g * 128 + (ah * 4 + a) * 16 + fr) * 128 + ks * 32 + 8 * fq);
#pragma unroll
        for (int ks = 0; ks < 4; ++ks) {
            bf16x8 bfr[4];
#pragma unroll
            for (int c = 0; c < 4; ++c) { const s16x4 lo = tr16(trbase + (32 * ks) * VN_LD + 16 * c), hi = tr16(trbase + (32 * ks + 4) * VN_LD + 16 * c);
                bfr[c] = (bf16x8){lo[0], lo[1], lo[2], lo[3], hi[0], hi[1], hi[2], hi[3]}; }
#pragma unroll
            for (int a = 0; a < 4; ++a)
#pragma unroll
                for (int c = 0; c < 4; ++c) acc[a][c] = __builtin_amdgcn_mfma_f32_16x16x32_bf16(afr[a][ks], bfr[c], acc[a][c], 0, 0, 0);
        }
        const int pr_ = lane >> 2, cq = lane & 3, ch = g * 64 + 16 * cq;
        u32x4v un0, un1, zn0, zn1; float bsn;
        { const GAS bf16* pr = proj + (size_t)(row0 + (ah * 4) * 16 + pr_) * D_IN;
          un0 = *(const GAS u32x4v*)(pr + C_U + ch); un1 = *(const GAS u32x4v*)(pr + C_U + ch + 8); zn0 = *(const GAS u32x4v*)(pr + C_ZB + ch); zn1 = *(const GAS u32x4v*)(pr + C_ZB + ch + 8); bsn = b_s[g * 128 + (ah * 4) * 16 + pr_]; }
#pragma unroll
        for (int a = 0; a < 4; ++a) {
#pragma unroll
            for (int c = 0; c < 4; ++c)
#pragma unroll
                for (int e = 0; e < 4; e += 2) { const unsigned w = cvtpk(acc[a][c][e], acc[a][c][e + 1]); LAS bf16* sp = stg + (4 * fq + e) * 64 + 16 * c + fr; sp[0] = (bf16)(w & 0xffffu); sp[64] = (bf16)(w >> 16); }
            const int p = (ah * 4 + a) * 16 + pr_;
            const u32x4v u0 = un0, u1 = un1, z0 = zn0, z1 = zn1; const float bsv = bsn;
            if (a < 3) { const GAS bf16* pr = proj + (size_t)(row0 + p + 16) * D_IN;
                un0 = *(const GAS u32x4v*)(pr + C_U + ch); un1 = *(const GAS u32x4v*)(pr + C_U + ch + 8); zn0 = *(const GAS u32x4v*)(pr + C_ZB + ch); zn1 = *(const GAS u32x4v*)(pr + C_ZB + ch + 8); bsn = b_s[g * 128 + p + 16]; }
            const u32x4v s0 = *(const LAS u32x4v*)(stg + pr_ * 64 + 16 * cq), s1 = *(const LAS u32x4v*)(stg + pr_ * 64 + 16 * cq + 8);
            u32x4v o0, o1;
#pragma unroll
            for (int e = 0; e < 4; ++e) {
                o0[e] = cvtpk(bf2f(u0[e] & 0xffffu) * (bf2f(s0[e] & 0xffffu) + bsv) * silu_f(bf2f(z0[e] & 0xffffu)), bf2f(u0[e] >> 16) * (bf2f(s0[e] >> 16) + bsv) * silu_f(bf2f(z0[e] >> 16)));
                o1[e] = cvtpk(bf2f(u1[e] & 0xffffu) * (bf2f(s1[e] & 0xffffu) + bsv) * silu_f(bf2f(z1[e] & 0xffffu)), bf2f(u1[e] >> 16) * (bf2f(s1[e] >> 16) + bsv) * silu_f(bf2f(z1[e] >> 16))); }
            GAS bf16* op = MIX + (size_t)(row0 + p) * D + 512 + ch;
            *(GAS u32x4v*)op = o0; *(GAS u32x4v*)(op + 8) = o1;
        }
    }
    __syncthreads();
}

#define XB_TMO      128
#define XB_XCNT(j)  (256  + 64 * (j))
#define XB_XSUB(j)  (1280 + 64 * (j))
#define XB_XGEN(j)  (2304 + 64 * (j))
#define XB_TOP      3328
#define XB_TOPGEN   3392
#define XCD_BAR_WORDS 3456
#define XB_SPIN_CAP (1u << 18)

__device__ __forceinline__ unsigned xb_ld(unsigned* p)              { return __hip_atomic_load(p, __ATOMIC_RELAXED, __HIP_MEMORY_SCOPE_AGENT); }
__device__ __forceinline__ unsigned xb_add(unsigned* p, unsigned v) { return __hip_atomic_fetch_add(p, v, __ATOMIC_RELAXED, __HIP_MEMORY_SCOPE_AGENT); }
__device__ __forceinline__ unsigned xb_xcc_id() { return (unsigned)__builtin_amdgcn_s_getreg((3 << 11) | 20) & 0xFu; }
#define XB_SPIN(cond, bar) do { unsigned _sp = 0; while (cond) { __builtin_amdgcn_s_sleep(1); \
    if ((++_sp & 255u) == 0u) { if (xb_ld(&(bar)[XB_TMO])) break; if (_sp > XB_SPIN_CAP) { atomicAdd(&(bar)[XB_TMO], 1u); break; } } } } while (0)

struct XcdBarrier {
    unsigned* bar; unsigned x;
    volatile LAS unsigned* st;
};

__device__ __forceinline__ XcdBarrier xcd_barrier_post(unsigned* bar, volatile LAS unsigned* st) {
    XcdBarrier b; b.bar = bar; b.x = xb_xcc_id(); b.st = st;
    if (threadIdx.x == 0) (void)xb_add(&bar[XB_XCNT(b.x)], 1u);
    return b;
}
__device__ __forceinline__ void xcd_barrier_complete(unsigned* bar, unsigned x, unsigned& nloc, unsigned& nx) {
    const unsigned G = gridDim.x * gridDim.y * gridDim.z;
    unsigned sum, cnt, mine, sp = 0u;
    for (;;) {
        sum = 0u; cnt = 0u; mine = 0u;
#pragma unroll
        for (unsigned j = 0; j < 16; ++j) { const unsigned c = xb_ld(&bar[XB_XCNT(j)]); sum += c; cnt += (c > 0u) ? 1u : 0u; mine = (j == x) ? c : mine; }
        if (sum == G) break;
        __builtin_amdgcn_s_sleep(1);
        if ((++sp & 255u) == 0u) { if (xb_ld(&bar[XB_TMO])) break; if (sp > XB_SPIN_CAP) { atomicAdd(&bar[XB_TMO], 1u); break; } }
    }
    nloc = mine > 0u ? mine : 1u; nx = cnt > 0u ? cnt : 1u;
}

__device__ __forceinline__ void xcd_barrier(const XcdBarrier& b) {
    asm volatile("s_waitcnt vmcnt(0)" ::: "memory");
    __syncthreads();
    if (threadIdx.x == 0) {
        unsigned* bar = b.bar;
        __builtin_amdgcn_s_waitcnt(0);
        unsigned nloc = b.st[0], nx = b.st[1];
        if (nloc == 0u) { xcd_barrier_complete(bar, b.x, nloc, nx); b.st[0] = nloc; b.st[1] = nx; }
        const unsigned old = xb_add(&bar[XB_XSUB(b.x)], 1u);
        const unsigned gen = old / nloc;
        if (old + 1u == (gen + 1u) * nloc) {
            __builtin_amdgcn_fence(__ATOMIC_RELEASE, "agent");
            asm volatile("s_waitcnt vmcnt(0)" ::: "memory");
            const unsigned og = xb_add(&bar[XB_TOP], 1u);
            const unsigned tg = og / nx;
            if (og + 1u == (tg + 1u) * nx) xb_add(&bar[XB_TOPGEN], 1u);
            else XB_SPIN(xb_ld(&bar[XB_TOPGEN]) == tg, bar);
            __builtin_amdgcn_fence(__ATOMIC_ACQUIRE, "agent");
            xb_add(&bar[XB_XGEN(b.x)], 1u);
            asm volatile("s_waitcnt vmcnt(0)" ::: "memory");
        } else {
            XB_SPIN(xb_ld(&bar[XB_XGEN(b.x)]) == gen, bar);
            __builtin_amdgcn_fence(__ATOMIC_ACQUIRE, "agent");
            asm volatile("s_waitcnt vmcnt(0)" ::: "memory");
        }
    }
    __syncthreads();
}

#define SP_LOC(k, j) (4096 + 2048 * (k) + 64 * (j))
#define SP_TOP(k)    (4096 + 2048 * (k) + 1024)
__device__ __forceinline__ void split_arrive(const XcdBarrier& b, int k) {
    const unsigned nloc = b.st[0];
    const unsigned old = xb_add(&b.bar[SP_LOC(k, b.x)], 1u);
    if (old + 1u == nloc) { __builtin_amdgcn_fence(__ATOMIC_RELEASE, "agent"); asm volatile("s_waitcnt vmcnt(0)" ::: "memory"); (void)xb_add(&b.bar[SP_TOP(k)], 1u); }
}
__device__ __forceinline__ void split_wait(const XcdBarrier& b, int k) {
    if (threadIdx.x == 0) { const unsigned nx = b.st[1]; unsigned* bar = b.bar; XB_SPIN(xb_ld(&bar[SP_TOP(k)]) < nx, bar);
        __builtin_amdgcn_fence(__ATOMIC_ACQUIRE, "agent"); asm volatile("s_waitcnt vmcnt(0)" ::: "memory"); }
    __syncthreads();
}

__device__ __forceinline__ int queue_pull(unsigned char* ws, size_t qoff, volatile LAS int* qslot) {
    if (threadIdx.x == 0) *qslot = (int)__hip_atomic_fetch_add((unsigned*)(ws + qoff), 1u, __ATOMIC_RELAXED, __HIP_MEMORY_SCOPE_AGENT);
    __syncthreads();
    const int t = *qslot;
    __syncthreads();
    return t;
}
__device__ __forceinline__ void phase3(const Params& P, LAS unsigned char* lds, const XcdBarrier& xb) {
    const int G = gridDim.x, bid = blockIdx.x;
    const bool bal = (G == 256);
    volatile LAS int* qslot = (volatile LAS int*)(lds + LDS_BYTES - 32);
    const int nit = bal ? 513 : (640 + G - 1) / G;
    for (int it = 0; it < nit; ++it) {
        int m0, L, h, dir, p0, npt, mode, chain; const float* s0; float* sfin;
        if (bal) {
            if (it == 0) { const int b = bid & 7, q = (bid >> 3) & 15; h = q >> 1; dir = q & 1; chain = b * 16 + q; m0 = M_CTX + b * L_LAT; L = L_LAT; sfin = nullptr;
                split_wait(xb, 0);
                if (bid < 128) { mode = 1; p0 = 0; npt = 2048; s0 = (dir ? P.in[I_SB] : P.in[I_SF]) + (size_t)(b * 8 + h) * 4096; }
                else { mode = 2; p0 = 2048; npt = 2048; s0 = nullptr; } }
            else { if (it == 1) split_wait(xb, 1);
                const int cc = queue_pull(P.ws, CW_QUEUE, qslot); if (cc >= 512) break;
                const int b = cc >> 4; chain = 0; h = (cc >> 1) & 7; dir = cc & 1; m0 = b * L_CTX; L = L_CTX; p0 = 0; npt = L_CTX; mode = 0;
                s0 = nullptr; sfin = P.out + (size_t)MT * D + (size_t)dir * STATE_ELEMS + (size_t)(b * 8 + h) * 4096; }
        } else {
            const int c = bid + it * G; if (c >= 640) continue;
            chain = 0; p0 = 0; mode = 0;
            if (c < 128) { const int b = c >> 4; h = (c >> 1) & 7; dir = c & 1; m0 = M_CTX + b * L_LAT; L = L_LAT; npt = L_LAT;
                s0 = (dir ? P.in[I_SB] : P.in[I_SF]) + (size_t)(b * 8 + h) * 4096; sfin = nullptr; }
            else { const int cc = c - 128, b = cc >> 4; h = (cc >> 1) & 7; dir = cc & 1; m0 = b * L_CTX; L = L_CTX; npt = L_CTX;
                s0 = nullptr; sfin = P.out + (size_t)MT * D + (size_t)dir * STATE_ELEMS + (size_t)(b * 8 + h) * 4096; }
        }
        do_chain(P, lds, m0, L, h, dir, s0, sfin, p0, npt, mode, chain);
    }
    if (bal) { for (;;) { const int u = queue_pull(P.ws, CW_QUEUE + 256, qslot); if (u >= 320) break; do_gmlp(P, lds, u); } }
    else { for (int u = bid; u < 320; u += G) do_gmlp(P, lds, u); }
}

__device__ __forceinline__ void phase35(const Params& P, LAS unsigned char* lds, int gw, int NGW, int wave, int lane) {
    if (gridDim.x != 256) return;
    const GAS bf16* Gm = (const GAS bf16*)(P.ws + WS_G); const GAS bf16* HM = (const GAS bf16*)(P.ws + WS_HMID); GAS bf16* CORR = (GAS bf16*)(P.ws + WS_CORR);
    const int lr = lane & 15, lg = lane >> 4;
    LAS bf16* stg = (LAS bf16*)(lds + wave * 2304);
    const int chain = gw >> 4, b = chain >> 4, h = (chain >> 1) & 7, dir = chain & 1;
    bf16x8 hb[4][2];
#pragma unroll
    for (int nt = 0; nt < 4; ++nt) { const GAS bf16* hp = HM + (size_t)chain * 4096 + (16 * nt + lr) * 64 + 8 * lg; hb[nt][0] = *(const GAS bf16x8*)hp; hb[nt][1] = *(const GAS bf16x8*)(hp + 32); }
    const GAS bf16* gp = Gm + ((size_t)chain * 2048 + (gw & 15) * 128 + lr) * 64 + 8 * lg;
    bf16x8 a0 = *(const GAS bf16x8*)gp, a1 = *(const GAS bf16x8*)(gp + 32);
#pragma unroll 1
    for (int i = 0; i < 8; ++i) {
        const bf16x8 c0 = a0, c1 = a1;
        if (i < 7) { a0 = *(const GAS bf16x8*)(gp + (size_t)(i + 1) * 1024); a1 = *(const GAS bf16x8*)(gp + (size_t)(i + 1) * 1024 + 32); }
#pragma unroll
        for (int nt = 0; nt < 4; ++nt) { f32x4 acc = MFMA16(c0, hb[nt][0], ((f32x4){0.f, 0.f, 0.f, 0.f})); acc = MFMA16(c1, hb[nt][1], acc);
            const unsigned w0 = cvtpk(acc[0], acc[1]), w1 = cvtpk(acc[2], acc[3]); LAS bf16* sp = stg + (4 * lg) * 72 + 16 * nt + lr;
            sp[0] = (bf16)(w0 & 0xffffu); sp[72] = (bf16)(w0 >> 16); sp[144] = (bf16)(w1 & 0xffffu); sp[216] = (bf16)(w1 >> 16); }
        const int tr = lane >> 2, vq = lane & 3, p = 2048 + ((gw & 15) * 8 + i) * 16 + tr, t = dir ? (L_LAT - 1 - p) : p;
        const u32x4v o0 = *(const LAS u32x4v*)(stg + tr * 72 + 16 * vq), o1 = *(const LAS u32x4v*)(stg + tr * 72 + 16 * vq + 8);
        GAS bf16* cp = CORR + ((size_t)(b * L_LAT + t)) * 512 + h * 64 + 16 * vq;
        *(GAS u32x4v*)cp = o0; *(GAS u32x4v*)(cp + 8) = o1;
    }
}

__device__ __forceinline__ void phase4(const Params& P, int gw, int NGW, int lane, int m_lo, int m_hi) {
    const GAS bf16* proj = (const GAS bf16*)(P.ws + WS_PROJ); GAS bf16* MIX = (GAS bf16*)(P.ws + WS_H); const GAS bf16* YD = (const GAS bf16*)P.out; const GAS float* BS = (const GAS float*)(P.ws + WS_BS);
    const GAS float* ts_mu = (const GAS float*)P.in[I_TSMU]; const GAS float* gn_w = (const GAS float*)P.in[I_GNW]; const GAS float* gn_b = (const GAS float*)P.in[I_GNB];
    const int ch = 8 * lane, hd = lane >> 3;
    float m0v[8], m1v[8], gw8[8], gb8[8];
#pragma unroll
    for (int e = 0; e < 8; ++e) { m0v[e] = ts_mu[C_V + ch + e]; m1v[e] = ts_mu[1536 + C_V + ch + e]; gw8[e] = gn_w[ch + e]; gb8[e] = gn_b[ch + e]; }
    for (int m = m_lo + gw; m < m_hi; m += NGW) {
        const int t = (m < M_CTX) ? (m & (L_CTX - 1)) : ((m - M_CTX) & (L_LAT - 1)), L = (m < M_CTX) ? L_CTX : L_LAT;
        const u32x4v yf = *(const GAS u32x4v*)(YD + (size_t)m * 512 + ch), yb = *(const GAS u32x4v*)(YD + ((size_t)MT + m) * 512 + ch);
        const GAS bf16* pr = proj + (size_t)m * D_IN;
        const u32x4v vc = *(const GAS u32x4v*)(pr + C_V + ch), za = *(const GAS u32x4v*)(pr + C_ZA + ch);
        u32x4v vp = (u32x4v){0u, 0u, 0u, 0u}, vn = (u32x4v){0u, 0u, 0u, 0u};
        if (t > 0) vp = *(const GAS u32x4v*)(pr + C_V + ch - D_IN);
        if (t < L - 1) vn = *(const GAS u32x4v*)(pr + C_V + ch + D_IN);
        const float bon = BS[(size_t)m * 8 + hd] + BS[((size_t)MT + m) * 8 + hd];
        u32x4v cr = (u32x4v){0u, 0u, 0u, 0u};
        if (m >= M_CTX && gridDim.x == 256) cr = *(const GAS u32x4v*)((const GAS bf16*)(P.ws + WS_CORR) + (size_t)(m - M_CTX) * 512 + ch);
        float y[8];
#pragma unroll
        for (int e = 0; e < 8; ++e) { const unsigned sh = (e & 1) ? 16u : 0u; y[e] = bf2f((yf[e >> 1] >> sh) & 0xffffu) + bf2f((yb[e >> 1] >> sh) & 0xffffu); }
        float s = 0.f;
#pragma unroll
        for (int e = 0; e < 8; ++e) { y[e] += bf2f((cr[e >> 1] >> ((e & 1) ? 16u : 0u)) & 0xffffu); s += y[e]; }
        const float mean = oct_sum(s) * (1.0f / 64.0f); float q = 0.f;
#pragma unroll
        for (int e = 0; e < 8; ++e) { y[e] -= mean; q += y[e] * y[e]; }
        const float rstd = 1.0f / sqrtf(oct_sum(q) * (1.0f / 64.0f) + GN_EPS);
        u32x4v o;
#pragma unroll
        for (int e2 = 0; e2 < 4; ++e2) { float r2[2];
#pragma unroll
            for (int hh = 0; hh < 2; ++hh) { const int e = 2 * e2 + hh; const unsigned sh = hh ? 16u : 0u;
                const float c0 = bf2f((vc[e2] >> sh) & 0xffffu), p0 = bf2f((vp[e2] >> sh) & 0xffffu), n0 = bf2f((vn[e2] >> sh) & 0xffffu), z = bf2f((za[e2] >> sh) & 0xffffu);
                const float v = c0 + m0v[e] * (p0 - c0) + m1v[e] * (n0 - c0);
                r2[hh] = (y[e] * rstd * gw8[e] + gb8[e] + bon * v) * silu_f(z); }
            o[e2] = cvtpk(r2[0], r2[1]); }
        *(GAS u32x4v*)(MIX + (size_t)m * D + ch) = o;
    }
}

__device__ __forceinline__ void phase45(const Params& P, LAS unsigned char* lds, int gw, int NGW, int wave, int lane) {
    phase4(P, gw, NGW, lane, 0, M_CTX);
    const GAS bf16* Gm = (const GAS bf16*)(P.ws + WS_G); const GAS bf16* HM = (const GAS bf16*)(P.ws + WS_HMID);
    const GAS bf16* proj = (const GAS bf16*)(P.ws + WS_PROJ); GAS bf16* MIX = (GAS bf16*)(P.ws + WS_H); const GAS bf16* YD = (const GAS bf16*)P.out; const GAS float* BS = (const GAS float*)(P.ws + WS_BS);
    const GAS float* ts_mu = (const GAS float*)P.in[I_TSMU]; const GAS float* gn_w = (const GAS float*)P.in[I_GNW]; const GAS float* gn_b = (const GAS float*)P.in[I_GNB];
    const int lr = lane & 15, lg = lane >> 4;
    LAS bf16* stg = (LAS bf16*)(lds + wave * 16640);
    const int tile = gw, b = tile >> 8, t0 = (tile & 255) * 16, dirs = (t0 >= 2048) ? 0 : 1;
    const int grow0 = (dirs ? (L_LAT - 1 - t0 - 15) : t0) - 2048;
#pragma unroll 1
    for (int hp2 = 0; hp2 < 4; ++hp2) {
        bf16x8 ga[2][2], hb[2][4][2];
#pragma unroll
        for (int q = 0; q < 2; ++q) { const int chain = b * 16 + (2 * hp2 + q) * 2 + dirs;
            const GAS bf16* gp = Gm + ((size_t)chain * 2048 + grow0 + lr) * 64 + 8 * lg; ga[q][0] = *(const GAS bf16x8*)gp; ga[q][1] = *(const GAS bf16x8*)(gp + 32);
#pragma unroll
            for (int nt = 0; nt < 4; ++nt) { const GAS bf16* hp = HM + (size_t)chain * 4096 + (16 * nt + lr) * 64 + 8 * lg; hb[q][nt][0] = *(const GAS bf16x8*)hp; hb[q][nt][1] = *(const GAS bf16x8*)(hp + 32); } }
#pragma unroll
        for (int q = 0; q < 2; ++q)
#pragma unroll
            for (int nt = 0; nt < 4; ++nt) { f32x4 acc = MFMA16(ga[q][0], hb[q][nt][0], ((f32x4){0.f, 0.f, 0.f, 0.f})); acc = MFMA16(ga[q][1], hb[q][nt][1], acc);
                const unsigned w0 = cvtpk(acc[0], acc[1]), w1 = cvtpk(acc[2], acc[3]); LAS bf16* sp = stg + (4 * lg) * 520 + (2 * hp2 + q) * 64 + 16 * nt + lr;
                sp[0] = (bf16)(w0 & 0xffffu); sp[520] = (bf16)(w0 >> 16); sp[1040] = (bf16)(w1 & 0xffffu); sp[1560] = (bf16)(w1 >> 16); }
    }
    const int ch = 8 * lane, hd = lane >> 3;
    float m0v[8], m1v[8], gw8[8], gb8[8];
#pragma unroll
    for (int e = 0; e < 8; ++e) { m0v[e] = ts_mu[C_V + ch + e]; m1v[e] = ts_mu[1536 + C_V + ch + e]; gw8[e] = gn_w[ch + e]; gb8[e] = gn_b[ch + e]; }
#pragma unroll 1
    for (int r = 0; r < 16; ++r) {
        const int t = t0 + r, m = M_CTX + b * L_LAT + t, pl = dirs ? (15 - r) : r;
        const u32x4v yf = *(const GAS u32x4v*)(YD + (size_t)m * 512 + ch), yb = *(const GAS u32x4v*)(YD + ((size_t)MT + m) * 512 + ch);
        const GAS bf16* pr = proj + (size_t)m * D_IN;
        const u32x4v vc = *(const GAS u32x4v*)(pr + C_V + ch), za = *(const GAS u32x4v*)(pr + C_ZA + ch);
        u32x4v vp = (u32x4v){0u, 0u, 0u, 0u}, vn = (u32x4v){0u, 0u, 0u, 0u};
        if (t > 0) vp = *(const GAS u32x4v*)(pr + C_V + ch - D_IN);
        if (t < L_LAT - 1) vn = *(const GAS u32x4v*)(pr + C_V + ch + D_IN);
        const float bon = BS[(size_t)m * 8 + hd] + BS[((size_t)MT + m) * 8 + hd];
        const u32x4v cr = *(const LAS u32x4v*)(stg + pl * 520 + ch);
        float y[8]; float s = 0.f;
#pragma unroll
        for (int e = 0; e < 8; ++e) { const unsigned sh = (e & 1) ? 16u : 0u; y[e] = bf2f((yf[e >> 1] >> sh) & 0xffffu) + bf2f((yb[e >> 1] >> sh) & 0xffffu) + bf2f((cr[e >> 1] >> sh) & 0xffffu); s += y[e]; }
        const float mean = oct_sum(s) * (1.0f / 64.0f); float q = 0.f;
#pragma unroll
        for (int e = 0; e < 8; ++e) { y[e] -= mean; q += y[e] * y[e]; }
        const float rstd = 1.0f / sqrtf(oct_sum(q) * (1.0f / 64.0f) + GN_EPS);
        u32x4v o;
#pragma unroll
        for (int e2 = 0; e2 < 4; ++e2) { float r2[2];
#pragma unroll
            for (int hh = 0; hh < 2; ++hh) { const int e = 2 * e2 + hh; const unsigned sh = hh ? 16u : 0u;
                const float c0 = bf2f((vc[e2] >> sh) & 0xffffu), p0 = bf2f((vp[e2] >> sh) & 0xffffu), n0 = bf2f((vn[e2] >> sh) & 0xffffu), z = bf2f((za[e2] >> sh) & 0xffffu);
                const float v = c0 + m0v[e] * (p0 - c0) + m1v[e] * (n0 - c0);
                r2[hh] = (y[e] * rstd * gw8[e] + gb8[e] + bon * v) * silu_f(z); }
            o[e2] = cvtpk(r2[0], r2[1]); }
        *(GAS u32x4v*)(MIX + (size_t)m * D + ch) = o;
    }
}

__device__ __forceinline__ void phase6(const Params& P, int gw, int NGW, int lane) {
    const GAS float* mod = (const GAS float*)(P.ws + WS_MOD); const GAS float* ln_post = (const GAS float*)P.in[I_LNPOST]; const GAS bf16* OB = (const GAS bf16*)(P.ws + WS_OUTB);
#pragma unroll 1
    for (int seg = 0; seg < 9; ++seg) {
        const int m_lo = (seg == 0) ? 0 : M_CTX + (seg - 1) * L_LAT, m_hi = (seg == 0) ? M_CTX : m_lo + L_LAT;
        const GAS float* gate = mod + seg * 3072 + 2048;
        f32x4 wg[4];
#pragma unroll
        for (int j = 0; j < 4; ++j) { const int col = 4 * (lane + 64 * j); wg[j] = *(const GAS f32x4*)(ln_post + col) * *(const GAS f32x4*)(gate + col); }
        for (int m = m_lo + gw; m < m_hi; m += NGW) {
            const GAS f32x4* xr = (const GAS f32x4*)x_row(P, m) + lane; GAS f32x4* orow = (GAS f32x4*)(P.out + (size_t)m * D) + lane;
            const GAS u32x2v* ob = (const GAS u32x2v*)(OB + (size_t)m * D) + lane;
            f32x4 o[4], xv[4]; float ss = 0.f;
#pragma unroll
            for (int j = 0; j < 4; ++j) { const u32x2v r = ob[64 * j]; xv[j] = xr[64 * j]; o[j][0] = bf2f(r.x & 0xffffu); o[j][1] = bf2f(r.x >> 16); o[j][2] = bf2f(r.y & 0xffffu); o[j][3] = bf2f(r.y >> 16);
                ss += (o[j][0] * o[j][0] + o[j][1] * o[j][1]) + (o[j][2] * o[j][2] + o[j][3] * o[j][3]); }
            const float rstd = 1.0f / sqrtf(wave_sum(ss) * (1.0f / D) + NORM_EPS);
#pragma unroll
            for (int j = 0; j < 4; ++j) orow[64 * j] = xv[j] + o[j] * rstd * wg[j];
        }
    }
}

struct Gemm1Order {
    int G, c; pg8::StaticOrder so;
    __device__ __forceinline__ void init(int G_, int c_) { G = G_; c = c_; so.init(MT, D_IN, G_, c_); }
    __device__ __forceinline__ bool next(int i, pg8::Unit& u) const {
        if (G != 256) return so.next(i, u);
        const int j = 32 * i + (c >> 3), x = c & 7; if (j >= 300) return false;
        if (j < 240) { const int grp = (j >= 120) ? 1 : 0, idx = j - 120 * grp; u.pm = 32 + 16 * x + 8 * grp + (idx & 7); u.pn = idx >> 3; }
        else { const int jj = j - 240; u.pm = 4 * x + (jj & 3); u.pn = jj >> 2; }
        return true;
    }
    __device__ __forceinline__ void a_ready(const pg8::Unit&) const {}
    __device__ __forceinline__ void done(const pg8::Unit&, int ui) const {
        if (G == 256 && ui == 7) { asm volatile("s_waitcnt vmcnt(0)" ::: "memory"); __builtin_amdgcn_s_barrier();
            if (threadIdx.x == 0) split_arrive(xb, 0); }
    }
    XcdBarrier xb;
};

constexpr int N_PHASES = 8;
__global__ void __launch_bounds__(NTHREADS, 2) fwd_kernel(Params P) {
    extern __shared__ __attribute__((aligned(16))) unsigned char lds_raw[];
    LAS unsigned char* lds = (LAS unsigned char*)lds_raw;
    const int tid = threadIdx.x, lane = tid & 63, wave = __builtin_amdgcn_readfirstlane(tid >> 6);
    const int G = gridDim.x, gw = blockIdx.x * NWAVES + wave, NGW = G * NWAVES;
    const int lo = P.ph_lo, hi = P.ph_hi;
    volatile LAS unsigned* bst = (volatile LAS unsigned*)(lds + LDS_BYTES - 16);
    if (tid < 2) bst[tid] = 0u;
    __syncthreads();
    XcdBarrier bar = xcd_barrier_post((unsigned*)P.ws, bst);
#define IN(k) (lo <= (k) && (k) < hi)
#define SEAM(k) do { if (IN(k) && IN((k) + 1)) xcd_barrier(bar); } while (0)
#define PP(name) const Params* name = (const Params*)__builtin_amdgcn_kernarg_segment_ptr(); asm volatile("" : "+s"(name))
    if (IN(0)) { PP(q); phase0(*q, lds, gw, NGW, wave, lane);
        if (G > 96) { if ((int)blockIdx.x >= 96) weight_copies(*q, lds, gw - 96 * NWAVES, NGW - 96 * NWAVES, wave, lane); }
        else weight_copies(*q, lds, gw, NGW, wave, lane); }
    SEAM(0);
    if (IN(1)) { PP(q); phase1(*q, gw, NGW, lane); }
    SEAM(1);
    if (IN(2)) { PP(q); unsigned char* ws = q->ws;
        pg8::Gemm g{(const pg8::bf16_t*)(ws + WS_H), (const pg8::bf16_t*)(ws + WS_WIN), MT, D_IN, D}; Gemm1Order S; S.init(G, (int)blockIdx.x); S.xb = bar;
        pg8::EpiBf16 E{(pg8::bf16_t*)(ws + WS_PROJ), D_IN, C_WD / 256};
        pg8::gemm_phase<pg8::EpiBf16, Gemm1Order, true, true>(lds, g, S, E);
        if (G == 256 && tid == 0) split_arrive(bar, 1); }
    if (G != 256) SEAM(2);
    if (IN(3)) { PP(q); phase3(*q, lds, bar); }
    SEAM(3);
    if (G == 256) { if (IN(4)) { PP(q); phase45(*q, lds, gw, NGW, wave, lane); } }
    else { if (IN(4)) { PP(q); phase35(*q, lds, gw, NGW, wave, lane); }
        SEAM(4);
        if (IN(5)) { PP(q); phase4(*q, gw, NGW, lane, 0, MT); } }
    SEAM(5);
    if (IN(6)) { PP(q); unsigned char* ws = q->ws;
        pg8::Gemm g{(const pg8::bf16_t*)(ws + WS_H), (const pg8::bf16_t*)(ws + WS_WOUT), MT, D, D}; pg8::StaticOrder S; S.init(MT, D, G, (int)blockIdx.x);
        pg8::EpiBf16 E{(pg8::bf16_t*)(ws + WS_OUTB), D, -1};
        pg8::gemm_phase<pg8::EpiBf16, pg8::StaticOrder, true, true>(lds, g, S, E); }
    SEAM(6);
    if (IN(7)) { PP(q); phase6(*q, gw, NGW, lane); }
#undef PP
#undef IN
#undef SEAM
}

#ifndef N_LAUNCHES
#define N_LAUNCHES 1
#endif
extern "C" void kernel_launch(void* const* d_in, const int* in_sizes, int n_in, void* d_out, int out_size, void* d_ws, size_t ws_size, hipStream_t stream) {
    static int grid = 0;
    if (grid == 0) {
        if (n_in != 26 || ws_size < WS_END) { fprintf(stderr, "kernel_launch: unexpected n_in %d / ws_size %zu (need %zu)\n", n_in, ws_size, (size_t)WS_END); grid = -1; return; }
        int dev = 0, cus = 0, per_cu = 0;
        hipGetDevice(&dev); hipDeviceGetAttribute(&cus, hipDeviceAttributeMultiprocessorCount, dev);
        if (hipFuncSetAttribute((const void*)fwd_kernel, hipFuncAttributeMaxDynamicSharedMemorySize, LDS_BYTES) != hipSuccess) { fprintf(stderr, "kernel_launch: hipFuncSetAttribute failed\n"); grid = -1; return; }
        if (hipOccupancyMaxActiveBlocksPerMultiprocessor(&per_cu, (const void*)fwd_kernel, NTHREADS, LDS_BYTES) != hipSuccess || per_cu < 1) { fprintf(stderr, "kernel_launch: occupancy query says %d\n", per_cu); per_cu = 1; }
        (void)hipGetLastError();
        grid = cus * 1;
        fprintf(stderr, "kernel_launch: cus %d per_cu %d grid %d\n", cus, per_cu, grid);
    }
    if (grid < 0) return;
    hipMemsetAsync((char*)d_ws + WS_CTL, 0, CTL_ZERO_BYTES, stream);
    Params p{};
    for (int i = 0; i < 26; ++i) p.in[i] = (const float*)d_in[i];
    p.out = (float*)d_out; p.ws = (unsigned char*)d_ws;
    if (N_LAUNCHES == 1) {
        p.ph_lo = 0; p.ph_hi = N_PHASES;
        hipLaunchKernelGGL(fwd_kernel, dim3(grid), dim3(NTHREADS), LDS_BYTES, stream, p);
    } else {
        for (int ph = 0; ph < N_PHASES; ++ph) { p.ph_lo = ph; p.ph_hi = ph + 1; hipLaunchKernelGGL(fwd_kernel, dim3(grid), dim3(NTHREADS), LDS_BYTES, stream, p); }
    }
}
```

```cpp
#include <hip/hip_runtime.h>
#include <cstdio>
#include <cstdint>
namespace pg8 {
#define PG8_LAS __attribute__((address_space(3)))
typedef unsigned short bf16_t;
typedef short bf16x8 __attribute__((ext_vector_type(8)));
typedef float f32x4 __attribute__((ext_vector_type(4)));
typedef unsigned u32x4 __attribute__((ext_vector_type(4)));
constexpr int BM = 256, BK = 64, HALF = 128, HTB = HALF * BK * 2  , STAGE_BYTES = 8 * HTB, NXCD = 8, WGM = 8;

__host__ __device__ __forceinline__ int lds_byte(int r, int c) { const int st = (r >> 4) * 2 + (c >> 5), rr = r & 15, cc = c & 31, ob = rr * 64 + cc * 2; return st * 1024 + (ob ^ (((ob >> 9) & 1) << 5)); }
__host__ __device__ __forceinline__ void stage_rc(int b, int& R, int& C) { const int st = b / 1024, sb = b % 1024, swz = sb ^ (((sb >> 9) & 1) << 5); R = (st >> 1) * 16 + swz / 64; C = (st & 1) * 32 + (swz % 64) / 2; }
__host__ __device__ __forceinline__ int perm32(int rho) { const int n = rho >> 4, i = rho & 15; return 8 * (i >> 2) + 4 * n + (i & 3); }

struct Unit { int pm, pn; };
struct Gemm { const bf16_t* A; const bf16_t* Bt; int M, N, K; };

struct StaticOrder {
    int nM, nN, nwg, G, c;
    __host__ __device__ void init(int M, int N, int G_, int c_) { nM = M / BM; nN = N / BM; nwg = nM * nN; G = G_; c = c_; }
    __host__ __device__ bool next(int i, Unit& u) const {
        const long L = (long)i * G + c; if (L >= nwg) return false;
        int wgid = (int)L; { const int q = nwg / NXCD, r = nwg % NXCD, xcd = wgid % NXCD, off = wgid / NXCD; wgid = (xcd < r ? xcd * (q + 1) : r * (q + 1) + (xcd - r) * q) + off; }
        const int nig = WGM * nN, gid = wgid / nig, fm = gid * WGM, gsz = (nM - fm) < WGM ? (nM - fm) : WGM;
        u.pm = fm + ((wgid % nig) % gsz); u.pn = (wgid % nig) / gsz; return true;
    }
    __device__ __forceinline__ void a_ready(const Unit&) const {}
    __device__ __forceinline__ void done(const Unit&, int) const {}
};
typedef float f32x2p __attribute__((ext_vector_type(2)));
typedef __bf16 bf16x2p __attribute__((ext_vector_type(2)));
__device__ __forceinline__ unsigned cvt_pk_bf16(float lo, float hi) { f32x2p v; v.x = lo; v.y = hi; return __builtin_bit_cast(unsigned, __builtin_convertvector(v, bf16x2p)); }
struct EpiBf16 {
    static constexpr bool PERM = true, AFTER_DRAIN = false;
    bf16_t* O; int ldc; int tanh_pn;
    __device__ __forceinline__ void operator()(const f32x4 (&acc)[2][2][4][2], const Unit& u, int wr, int wc, int fr, int fq) const {
        const int row0 = u.pm * BM + wr * 64 + fr, col0 = u.pn * BM + wc * 32 + 8 * fq;
#pragma unroll
        for (int ai = 0; ai < 2; ++ai)
#pragma unroll
            for (int m = 0; m < 4; ++m) { bf16_t* rowp = O + (size_t)(row0 + ai * HALF + m * 16) * ldc + col0;
#pragma unroll
                for (int bj = 0; bj < 2; ++bj) { f32x4 v0 = acc[ai][bj][m][0], v1 = acc[ai][bj][m][1];
                    if (bj == 0 && u.pn == tanh_pn) {
#pragma unroll
                        for (int j = 0; j < 4; ++j) { v0[j] = 1.0f - 2.0f * __builtin_amdgcn_rcpf(1.0f + __builtin_amdgcn_exp2f(2.88539008f * v0[j])); v1[j] = 1.0f - 2.0f * __builtin_amdgcn_rcpf(1.0f + __builtin_amdgcn_exp2f(2.88539008f * v1[j])); } }
                    u32x4 w; w.x = cvt_pk_bf16(v0[0], v0[1]); w.y = cvt_pk_bf16(v0[2], v0[3]); w.z = cvt_pk_bf16(v1[0], v1[1]); w.w = cvt_pk_bf16(v1[2], v1[3]);
                    __builtin_nontemporal_store(w, (u32x4*)(rowp + bj * HALF)); } }
    }
};
struct EpiF32 {
    static constexpr bool PERM = false, AFTER_DRAIN = false;
    float* C; int ldc;
    __device__ __forceinline__ void operator()(const f32x4 (&acc)[2][2][4][2], const Unit& u, int wr, int wc, int fr, int fq) const {
        const int row0 = u.pm * BM + wr * 64 + fr, col0 = u.pn * BM + wc * 32 + 4 * fq;
#pragma unroll
        for (int ai = 0; ai < 2; ++ai)
#pragma unroll
            for (int m = 0; m < 4; ++m) { float* rowp = C + (size_t)(row0 + ai * HALF + m * 16) * ldc + col0;
#pragma unroll
                for (int bj = 0; bj < 2; ++bj)
#pragma unroll
                    for (int n = 0; n < 2; ++n) *(f32x4*)(rowp + bj * HALF + n * 16) = acc[ai][bj][m][n]; }
    }
};
template <class Epi, class Sched, bool ALIGN_EPI = false, bool SP2 = false>
__device__ __forceinline__ void gemm_phase(PG8_LAS unsigned char* lds, const Gemm g, const Sched& S, const Epi& E) {
    const int tid = threadIdx.x, wid = __builtin_amdgcn_readfirstlane(tid >> 6), lane = tid & 63, wr = wid >> 2, wc = wid & 3, fr = lane & 15, fq = lane >> 4;
    const int K = g.K, nt = K / BK;
    unsigned voffA[2], voffB[2];
#pragma unroll
    for (int i = 0; i < 2; ++i) { int R, C; stage_rc(tid * 16 + i * 8192, R, C); const int Rb = Epi::PERM ? ((R & ~31) + perm32(R & 31)) : R;
        voffA[i] = (unsigned)(R * K + C) * 2u; voffB[i] = (unsigned)(Rb * K + C) * 2u; }
    const size_t kstep = (size_t)(BK * 2);
    const size_t hstep = (size_t)HALF * K * 2;
    const size_t tstep = 2 * hstep;
    const unsigned ldsw = (unsigned)wid * 1024u;
    const int aoff = lds_byte(wr * 64 + fr, fq * 8), boff = lds_byte(wc * 32 + fr, fq * 8);
#define PG8_SA(b, h) (((b) * 2 + (h)) * HTB)
#define PG8_SB(b, h) ((4 + (b) * 2 + (h)) * HTB)
#define PG8_STAGE(bufoff, gbase, voff) do { _Pragma("unroll") for (int _i = 0; _i < 2; ++_i) \
        __builtin_amdgcn_global_load_lds((const unsigned*)((const char*)(gbase) + (voff)[_i]), (PG8_LAS unsigned*)(lds + (bufoff) + ldsw + _i * 8192), 16, 0, 0); } while (0)
#define PG8_LDA(dst, b, h) do { _Pragma("unroll") for (int m = 0; m < 4; ++m) _Pragma("unroll") for (int k = 0; k < 2; ++k) dst[m][k] = *(const PG8_LAS bf16x8*)(lds + PG8_SA(b, h) + aoff + m * 2048 + k * 1024); } while (0)
#define PG8_LDB(dst, b, h) do { _Pragma("unroll") for (int n = 0; n < 2; ++n) _Pragma("unroll") for (int k = 0; k < 2; ++k) dst[n][k] = *(const PG8_LAS bf16x8*)(lds + PG8_SB(b, h) + boff + n * 2048 + k * 1024); } while (0)
#define PG8_MMA(ai, bj, At, Bt) do { __builtin_amdgcn_s_setprio(1); _Pragma("unroll") for (int m = 0; m < 4; ++m) _Pragma("unroll") for (int n = 0; n < 2; ++n) _Pragma("unroll") for (int k = 0; k < 2; ++k) \
        acc[ai][bj][m][n] = __builtin_amdgcn_mfma_f32_16x16x32_bf16(Bt[n][k], At[m][k], acc[ai][bj][m][n], 0, 0, 0); __builtin_amdgcn_s_setprio(0); } while (0)
#define PG8_WAIT_V(n) asm volatile("s_waitcnt vmcnt(" #n ")" ::: "memory")
#define PG8_WAIT_L(n) asm volatile("s_waitcnt lgkmcnt(" #n ")" ::: "memory")
#define PG8_BAR __builtin_amdgcn_s_barrier()
#define PG8_SCHED __builtin_amdgcn_sched_barrier(0)
    Unit cur, nxt; int ui = 0;
    if (!S.next(0, cur)) return;
    f32x4 acc[2][2][4][2];
#pragma unroll
    for (int a = 0; a < 2; ++a)
#pragma unroll
        for (int b = 0; b < 2; ++b)
#pragma unroll
            for (int m = 0; m < 4; ++m)
#pragma unroll
                for (int n = 0; n < 2; ++n) acc[a][b][m][n] = (f32x4){0.f, 0.f, 0.f, 0.f};
    bf16x8 At[4][2], B0[2][2], B1[2][2];
    const char* cA = (const char*)g.A + (size_t)cur.pm * tstep; const char* cB = (const char*)g.Bt + (size_t)cur.pn * tstep;
    S.a_ready(cur);
    if constexpr (SP2) {
        PG8_STAGE(PG8_SB(0, 0), cB, voffB); PG8_STAGE(PG8_SB(0, 1), cB + hstep, voffB); PG8_STAGE(PG8_SA(0, 0), cA, voffA); PG8_STAGE(PG8_SA(0, 1), cA + hstep, voffA);
        if (wr == 1) PG8_BAR;
        PG8_WAIT_V(2); PG8_BAR;
        PG8_STAGE(PG8_SB(1, 0), cB + kstep, voffB); PG8_STAGE(PG8_SA(1, 0), cA + kstep, voffA); PG8_STAGE(PG8_SB(1, 1), cB + hstep + kstep, voffB);
        PG8_WAIT_V(6); PG8_BAR;
    } else {
        PG8_STAGE(PG8_SB(0, 0), cB, voffB); PG8_STAGE(PG8_SA(0, 0), cA, voffA); PG8_STAGE(PG8_SB(0, 1), cB + hstep, voffB); PG8_STAGE(PG8_SA(0, 1), cA + hstep, voffA);
        if (wr == 1) PG8_BAR;
        PG8_WAIT_V(4); PG8_BAR;
        PG8_STAGE(PG8_SB(1, 0), cB + kstep, voffB); PG8_STAGE(PG8_SA(1, 0), cA + kstep, voffA); PG8_STAGE(PG8_SB(1, 1), cB + hstep + kstep, voffB);
        PG8_WAIT_V(6); PG8_BAR;
    }
    for (;;) {
        const bool has_next = S.next(ui + 1, nxt);
        const char* nA = has_next ? (const char*)g.A + (size_t)nxt.pm * tstep : cA; const char* nB = has_next ? (const char*)g.Bt + (size_t)nxt.pn * tstep : cB;
        for (int t = 0; t < nt; t += 2) {
            const bool last = (t == nt - 2);
            const char* a1 = cA + (size_t)(t + 1) * kstep;
            const char* a2 = last ? nA : cA + (size_t)(t + 2) * kstep; const char* b2 = last ? nB : cB + (size_t)(t + 2) * kstep;
            const char* a3 = a2 + kstep; const char* b3 = b2 + kstep;
            if (last && has_next) S.a_ready(nxt);
            if constexpr (SP2) {
            PG8_LDB(B0, 0, 0); PG8_LDB(B1, 0, 1); PG8_SCHED; PG8_LDA(At, 0, 0); PG8_STAGE(PG8_SA(1, 1), a1 + hstep, voffA);
            PG8_WAIT_V(8); PG8_WAIT_L(0); PG8_BAR; PG8_MMA(0, 0, At, B0); PG8_MMA(0, 1, At, B1); PG8_BAR; PG8_SCHED;
            PG8_LDA(At, 0, 1); PG8_STAGE(PG8_SB(0, 0), b2, voffB); PG8_STAGE(PG8_SB(0, 1), b2 + hstep, voffB); PG8_STAGE(PG8_SA(0, 0), a2, voffA);
            PG8_WAIT_V(8); PG8_WAIT_L(0); PG8_BAR; PG8_MMA(1, 0, At, B0); PG8_MMA(1, 1, At, B1); PG8_BAR; PG8_SCHED;
            PG8_LDB(B0, 1, 0); PG8_LDB(B1, 1, 1); PG8_SCHED; PG8_LDA(At, 1, 0); PG8_STAGE(PG8_SA(0, 1), a2 + hstep, voffA);
            PG8_WAIT_V(8); PG8_WAIT_L(0); PG8_BAR; PG8_MMA(0, 0, At, B0); PG8_MMA(0, 1, At, B1); PG8_BAR; PG8_SCHED;
            PG8_LDA(At, 1, 1); PG8_STAGE(PG8_SB(1, 0), b3, voffB); PG8_STAGE(PG8_SB(1, 1), b3 + hstep, voffB); PG8_STAGE(PG8_SA(1, 0), a3, voffA);
            PG8_WAIT_V(8); PG8_WAIT_L(0); PG8_BAR; PG8_MMA(1, 0, At, B0); PG8_MMA(1, 1, At, B1); PG8_BAR; PG8_SCHED;
            } else {
            PG8_LDB(B0, 0, 0); PG8_SCHED; PG8_LDA(At, 0, 0); PG8_STAGE(PG8_SA(1, 1), a1 + hstep, voffA);
            PG8_WAIT_L(8); PG8_BAR; PG8_WAIT_L(0); PG8_MMA(0, 0, At, B0); PG8_BAR; PG8_SCHED;
            PG8_LDB(B1, 0, 1); PG8_STAGE(PG8_SB(0, 0), b2, voffB);
            PG8_BAR; PG8_WAIT_L(0); PG8_MMA(0, 1, At, B1); PG8_BAR;
            PG8_LDA(At, 0, 1); PG8_STAGE(PG8_SA(0, 0), a2, voffA);
            PG8_BAR; PG8_WAIT_L(0); PG8_MMA(1, 0, At, B0); PG8_BAR; PG8_SCHED;
            PG8_STAGE(PG8_SB(0, 1), b2 + hstep, voffB);
            PG8_WAIT_V(6); PG8_BAR; PG8_MMA(1, 1, At, B1); PG8_BAR;
            PG8_LDB(B0, 1, 0); PG8_SCHED; PG8_LDA(At, 1, 0); PG8_STAGE(PG8_SA(0, 1), a2 + hstep, voffA);
            PG8_WAIT_L(8); PG8_BAR; PG8_WAIT_L(0); PG8_MMA(0, 0, At, B0); PG8_BAR; PG8_SCHED;
            PG8_LDB(B1, 1, 1); PG8_STAGE(PG8_SB(1, 0), b3, voffB);
            PG8_BAR; PG8_WAIT_L(0); PG8_MMA(0, 1, At, B1); PG8_BAR;
            PG8_LDA(At, 1, 1); PG8_STAGE(PG8_SA(1, 0), a3, voffA);
            PG8_BAR; PG8_WAIT_L(0); PG8_MMA(1, 0, At, B0); PG8_BAR; PG8_SCHED;
            PG8_STAGE(PG8_SB(1, 1), b3 + hstep, voffB);
            PG8_WAIT_V(6); PG8_BAR; PG8_MMA(1, 1, At, B1); PG8_BAR;
            }
        }
        if constexpr (ALIGN_EPI) { if (wr == 0) PG8_BAR; }
        if constexpr (!Epi::AFTER_DRAIN) { E(acc, cur, wr, wc, fr, fq); S.done(cur, ui); }
        if (!has_next) break;
#pragma unroll
        for (int a = 0; a < 2; ++a)
#pragma unroll
            for (int b = 0; b < 2; ++b)
#pragma unroll
                for (int m = 0; m < 4; ++m)
#pragma unroll
                    for (int n = 0; n < 2; ++n) acc[a][b][m][n] = (f32x4){0.f, 0.f, 0.f, 0.f};
        cur = nxt; cA = nA; cB = nB; ++ui;
        if constexpr (ALIGN_EPI) { if (wr == 1) PG8_BAR; }
    }
    PG8_WAIT_V(0);
    if constexpr (!ALIGN_EPI) { if (wr == 0) PG8_BAR; }
    PG8_BAR;
    if constexpr (Epi::AFTER_DRAIN) { E.fused(acc, cur, wr, wc, fr, fq, lds, wid, lane); S.done(cur, ui); }
#undef PG8_SA
#undef PG8_SB
#undef PG8_STAGE
#undef PG8_LDA
#undef PG8_LDB
#undef PG8_MMA
#undef PG8_WAIT_V
#undef PG8_WAIT_L
#undef PG8_BAR
#undef PG8_SCHED
}
}

constexpr int D = 1024, M_CTX = 32 * 256, M_LAT = 8 * 4096, MT = M_CTX + M_LAT;
constexpr int L_CTX = 256, L_LAT = 4096, NB_CTX = 32, NB_LAT = 8;
constexpr int D_IN = 3840, D_A = 512, NH = 8, HD = 64;
constexpr int C_R = 0, C_K = 512, C_V = 1024, C_ZA = 1536, C_WD = 2048, C_AD = 2176, C_U = 2304, C_VB = 2816, C_ZB = 3328;
constexpr float NORM_EPS = 1e-6f, GN_EPS = 6.4e-4f;
constexpr size_t STATE_ELEMS = (size_t)NB_CTX * NH * HD * HD;

constexpr size_t MiB = 1u << 20;
constexpr size_t WS_CTL = 0, CTL_ZERO_BYTES = 192 * 1024;
constexpr size_t CW_QUEUE = 15 * 1024;
constexpr size_t WS_MOD = 64 * 1024;
constexpr size_t WS_WIN = 1 * MiB;
constexpr size_t WS_WOUT = 9 * MiB;
constexpr size_t WS_WSB = 11 * MiB;
constexpr size_t WS_BS = 12 * MiB;
constexpr size_t WS_H = 16 * MiB;
constexpr size_t WS_PROJ = 96 * MiB;
constexpr size_t WS_OUTB = WS_PROJ + 64 * MiB;
constexpr size_t WS_G = WS_PROJ + (size_t)MT * D_IN * 2;
constexpr size_t WS_HMID = WS_G + (size_t)128 * 2048 * 64 * 2;
constexpr size_t WS_CORR = WS_HMID + (size_t)128 * 4096 * 2;
constexpr size_t WS_END = WS_CORR + (size_t)M_LAT * 512 * 2;
static_assert((size_t)M_CTX * D_IN * 2 <= 64 * MiB && 64 * MiB + (size_t)MT * D * 2 <= (size_t)MT * D_IN * 2, "OUTB overlay");
static_assert(WS_WIN + (size_t)D_IN * D * 2 <= WS_WOUT && WS_BS + (size_t)2 * MT * 8 * 4 <= WS_H && WS_H + (size_t)MT * D * 2 <= WS_PROJ, "ws map");

constexpr int LDS_BYTES = 163840;
constexpr int NWAVES = 8, NTHREADS = 512;

#define LAS __attribute__((address_space(3)))
#define GAS __attribute__((address_space(1)))
typedef unsigned short bf16;
typedef float f32x4 __attribute__((ext_vector_type(4)));
typedef short bf16x8 __attribute__((ext_vector_type(8)));
typedef unsigned u32x4v __attribute__((ext_vector_type(4)));
typedef unsigned u32x2v __attribute__((ext_vector_type(2)));

__device__ __forceinline__ float bf2f(unsigned b) { return __uint_as_float(b << 16); }
__device__ __forceinline__ unsigned f2bf(float f) { unsigned u = __float_as_uint(f); return (u + 0x7fffu + ((u >> 16) & 1u)) >> 16; }
__device__ __forceinline__ unsigned pk2(float lo, float hi) { return f2bf(lo) | (f2bf(hi) << 16); }
template <int CTRL> __device__ __forceinline__ float dpp_f(float v) { return __int_as_float(__builtin_amdgcn_update_dpp(0, __float_as_int(v), CTRL, 0xf, 0xf, true)); }
__device__ __forceinline__ float quad_sum4(float v) { v += dpp_f<0xB1>(v); v += dpp_f<0x4E>(v); return v; }
__device__ __forceinline__ float wave_sum(float v) {
    v += dpp_f<0xB1>(v); v += dpp_f<0x4E>(v);
    v += dpp_f<0x141>(v); v += dpp_f<0x140>(v);
    v += __int_as_float(__builtin_amdgcn_ds_swizzle(__float_as_int(v), 0x401F));
    return __int_as_float(__builtin_amdgcn_readlane(__float_as_int(v), 0)) + __int_as_float(__builtin_amdgcn_readlane(__float_as_int(v), 32));
}
__device__ __forceinline__ float silu_f(float x) { return x * __builtin_amdgcn_rcpf(1.0f + __builtin_amdgcn_exp2f(-1.44269504f * x)); }
__device__ __forceinline__ float sigmoid_f(float x) { return 1.0f / (1.0f + __expf(-x)); }

struct Params { const float* in[26]; float* out; unsigned char* ws; int ph_lo, ph_hi; };

#ifdef PROBE_KA
constexpr size_t CW_TS = 48 * 1024;
__device__ __forceinline__ void ts_mark(int k) { if (threadIdx.x == 0) { const Params* q = (const Params*)__builtin_amdgcn_kernarg_segment_ptr(); asm volatile("" : "+s"(q));
    ((unsigned*)(q->ws + CW_TS))[blockIdx.x * 16 + k] = (unsigned)__builtin_amdgcn_s_memrealtime(); } }
#define TS(ws, k) ts_mark(k)
#else
#define TS(ws, k) do {} while (0)
#endif
enum { I_XP = 0, I_XS, I_C, I_SF, I_SB, I_CCTX, I_LNPRE, I_LNPOST, I_WMOD, I_BMOD, I_WIN, I_TSMU, I_W0, I_WUP, I_A0, I_AUP, I_KK, I_KA, I_RK, I_GNW, I_GNB, I_SLG, I_SLB, I_WS, I_BSS, I_WOUT };

__device__ __forceinline__ void transpose_item(const float* W, int K, int N, bf16* WT, LAS float* scr, int item, int lane) {
    const int nblk = N / 32, kb = item / nblk, nb = item % nblk, k0 = 64 * kb, n0 = 32 * nb;
    float tv[32];
#pragma unroll
    for (int i = 0; i < 32; ++i) tv[i] = ((const GAS float*)W)[(size_t)(k0 + 2 * i + (lane >> 5)) * N + n0 + (lane & 31)];
#pragma unroll
    for (int i = 0; i < 32; ++i) scr[(2 * i + (lane >> 5)) * 33 + (lane & 31)] = tv[i];
    asm volatile("s_waitcnt lgkmcnt(0)" ::: "memory");
    const int c = lane & 7;
#pragma unroll
    for (int j = 0; j < 4; ++j) { const int n = (lane >> 3) + 8 * j; const LAS float* s = scr + (8 * c) * 33 + n;
        u32x4v o; o.x = pk2(s[0 * 33], s[1 * 33]); o.y = pk2(s[2 * 33], s[3 * 33]); o.z = pk2(s[4 * 33], s[5 * 33]); o.w = pk2(s[6 * 33], s[7 * 33]);
        *(u32x4v*)(WT + (size_t)(n0 + n) * K + k0 + 8 * c) = o; }
    asm volatile("s_waitcnt lgkmcnt(0)" ::: "memory");
}

__device__ __forceinline__ void phase0(const Params& P, LAS unsigned char* lds, int gw, int NGW, int wave, int lane) {
    unsigned char* ws = P.ws;
    float* mod = (float*)(ws + WS_MOD);
    const float* w_mod = P.in[I_WMOD]; const float* b_mod = P.in[I_BMOD]; const float* cc = P.in[I_C]; const float* cctx = P.in[I_CCTX];
    if (blockIdx.x < 96 && gridDim.x >= 96) {
        const int cgp = blockIdx.x % 12, rg = blockIdx.x / 12, col = cgp * 256 + lane * 4, r0 = rg * 128 + wave * 16;
        f32x4 acc[9];
#pragma unroll
        for (int v = 0; v < 9; ++v) acc[v] = (f32x4){0.f, 0.f, 0.f, 0.f};
        f32x4 w[16];
#pragma unroll
        for (int i = 0; i < 16; ++i) w[i] = *(const GAS f32x4*)((const GAS float*)w_mod + (size_t)(r0 + i) * 3072 + col);
#pragma unroll
        for (int i = 0; i < 16; ++i) {
#pragma unroll
            for (int v = 0; v < 9; ++v) { const float cv = (v == 0) ? cctx[r0 + i] : cc[(v - 1) * 1024 + r0 + i]; acc[v] += silu_f(cv) * w[i]; }
        }
        LAS f32x4* red = (LAS f32x4*)lds;
#pragma unroll
        for (int v = 0; v < 9; ++v) red[(wave * 9 + v) * 64 + lane] = acc[v];
        __syncthreads();
        for (int idx = wave * 64 + lane; idx < 9 * 64; idx += 512) {
            f32x4 s = red[idx];
#pragma unroll
            for (int w2 = 1; w2 < 8; ++w2) s += red[w2 * 576 + idx];
            const int v = idx >> 6, l = idx & 63, c2 = cgp * 256 + l * 4;
            if (rg == 0) s += *(const f32x4*)(b_mod + c2);
#pragma unroll
            for (int e = 0; e < 4; ++e) atomicAdd(mod + v * 3072 + c2 + e, s[e]);
        }
        __syncthreads();
    } else if (gridDim.x < 96) {
        for (int task = gw; task < 12 * 64; task += NGW) {
            const int cgp = task % 12, rs = task / 12, col = cgp * 256 + lane * 4;
            f32x4 acc[9];
#pragma unroll
            for (int v = 0; v < 9; ++v) acc[v] = (f32x4){0.f, 0.f, 0.f, 0.f};
            for (int i = rs * 16; i < rs * 16 + 16; ++i) { const f32x4 w = *(const GAS f32x4*)((const GAS float*)w_mod + (size_t)i * 3072 + col);
#pragma unroll
                for (int v = 0; v < 9; ++v) { const float cv = (v == 0) ? cctx[i] : cc[(v - 1) * 1024 + i]; acc[v] += silu_f(cv) * w; } }
            if (rs == 0) { const f32x4 b = *(const f32x4*)(b_mod + col);
#pragma unroll
                for (int v = 0; v < 9; ++v) acc[v] += b; }
#pragma unroll
            for (int v = 0; v < 9; ++v)
#pragma unroll
                for (int e = 0; e < 4; ++e) atomicAdd(mod + v * 3072 + col + e, acc[v][e]);
        }
    }
}

__device__ __forceinline__ void weight_copies(const Params& P, LAS unsigned char* lds, int gw, int NGW, int wave, int lane) {
    unsigned char* ws = P.ws;
    LAS float* scr = (LAS float*)(lds + wave * 16384);
    constexpr int I_1 = (D / 64) * (D_IN / 32), I_2 = (D / 64) * (D / 32);
    for (int it = gw; it < I_1 + I_2; it += NGW) {
        if (it < I_1) transpose_item(P.in[I_WIN], D, D_IN, (bf16*)(ws + WS_WIN), scr, it, lane);
        else transpose_item(P.in[I_WOUT], D, D, (bf16*)(ws + WS_WOUT), scr, it - I_1, lane);
    }
    { const float* w_s = P.in[I_WS]; bf16* wsb = (bf16*)(ws + WS_WSB);
      for (int i = gw * 64 + lane; i < 8 * 128 * 128 / 4; i += NGW * 64) { const f32x4 v = *(const f32x4*)(w_s + (size_t)i * 4); u32x2v o; o.x = pk2(v[0], v[1]); o.y = pk2(v[2], v[3]); *(u32x2v*)(wsb + (size_t)i * 4) = o; } }
}


__device__ __forceinline__ const GAS float* x_row(const Params& P, int m) { return (const GAS float*)(m < M_CTX ? P.in[I_XP] + (size_t)m * D : P.in[I_XS] + (size_t)(m - M_CTX) * D); }
__device__ __forceinline__ int mod_index(int m) { return m < M_CTX ? 0 : 1 + (m - M_CTX) / L_LAT; }

__device__ __forceinline__ void prenorm_rows(const Params& P, int m0, int nrows, int lane, const f32x4 (&gs)[4], const f32x4 (&sh)[4]) {
    f32x4 vn[4];
    { const GAS f32x4* xr = (const GAS f32x4*)x_row(P, m0) + lane;
#pragma unroll
      for (int j = 0; j < 4; ++j) vn[j] = xr[64 * j]; }
#pragma unroll 1
    for (int r = 0; r < nrows; ++r) {
        const int m = m0 + r;
        f32x4 v[4];
#pragma unroll
        for (int j = 0; j < 4; ++j) v[j] = vn[j];
        if (r + 1 < nrows) { const GAS f32x4* xr = (const GAS f32x4*)x_row(P, m + 1) + lane;
#pragma unroll
            for (int j = 0; j < 4; ++j) vn[j] = xr[64 * j]; }
        float ss = 0.f;
#pragma unroll
        for (int j = 0; j < 4; ++j) ss += (v[j].x * v[j].x + v[j].y * v[j].y) + (v[j].z * v[j].z + v[j].w * v[j].w);
        const float rstd = 1.0f / sqrtf(wave_sum(ss) * (1.0f / D) + NORM_EPS);
        GAS u32x2v* o8 = (GAS u32x2v*)((GAS bf16*)(P.ws + WS_H) + (size_t)m * D) + lane;
#pragma unroll
        for (int j = 0; j < 4; ++j) { const f32x4 o = v[j] * rstd * gs[j] + sh[j]; u32x2v w; w.x = pg8::cvt_pk_bf16(o.x, o.y); w.y = pg8::cvt_pk_bf16(o.z, o.w); o8[64 * j] = w; }
    }
}
__device__ __forceinline__ void prenorm_mod(const Params& P, int seg, int lane, f32x4 (&gs)[4], f32x4 (&sh)[4]) {
    const GAS float* mod = (const GAS float*)(P.ws + WS_MOD); const GAS float* ln_pre = (const GAS float*)P.in[I_LNPRE];
    const GAS float* shift = mod + seg * 3072; const GAS float* scale = shift + 1024;
#pragma unroll
    for (int j = 0; j < 4; ++j) { const int col = 4 * (lane + 64 * j); gs[j] = *(const GAS f32x4*)(ln_pre + col) * (1.0f + *(const GAS f32x4*)(scale + col)); sh[j] = *(const GAS f32x4*)(shift + col); }
}
__device__ __forceinline__ void phase1(const Params& P, int gw, int NGW, int lane) {
    const GAS float* mod = (const GAS float*)(P.ws + WS_MOD); const GAS float* ln_pre = (const GAS float*)P.in[I_LNPRE]; GAS bf16* H = (GAS bf16*)(P.ws + WS_H);
#pragma unroll 1
    for (int seg = 0; seg < 9; ++seg) {
        const int m_lo = (seg == 0) ? 0 : M_CTX + (seg - 1) * L_LAT, m_hi = (seg == 0) ? M_CTX : m_lo + L_LAT;
        const GAS float* shift = mod + seg * 3072; const GAS float* scale = shift + 1024;
        f32x4 gs[4], sh[4];
#pragma unroll
        for (int j = 0; j < 4; ++j) { const int col = 4 * (lane + 64 * j); gs[j] = *(const GAS f32x4*)(ln_pre + col) * (1.0f + *(const GAS f32x4*)(scale + col)); sh[j] = *(const GAS f32x4*)(shift + col); }
        for (int m = m_lo + gw; m < m_hi; m += NGW) {
            const GAS f32x4* xr = (const GAS f32x4*)x_row(P, m) + lane;
            f32x4 v[4]; float ss = 0.f;
#pragma unroll
            for (int j = 0; j < 4; ++j) { v[j] = xr[64 * j]; ss += (v[j].x * v[j].x + v[j].y * v[j].y) + (v[j].z * v[j].z + v[j].w * v[j].w); }
            const float rstd = 1.0f / sqrtf(wave_sum(ss) * (1.0f / D) + NORM_EPS);
            GAS u32x2v* o8 = (GAS u32x2v*)(H + (size_t)m * D) + lane;
#pragma unroll
            for (int j = 0; j < 4; ++j) { const f32x4 o = v[j] * rstd * gs[j] + sh[j]; u32x2v w; w.x = pk2(o.x, o.y); w.y = pk2(o.z, o.w); o8[64 * j] = w; }
        }
    }
}

constexpr int CH_RKV_LD = 200, CH_TW_LD = 72, CH_I1_LD = 72, CH_I2_LD = 40, CH_G_LD = 40;
constexpr int CH_RKV = 0, CH_TW = 26400, CH_AD = 35616, CH_WUPT = 44832, CH_AUPT = 54048, CH_IMG = 63264, CH_IMG_STRIDE = 30720;
constexpr int CH_GRAM_STRIDE = 17920;
constexpr int CH_HF = 124704, CH_N2 = 141088, CH_EC = 141344, CH_BPART = 141856, CH_KTAB = 142880, CH_HF2 = 143648, CH_END = 160032;
static_assert(2 * CH_GRAM_STRIDE <= CH_WUPT && CH_IMG + 2 * CH_IMG_STRIDE == CH_HF && CH_END <= LDS_BYTES - 64, "chain LDS map");

typedef unsigned short us4 __attribute__((ext_vector_type(4)));
#define MFMA16(a, b, c) __builtin_amdgcn_mfma_f32_16x16x32_bf16((a), (b), (c), 0, 0, 0)
__device__ __forceinline__ bf16x8 ldfrag(const LAS bf16* img, int ld, int row0, int k0, int lane) { return *(const LAS bf16x8*)(img + (row0 + (lane & 15)) * ld + k0 + 8 * (lane >> 4)); }
typedef float f32x2c __attribute__((ext_vector_type(2)));
typedef __bf16 bf16x2c __attribute__((ext_vector_type(2)));
__device__ __forceinline__ unsigned cvtpk(float lo, float hi) { f32x2c v; v.x = lo; v.y = hi; return __builtin_bit_cast(unsigned, __builtin_convertvector(v, bf16x2c)); }
__device__ __forceinline__ void st_nm(LAS bf16* img, int ld, int n0, int m0, f32x4 c, int lane) {
    u32x2v o; o.x = cvtpk(c[0], c[1]); o.y = cvtpk(c[2], c[3]); *(LAS u32x2v*)(img + (n0 + (lane & 15)) * ld + m0 + 4 * (lane >> 4)) = o; }
__device__ __forceinline__ void st_mn(LAS bf16* img, int ld, int m0, int n0, f32x4 c, int lane) {
#pragma unroll
    for (int e = 0; e < 4; e += 2) { const unsigned w = cvtpk(c[e], c[e + 1]); LAS bf16* p = img + (m0 + 4 * (lane >> 4) + e) * ld + n0 + (lane & 15); p[0] = (bf16)(w & 0xffffu); p[ld] = (bf16)(w >> 16); } }
__device__ __forceinline__ float fast_sigmoid(float x) { return __builtin_amdgcn_rcpf(1.0f + __builtin_amdgcn_exp2f(-1.44269504f * x)); }
__device__ __forceinline__ float fast_tanh(float x) { return 1.0f - 2.0f * __builtin_amdgcn_rcpf(1.0f + __builtin_amdgcn_exp2f(2.88539008f * x)); }
__device__ __forceinline__ float row16_sum(float v) { v += dpp_f<0xB1>(v); v += dpp_f<0x4E>(v); v += dpp_f<0x141>(v); v += dpp_f<0x140>(v); return v; }
__device__ __forceinline__ float oct_sum(float v) { v += dpp_f<0xB1>(v); v += dpp_f<0x4E>(v); v += dpp_f<0x141>(v); return v; }

typedef short bf16x4 __attribute__((ext_vector_type(4)));
#define MF16(a, b, c) __builtin_amdgcn_mfma_f32_16x16x16bf16_1k((a), (b), (c), 0, 0, 0)
__device__ __forceinline__ bf16x4 frag4(f32x4 c) { u32x2v o; o.x = cvtpk(c[0], c[1]); o.y = cvtpk(c[2], c[3]); return __builtin_bit_cast(bf16x4, o); }
__device__ __forceinline__ bf16x4 ldfrag4(const LAS bf16* img, int ld, int row0, int k0, int lane) { return *(const LAS bf16x4*)(img + (row0 + (lane & 15)) * ld + k0 + 4 * (lane >> 4)); }
typedef short s16x4c __attribute__((ext_vector_type(4)));
__device__ __forceinline__ bf16x8 ldfrag_tr(const LAS bf16* img, int ld, int col0, int k0, int lane) {
    const LAS bf16* p = img + (k0 + 8 * (lane >> 4) + ((lane & 15) >> 2)) * ld + col0 + 4 * (lane & 3);
    const s16x4c lo = __builtin_amdgcn_ds_read_tr16_b64_v4i16((LAS s16x4c*)p), hi = __builtin_amdgcn_ds_read_tr16_b64_v4i16((LAS s16x4c*)(p + 4 * ld));
    return (bf16x8){lo[0], lo[1], lo[2], lo[3], hi[0], hi[1], hi[2], hi[3]}; }
__device__ __forceinline__ bf16x4 ldfrag4_tr(const LAS bf16* img, int ld, int col0, int k0, int lane) {
    const LAS bf16* p = img + (k0 + 4 * (lane >> 4) + ((lane & 15) >> 2)) * ld + col0 + 4 * (lane & 3);
    return __builtin_bit_cast(bf16x4, __builtin_amdgcn_ds_read_tr16_b64_v4i16((LAS s16x4c*)p)); }
#define OPQ(v) asm volatile("" : "+v"(v))
struct RawRegs { u32x4v v[6]; };
__device__ __forceinline__ void chain_prefetch(RawRegs& R, const GAS bf16* proj, int m0, int L, int h, int dir, int ss, int tid, int p0) {
    OPQ(tid);
    const int qm = tid >> 3, pc = tid & 7, p = p0 + ss * 64 + qm, t = dir ? (L - 1 - p) : p;
    const GAS bf16* row = proj + (size_t)(m0 + t) * D_IN;
#pragma unroll
    for (int x = 0; x < 3; ++x) R.v[x] = *(const GAS u32x4v*)(row + x * 512 + h * 64 + pc * 8);
    R.v[4] = *(const GAS u32x4v*)(row + C_WD + dir * 64 + pc * 8);
    R.v[5] = *(const GAS u32x4v*)(row + C_AD + dir * 64 + pc * 8);
    u32x4v hv = (u32x4v){0u, 0u, 0u, 0u};
    if (tid < 48) { const int hi = tid >= 24, rem = hi ? tid - 24 : tid, x = rem >> 3, pc2 = rem & 7, ph = hi ? p0 + ss * 64 + 64 : p0 + ss * 64 - 1;
        if (ph >= 0 && ph < L) { const int th = dir ? (L - 1 - ph) : ph; hv = *(const GAS u32x4v*)(proj + (size_t)(m0 + th) * D_IN + x * 512 + h * 64 + pc2 * 8); } }
    R.v[3] = hv;
}
__device__ __forceinline__ void chain_stage_raw(const RawRegs& R, LAS unsigned char* lds, int tid) {
    OPQ(tid);
    const int qm = tid >> 3, pc = tid & 7;
#pragma unroll
    for (int x = 0; x < 3; ++x) *(LAS u32x4v*)(lds + CH_RKV + ((qm + 1) * CH_RKV_LD + x * 64 + pc * 8) * 2) = R.v[x];
    if (tid < 48) { const int hi = tid >= 24, rem = hi ? tid - 24 : tid, x = rem >> 3, pc2 = rem & 7;
        *(LAS u32x4v*)(lds + CH_RKV + ((hi ? 65 : 0) * CH_RKV_LD + x * 64 + pc2 * 8) * 2) = R.v[3]; }
    *(LAS u32x4v*)(lds + CH_TW + (qm * CH_TW_LD + pc * 8) * 2) = R.v[4];
    *(LAS u32x4v*)(lds + CH_AD + (qm * CH_TW_LD + pc * 8) * 2) = R.v[5];
}

__device__ __forceinline__ void do_chain(const Params& P, LAS unsigned char* lds, int m0, int L, int h, int dir, const float* s0, float* sfin, int p0, int npt, int mode, int chain) {
    const int tid = threadIdx.x, lane0 = tid & 63, wave = __builtin_amdgcn_readfirstlane(tid >> 6);
    const int grp = wave >> 2, cc = wave & 3;
#define STAGE_LANE() int ln_ = lane0; OPQ(ln_); const int lane = ln_, lr = lane & 15, lg = lane >> 4, c = 16 * cc + lr, vcol = c; (void)lr; (void)lg; (void)c; (void)vcol
    const GAS bf16* proj = (const GAS bf16*)(P.ws + WS_PROJ);
    GAS bf16* YD = (GAS bf16*)P.out; GAS float* BS = (GAS float*)(P.ws + WS_BS);
    const int nss = npt / 64;
    const int cj = h * 64 + 16 * cc + (lane0 & 15);
    const GAS float* ts_mu = (const GAS float*)P.in[I_TSMU];
    const float mlo_r = ts_mu[(dir ? 1536 : 0) + C_R + cj], mhi_r = ts_mu[(dir ? 0 : 1536) + C_R + cj];
    const float mlo_k = ts_mu[(dir ? 1536 : 0) + C_K + cj], mhi_k = ts_mu[(dir ? 0 : 1536) + C_K + cj];
    const float mlo_v = ts_mu[(dir ? 1536 : 0) + C_V + cj], mhi_v = ts_mu[(dir ? 0 : 1536) + C_V + cj];
    const float mc_r = 1.0f - mlo_r - mhi_r, mc_k = 1.0f - mlo_k - mhi_k, mc_v = 1.0f - mlo_v - mhi_v;
    const float w0c = -1.44269504f * ((const GAS float*)P.in[I_W0])[dir * 512 + cj], a0c = -1.44269504f * ((const GAS float*)P.in[I_A0])[dir * 512 + cj];
    const float kkc = ((const GAS float*)P.in[I_KK])[dir * 512 + cj], kac = ((const GAS float*)P.in[I_KA])[dir * 512 + cj], rkc = ((const GAS float*)P.in[I_RK])[dir * 512 + cj], kac1 = 1.0f - kac;
    LAS float* ktab = (LAS float*)(lds + CH_KTAB);
    if (tid < 64) { const int c8 = h * 64 + tid; ktab[tid] = ((const GAS float*)P.in[I_KK])[dir * 512 + c8]; ktab[64 + tid] = ts_mu[(dir ? 1536 : 0) + C_K + c8]; ktab[128 + tid] = ts_mu[(dir ? 0 : 1536) + C_K + c8]; }
    { LAS bf16* wupt = (LAS bf16*)(lds + CH_WUPT); LAS bf16* aupt = (LAS bf16*)(lds + CH_AUPT);
      const GAS float* wu = (const GAS float*)P.in[I_WUP] + (size_t)dir * 64 * 512 + h * 64; const GAS float* au = (const GAS float*)P.in[I_AUP] + (size_t)dir * 64 * 512 + h * 64;
#pragma unroll 1
      for (int kb = 0; kb < 2; ++kb) { float wv[4], av[4];
#pragma unroll
          for (int k = 0; k < 4; ++k) { const int idx = tid + 512 * (4 * kb + k), i = idx >> 6, c2 = idx & 63; wv[k] = wu[(size_t)i * 512 + c2]; av[k] = au[(size_t)i * 512 + c2]; }
#pragma unroll
          for (int k = 0; k < 4; ++k) { const int idx = tid + 512 * (4 * kb + k), i = idx >> 6, c2 = idx & 63; wupt[c2 * CH_TW_LD + i] = (bf16)f2bf(wv[k]); aupt[c2 * CH_TW_LD + i] = (bf16)f2bf(av[k]); } } }
    if (grp == 0) { STAGE_LANE(); LAS f32x4* hf = (LAS f32x4*)(lds + CH_HF) + cc * 256 + lane;
#pragma unroll
        for (int mt = 0; mt < 4; ++mt) hf[64 * mt] = s0 ? *(const f32x4*)(s0 + vcol * 64 + 16 * mt + 4 * lg) : (f32x4){0.f, 0.f, 0.f, 0.f};
        if (mode == 2) { LAS f32x4* hf2 = (LAS f32x4*)(lds + CH_HF2) + cc * 256 + lane;
#pragma unroll
            for (int mt = 0; mt < 4; ++mt) { f32x4 id;
#pragma unroll
                for (int e = 0; e < 4; ++e) id[e] = (mt == cc && lr == 4 * lg + e) ? 1.f : 0.f;
                hf2[64 * mt] = id; } }
    }
    RawRegs RR;
    chain_prefetch(RR, proj, m0, L, h, dir, 0, tid, p0);
    chain_stage_raw(RR, lds, tid);
    __syncthreads();
    LAS unsigned char* img = lds + CH_IMG + grp * CH_IMG_STRIDE;
    LAS bf16* I2_A = (LAS bf16*)(img), *I2_B = (LAS bf16*)(img + 5120), *I2_K = (LAS bf16*)(img + 10240), *I2_V = (LAS bf16*)(img + 15360), *I2_R = (LAS bf16*)(img + 20480), *I2_Q = (LAS bf16*)(img + 25600);
    LAS unsigned char* gram = lds + grp * CH_GRAM_STRIDE;
    LAS bf16* GX = (LAS bf16*)(gram), *GXT = (LAS bf16*)(gram + 2560), *GYT = (LAS bf16*)(gram + 5120), *GT = (LAS bf16*)(gram + 7680);
    LAS bf16* GLAK = (LAS bf16*)(gram + 10240), *GMRB = (LAS bf16*)(gram + 12800), *GMRK = (LAS bf16*)(gram + 15360);
    LAS float* n2s = (LAS float*)(lds + CH_N2); LAS float* ecs = (LAS float*)(lds + CH_EC); LAS float* bpart = (LAS float*)(lds + CH_BPART);
    const LAS bf16* rkv = (const LAS bf16*)(lds + CH_RKV);
    const f32x4 z4 = (f32x4){0.f, 0.f, 0.f, 0.f};

    for (int ss = 0; ss < nss; ++ss) {
        { STAGE_LANE(); const int tk = lane >> 3, cg = lane & 7, q = 8 * wave + tk + 1;
          const LAS bf16* kp = rkv + q * CH_RKV_LD + 64 + 8 * cg;
          const u32x4v lo = *(const LAS u32x4v*)(kp - CH_RKV_LD), mi = *(const LAS u32x4v*)kp, hi = *(const LAS u32x4v*)(kp + CH_RKV_LD);
          float s = 0.f;
#pragma unroll
          for (int hh2 = 0; hh2 < 2; ++hh2) { const f32x4 ckk = *(const LAS f32x4*)(ktab + 8 * cg + 4 * hh2), clo = *(const LAS f32x4*)(ktab + 64 + 8 * cg + 4 * hh2), chi = *(const LAS f32x4*)(ktab + 128 + 8 * cg + 4 * hh2);
#pragma unroll
              for (int e2 = 0; e2 < 4; ++e2) { const int e = 4 * hh2 + e2; const unsigned sh = (e & 1) ? 16u : 0u; const float kl = bf2f((lo[e >> 1] >> sh) & 0xffffu), kc = bf2f((mi[e >> 1] >> sh) & 0xffffu), kh = bf2f((hi[e >> 1] >> sh) & 0xffffu);
                  const float k = (kc + clo[e2] * (kl - kc) + chi[e2] * (kh - kc)) * ckk[e2]; s += k * k; } }
          s = oct_sum(s);
          if (cg == 0) n2s[8 * wave + tk] = __builtin_amdgcn_rsqf(s + 1e-12f); }
        f32x4 wl[2], al[2];
        { STAGE_LANE(); const LAS bf16* tw = (const LAS bf16*)(lds + CH_TW); const LAS bf16* ad = (const LAS bf16*)(lds + CH_AD);
          const LAS bf16* wupt = (const LAS bf16*)(lds + CH_WUPT); const LAS bf16* aupt = (const LAS bf16*)(lds + CH_AUPT);
#pragma unroll
          for (int tt = 0; tt < 2; ++tt) { wl[tt] = z4; al[tt] = z4;
#pragma unroll
              for (int ks = 0; ks < 2; ++ks) {
                  wl[tt] = MFMA16(ldfrag(tw, CH_TW_LD, 32 * grp + 16 * tt, 32 * ks, lane), ldfrag(wupt, CH_TW_LD, 16 * cc, 32 * ks, lane), wl[tt]);
                  al[tt] = MFMA16(ldfrag(ad, CH_TW_LD, 32 * grp + 16 * tt, 32 * ks, lane), ldfrag(aupt, CH_TW_LD, 16 * cc, 32 * ks, lane), al[tt]); } } }
        __syncthreads();
        { STAGE_LANE(); float lw[2][4];
#pragma unroll
          for (int tt = 0; tt < 2; ++tt)
#pragma unroll
              for (int e = 0; e < 4; ++e) lw[tt][e] = -0.87506130f * __builtin_amdgcn_rcpf(1.0f + __builtin_amdgcn_exp2f(__builtin_fmaf(wl[tt][e], -1.44269504f, w0c)));
          float gin[2][4], run[2];
#pragma unroll
          for (int tt = 0; tt < 2; ++tt) { gin[tt][0] = lw[tt][0]; gin[tt][1] = gin[tt][0] + lw[tt][1]; gin[tt][2] = gin[tt][1] + lw[tt][2]; gin[tt][3] = gin[tt][2] + lw[tt][3]; run[tt] = gin[tt][3]; }
          float off[2], tot0;
          { float r1 = run[0]; float t1 = __shfl_up(r1, 16); if (lg >= 1) r1 += t1; float t2 = __shfl_up(r1, 32); if (lg >= 2) r1 += t2; off[0] = r1 - run[0]; tot0 = __shfl(r1, 48 + lr); }
          { float r1 = run[1]; float t1 = __shfl_up(r1, 16); if (lg >= 1) r1 += t1; float t2 = __shfl_up(r1, 32); if (lg >= 2) r1 += t2; off[1] = r1 - run[1] + tot0;
            const float tot = __shfl(r1, 48 + lr) + tot0; if (lg == 0) ecs[grp * 64 + c] = __builtin_amdgcn_exp2f(tot); }
#pragma unroll
          for (int tt = 0; tt < 2; ++tt) {
              const int q0 = 32 * grp + 16 * tt + 4 * lg;
              float xr[6], xk[6], xv[6];
              { const LAS bf16* tp = rkv + (q0 + (lr >> 2)) * CH_RKV_LD + 16 * cc + 4 * (lr & 3);
#pragma unroll
                for (int x = 0; x < 3; ++x) { const s16x4c lo = __builtin_amdgcn_ds_read_tr16_b64_v4i16((LAS s16x4c*)(tp + 64 * x)), hi = __builtin_amdgcn_ds_read_tr16_b64_v4i16((LAS s16x4c*)(tp + 64 * x + 4 * CH_RKV_LD));
                    float* dst = (x == 0) ? xr : (x == 1) ? xk : xv;
#pragma unroll
                    for (int e = 0; e < 4; ++e) dst[e] = bf2f((unsigned)(unsigned short)lo[e]);
                    dst[4] = bf2f((unsigned)(unsigned short)hi[0]); dst[5] = bf2f((unsigned)(unsigned short)hi[1]); } }
              const f32x4 n2 = *(const LAS f32x4*)(n2s + 32 * grp + 16 * tt + 4 * lg);
              f32x4 fa, fb, fk, fr, fv; float exprev = 1.f;
#pragma unroll
              for (int e = 0; e < 4; ++e) {
                  const float r = mc_r * xr[e + 1] + mlo_r * xr[e] + mhi_r * xr[e + 2];
                  const float k = mc_k * xk[e + 1] + mlo_k * xk[e] + mhi_k * xk[e + 2];
                  const float v = mc_v * xv[e + 1] + mlo_v * xv[e] + mhi_v * xv[e + 2];
                  const float a = __builtin_amdgcn_rcpf(1.0f + __builtin_amdgcn_exp2f(__builtin_fmaf(al[tt][e], -1.44269504f, a0c)));
                  const float kk = k * kkc * n2[e];
                  const float kdv = k * __builtin_fmaf(a, kac, kac1);
                  const float g = gin[tt][e] + off[tt];
                  const float ex = __builtin_amdgcn_exp2f(g), ie = __builtin_amdgcn_exp2f(-g), ep = (e == 0) ? __builtin_amdgcn_exp2f(g - lw[tt][e]) : exprev; exprev = ex;
                  fa[e] = -kk * ep; fb[e] = kk * a * ie; fk[e] = kdv * ie; fr[e] = r * ex; fv[e] = v; }
              const f32x4 fq = fr * rkc;
              const int t0 = 16 * tt + 4 * lg;
              u32x2v oa, ob, ok, orr, ov, oq; oq.x = cvtpk(fq[0], fq[1]); oq.y = cvtpk(fq[2], fq[3]);
              oa.x = cvtpk(fa[0], fa[1]); oa.y = cvtpk(fa[2], fa[3]); ob.x = cvtpk(fb[0], fb[1]); ob.y = cvtpk(fb[2], fb[3]); ok.x = cvtpk(fk[0], fk[1]); ok.y = cvtpk(fk[2], fk[3]);
              orr.x = cvtpk(fr[0], fr[1]); orr.y = cvtpk(fr[2], fr[3]); ov.x = cvtpk(fv[0], fv[1]); ov.y = cvtpk(fv[2], fv[3]);
              *(LAS u32x2v*)(I2_A + c * CH_I2_LD + t0) = oa; *(LAS u32x2v*)(I2_B + c * CH_I2_LD + t0) = ob; *(LAS u32x2v*)(I2_K + c * CH_I2_LD + t0) = ok; *(LAS u32x2v*)(I2_V + c * CH_I2_LD + t0) = ov; *(LAS u32x2v*)(I2_R + c * CH_I2_LD + t0) = orr; *(LAS u32x2v*)(I2_Q + c * CH_I2_LD + t0) = oq;
          } }
        __syncthreads();
        f32x4 kv[4];
        { STAGE_LANE();
          if (cc != 0) { const bf16x8 vb = ldfrag(I2_V, CH_I2_LD, 16 * cc, 0, lane);
#pragma unroll
            for (int mt = 0; mt < 4; ++mt) kv[mt] = MFMA16(ldfrag(I2_K, CH_I2_LD, 16 * mt, 0, lane), vb, z4); }
          if (cc != 0) {
              const LAS bf16* GA = (cc < 2) ? I2_A : I2_R; const LAS bf16* GB = (cc & 1) ? I2_K : I2_B;
              f32x4 g00 = z4, g10 = z4, g11 = z4;
              bf16x8 fa[2][2], fb[2][2];
#pragma unroll
              for (int ks = 0; ks < 2; ++ks) { fa[ks][0] = ldfrag_tr(GA, CH_I2_LD, 0, 32 * ks, lane); fa[ks][1] = ldfrag_tr(GA, CH_I2_LD, 16, 32 * ks, lane); fb[ks][0] = ldfrag_tr(GB, CH_I2_LD, 0, 32 * ks, lane); fb[ks][1] = ldfrag_tr(GB, CH_I2_LD, 16, 32 * ks, lane); }
#pragma unroll
              for (int ks = 0; ks < 2; ++ks) { g00 = MFMA16(fa[ks][0], fb[ks][0], g00); g10 = MFMA16(fa[ks][1], fb[ks][0], g10); g11 = MFMA16(fa[ks][1], fb[ks][1], g11); }
              const bool strict = cc < 2;
#pragma unroll
              for (int e = 0; e < 4; ++e) { const int m = 4 * lg + e; const bool keep = strict ? (lr < m) : (lr <= m); g00[e] = keep ? g00[e] : 0.f; g11[e] = keep ? g11[e] : 0.f; }
              if (cc == 3) {
                  f32x4 d0 = z4, d1 = z4;
#pragma unroll
                  for (int ks = 0; ks < 2; ++ks) { d0 = MFMA16(ldfrag_tr(I2_Q, CH_I2_LD, 0, 32 * ks, lane), ldfrag_tr(I2_K, CH_I2_LD, 0, 32 * ks, lane), d0);
                      d1 = MFMA16(ldfrag_tr(I2_Q, CH_I2_LD, 16, 32 * ks, lane), ldfrag_tr(I2_K, CH_I2_LD, 16, 32 * ks, lane), d1); }
                  if ((lr >> 2) == lg) { const int e = lr & 3; const float b0 = (e == 0) ? d0[0] : (e == 1) ? d0[1] : (e == 2) ? d0[2] : d0[3], b1 = (e == 0) ? d1[0] : (e == 1) ? d1[1] : (e == 2) ? d1[2] : d1[3];
                      const int p = p0 + ss * 64 + 32 * grp + lr, t = dir ? (L - 1 - p) : p, t2 = dir ? (t - 16) : (t + 16);
                      BS[((size_t)dir * MT + m0 + t) * 8 + h] = b0; BS[((size_t)dir * MT + m0 + t2) * 8 + h] = b1; }
              }
              LAS bf16* dst = (cc == 1) ? GLAK : (cc == 2) ? GMRB : GMRK;
              st_mn(dst, CH_G_LD, 0, 0, g00, lane); st_mn(dst, CH_G_LD, 16, 0, g10, lane); st_mn(dst, CH_G_LD, 16, 16, g11, lane); st_mn(dst, CH_G_LD, 0, 16, z4, lane);
          } else {
              f32x4 x00 = z4, x11 = z4, t00 = z4, t01 = z4, t11 = z4;
              { bf16x8 fa[2][2], fb[2][2];
#pragma unroll
                for (int ks = 0; ks < 2; ++ks) { fa[ks][0] = ldfrag_tr(I2_A, CH_I2_LD, 0, 32 * ks, lane); fa[ks][1] = ldfrag_tr(I2_A, CH_I2_LD, 16, 32 * ks, lane); fb[ks][0] = ldfrag_tr(I2_B, CH_I2_LD, 0, 32 * ks, lane); fb[ks][1] = ldfrag_tr(I2_B, CH_I2_LD, 16, 32 * ks, lane); }
#pragma unroll
                for (int ks = 0; ks < 2; ++ks) { x00 = MFMA16(fa[ks][0], fb[ks][0], x00); x11 = MFMA16(fa[ks][1], fb[ks][1], x11);
                    t00 = MFMA16(fb[ks][0], fa[ks][0], t00); t01 = MFMA16(fb[ks][0], fa[ks][1], t01); t11 = MFMA16(fb[ks][1], fa[ks][1], t11); } }
              f32x4 y00, y10, y11, yt11;
#pragma unroll
              for (int e = 0; e < 4; ++e) { const int m = 4 * lg + e; x00[e] = (lr < m) ? x00[e] : 0.f; x11[e] = (lr < m) ? x11[e] : 0.f; t00[e] = (m < lr) ? t00[e] : 0.f; t11[e] = (m < lr) ? t11[e] : 0.f; y00[e] = (lr == m) ? 1.f : 0.f; }
              y11 = y00; yt11 = y00;
#pragma unroll 1
              for (int lev = 0; lev < 4; ++lev) {
                  const bf16x4 fx00 = frag4(x00), fx11 = frag4(x11), ft00 = frag4(t00), ft11 = frag4(t11), fy00 = frag4(y00), fy11 = frag4(y11);
                  y00 = MF16(ft00, fy00, y00); y11 = MF16(ft11, fy11, y11); yt11 = MF16(fy11, ft11, yt11);
                  if (lev < 3) { const f32x4 n00 = MF16(ft00, fx00, z4), n11 = MF16(ft11, fx11, z4), m00 = MF16(fx00, ft00, z4), m11 = MF16(fx11, ft11, z4);
                      x00 = n00; x11 = n11; t00 = m00; t11 = m11; }
              }
              { const f32x4 zz = MF16(frag4(t01), frag4(y00), z4);
                y10 = MF16(frag4(yt11), frag4(zz), z4); }
              st_mn(GT, CH_G_LD, 0, 0, y00, lane); st_mn(GT, CH_G_LD, 16, 0, y10, lane); st_mn(GT, CH_G_LD, 16, 16, y11, lane); st_mn(GT, CH_G_LD, 0, 16, z4, lane);
              { const bf16x8 vb = ldfrag(I2_V, CH_I2_LD, 16 * cc, 0, lane);
#pragma unroll
                for (int mt = 0; mt < 4; ++mt) kv[mt] = MFMA16(ldfrag(I2_K, CH_I2_LD, 16 * mt, 0, lane), vb, z4); }
          } }
        if (ss + 1 < nss) chain_prefetch(RR, proj, m0, L, h, dir, ss + 1, tid, p0);
        __syncthreads();
        f32x4 y0[2], u0[2]; bf16x4 apf[2][4];
        { STAGE_LANE(); const bf16x8 vb = ldfrag(I2_V, CH_I2_LD, 16 * cc, 0, lane);
          const f32x4 w0 = MFMA16(ldfrag(GLAK, CH_G_LD, 0, 0, lane), vb, z4), w1 = MFMA16(ldfrag(GLAK, CH_G_LD, 16, 0, lane), vb, z4);
          y0[0] = MFMA16(ldfrag(GMRK, CH_G_LD, 0, 0, lane), vb, z4); y0[1] = MFMA16(ldfrag(GMRK, CH_G_LD, 16, 0, lane), vb, z4);
          { const bf16x8 ta0 = ldfrag(GT, CH_G_LD, 0, 0, lane), ta1 = ldfrag(GT, CH_G_LD, 16, 0, lane);
#pragma unroll
            for (int mt = 0; mt < 4; ++mt) { const bf16x8 at = ldfrag(I2_A, CH_I2_LD, 16 * mt, 0, lane); apf[0][mt] = frag4(MFMA16(at, ta0, z4)); apf[1][mt] = frag4(MFMA16(at, ta1, z4)); } }
          const bf16x4 fw0 = frag4(w0), fw1 = frag4(w1);
          u0[0] = MF16(ldfrag4(GT, CH_G_LD, 0, 0, lane), fw0, z4);
          u0[1] = MF16(ldfrag4(GT, CH_G_LD, 16, 16, lane), fw1, MF16(ldfrag4(GT, CH_G_LD, 16, 0, lane), fw0, z4)); }
        { STAGE_LANE(); LAS f32x4* hf = (LAS f32x4*)(lds + CH_HF) + cc * 256 + lane;
          bf16x4 rf[2][4], bfr[4][2], mbf[3]; f32x4 ecv[4];
#pragma unroll
          for (int mt = 0; mt < 4; ++mt) {
              bfr[mt][0] = ldfrag4(I2_B, CH_I2_LD, 16 * mt, 0, lane); bfr[mt][1] = ldfrag4(I2_B, CH_I2_LD, 16 * mt, 16, lane); ecv[mt] = *(const LAS f32x4*)(ecs + grp * 64 + 16 * mt + 4 * lg); }
#define LOAD_PART_B() do { _Pragma("unroll") for (int mt = 0; mt < 4; ++mt) { rf[0][mt] = ldfrag4_tr(I2_R, CH_I2_LD, 0, 16 * mt, lane); rf[1][mt] = ldfrag4_tr(I2_R, CH_I2_LD, 16, 16 * mt, lane); } \
          mbf[0] = ldfrag4(GMRB, CH_G_LD, 0, 0, lane); mbf[1] = ldfrag4(GMRB, CH_G_LD, 16, 0, lane); mbf[2] = ldfrag4(GMRB, CH_G_LD, 16, 16, lane); } while (0)
          if (grp == 1) LOAD_PART_B();
          bf16x4 fH[4], fU0, fU1, fHP[4], fUP0, fUP1;
#pragma unroll
          for (int mt = 0; mt < 4; ++mt) fHP[mt] = (bf16x4){0, 0, 0, 0};
          fUP0 = fUP1 = (bf16x4){0, 0, 0, 0};
#pragma unroll 1
          for (int sg = 0; sg < 2; ++sg) {
              if (grp == sg) {
                  f32x4 hh[4];
#pragma unroll
                  for (int mt = 0; mt < 4; ++mt) { hh[mt] = hf[64 * mt]; fH[mt] = frag4(hh[mt]); }
                  f32x4 uu0 = u0[0], uu1 = u0[1];
#pragma unroll
                  for (int mt = 0; mt < 4; ++mt) { uu0 = MF16(apf[0][mt], fH[mt], uu0); uu1 = MF16(apf[1][mt], fH[mt], uu1); }
                  fU0 = frag4(uu0); fU1 = frag4(uu1);
#pragma unroll
                  for (int mt = 0; mt < 4; ++mt) { f32x4 acc = hh[mt] + kv[mt]; acc = MF16(bfr[mt][0], fU0, acc); acc = MF16(bfr[mt][1], fU1, acc); hf[64 * mt] = acc * ecv[mt]; }
                  if (mode == 2) {
                      LAS f32x4* hf2 = (LAS f32x4*)(lds + CH_HF2) + cc * 256 + lane; f32x4 hp[4];
#pragma unroll
                      for (int mt = 0; mt < 4; ++mt) { hp[mt] = hf2[64 * mt]; fHP[mt] = frag4(hp[mt]); }
                      f32x4 up0 = z4, up1 = z4;
#pragma unroll
                      for (int mt = 0; mt < 4; ++mt) { up0 = MF16(apf[0][mt], fHP[mt], up0); up1 = MF16(apf[1][mt], fHP[mt], up1); }
                      fUP0 = frag4(up0); fUP1 = frag4(up1);
#pragma unroll
                      for (int mt = 0; mt < 4; ++mt) { f32x4 acc = MF16(bfr[mt][0], fUP0, hp[mt]); acc = MF16(bfr[mt][1], fUP1, acc); hf2[64 * mt] = acc * ecv[mt]; }
                  }
              }
              __syncthreads();
              if (grp == sg) {
                  if (sg == 0) LOAD_PART_B();
                  f32x4 yy0 = y0[0], yy1 = y0[1];
#pragma unroll
                  for (int mt = 0; mt < 4; ++mt) { yy0 = MF16(rf[0][mt], fH[mt], yy0); yy1 = MF16(rf[1][mt], fH[mt], yy1); }
                  yy0 = MF16(mbf[0], fU0, yy0); yy1 = MF16(mbf[2], fU1, MF16(mbf[1], fU0, yy1));
#pragma unroll
                  for (int e = 0; e < 4; ++e) { const int p = p0 + ss * 64 + 32 * sg + 4 * lg + e, t = dir ? (L - 1 - p) : p, t2 = dir ? (t - 16) : (t + 16);
                      YD[((size_t)dir * MT + m0 + t) * 512 + h * 64 + vcol] = (bf16)f2bf(yy0[e]); YD[((size_t)dir * MT + m0 + t2) * 512 + h * 64 + vcol] = (bf16)f2bf(yy1[e]); }
                  if (mode == 2) {
                      f32x4 g0 = z4, g1 = z4;
#pragma unroll
                      for (int mt = 0; mt < 4; ++mt) { g0 = MF16(rf[0][mt], fHP[mt], g0); g1 = MF16(rf[1][mt], fHP[mt], g1); }
                      g0 = MF16(mbf[0], fUP0, g0); g1 = MF16(mbf[2], fUP1, MF16(mbf[1], fUP0, g1));
                      GAS bf16* G = (GAS bf16*)(P.ws + WS_G) + ((size_t)chain * 2048 + (ss * 64 + 32 * sg + 4 * lg)) * 64 + vcol;
#pragma unroll
                      for (int e = 0; e < 4; e += 2) { const unsigned w0 = cvtpk(g0[e], g0[e + 1]), w1 = cvtpk(g1[e], g1[e + 1]);
                          G[(size_t)e * 64] = (bf16)(w0 & 0xffffu); G[(size_t)(e + 1) * 64] = (bf16)(w0 >> 16); G[(size_t)(e + 16) * 64] = (bf16)(w1 & 0xffffu); G[(size_t)(e + 17) * 64] = (bf16)(w1 >> 16); }
                  }
              }
          }
#undef LOAD_PART_B
        }
        if (ss + 1 < nss) { chain_stage_raw(RR, lds, tid); __syncthreads(); }
    }
    if (grp == 1 && (sfin || mode == 1)) { STAGE_LANE(); const LAS f32x4* hf = (const LAS f32x4*)(lds + CH_HF) + cc * 256 + lane;
        if (mode == 1) { GAS bf16* hm = (GAS bf16*)(P.ws + WS_HMID) + (size_t)chain * 4096 + vcol * 64;
#pragma unroll
            for (int mt = 0; mt < 4; ++mt) { const f32x4 hv = hf[64 * mt]; u32x2v o; o.x = cvtpk(hv[0], hv[1]); o.y = cvtpk(hv[2], hv[3]); *(GAS u32x2v*)(hm + 16 * mt + 4 * lg) = o; } }
        else {
#pragma unroll
            for (int mt = 0; mt < 4; ++mt) *(f32x4*)(sfin + vcol * 64 + 16 * mt + 4 * lg) = hf[64 * mt]; }
    }
    __syncthreads();
#undef STAGE_LANE
}
constexpr int VN_LD = 520;
constexpr int GM_STG = 128 * VN_LD * 2;
static_assert(GM_STG + 8 * 2048 <= LDS_BYTES - 64, "gMLP LDS map");
typedef short s16x4 __attribute__((ext_vector_type(4)));
__device__ __forceinline__ s16x4 tr16(const LAS bf16* p) { return __builtin_amdgcn_ds_read_tr16_b64_v4i16((LAS s16x4*)p); }
__device__ __forceinline__ void do_gmlp(const Params& P, LAS unsigned char* lds, int unit) {
    const int tid = threadIdx.x, lane = tid & 63, wave = __builtin_amdgcn_readfirstlane(tid >> 6);
    const GAS bf16* proj = (const GAS bf16*)(P.ws + WS_PROJ); GAS bf16* MIX = (GAS bf16*)(P.ws + WS_H); const GAS bf16* wsb = (const GAS bf16*)(P.ws + WS_WSB);
    LAS bf16* vn = (LAS bf16*)lds;
    const int row0 = unit * 128;
    { const GAS float* g = (const GAS float*)P.in[I_SLG]; const GAS float* b = (const GAS float*)P.in[I_SLB];
      float gg[8], bb[8];
#pragma unroll
      for (int e = 0; e < 8; ++e) { gg[e] = g[lane * 8 + e]; bb[e] = b[lane * 8 + e]; }
      u32x4v rawv[16];
#pragma unroll
      for (int i = 0; i < 16; ++i) rawv[i] = *(const GAS u32x4v*)(proj + (size_t)(row0 + wave * 16 + i) * D_IN + C_VB + lane * 8);
#pragma unroll
      for (int i = 0; i < 16; ++i) { const int tok = wave * 16 + i; const u32x4v raw = rawv[i];
        float x[8]; x[0] = bf2f(raw.x & 0xffffu); x[1] = bf2f(raw.x >> 16); x[2] = bf2f(raw.y & 0xffffu); x[3] = bf2f(raw.y >> 16); x[4] = bf2f(raw.z & 0xffffu); x[5] = bf2f(raw.z >> 16); x[6] = bf2f(raw.w & 0xffffu); x[7] = bf2f(raw.w >> 16);
        float s = 0.f;
#pragma unroll
        for (int e = 0; e < 8; ++e) s += x[e];
        const float mean = wave_sum(s) * (1.0f / 512.0f); float q = 0.f;
#pragma unroll
        for (int e = 0; e < 8; ++e) { x[e] -= mean; q += x[e] * x[e]; }
        const float rstd = 1.0f / sqrtf(wave_sum(q) * (1.0f / 512.0f) + NORM_EPS);
        u32x4v o;
#pragma unroll
        for (int e = 0; e < 4; ++e) o[e] = cvtpk(x[2 * e] * rstd * gg[2 * e] + bb[2 * e], x[2 * e + 1] * rstd * gg[2 * e + 1] + bb[2 * e + 1]);
        *(LAS u32x4v*)(vn + tok * VN_LD + lane * 8) = o; } }
    __syncthreads();
    const int g = wave, fr = lane & 15, fq = lane >> 4;
    const GAS float* b_s = (const GAS float*)P.in[I_BSS];
    LAS bf16* stg = (LAS bf16*)(lds + GM_STG + wave * 2048);
    const LAS bf16* trbase = vn + (8 * fq + (fr >> 2)) * VN_LD + g * 64 + 4 * (fr & 3);
    const int pr_ = lane >> 2, cq = lane & 3, ch = g * 64 + 16 * cq;
    constexpr int GM_D = 3;
    bf16x8 bfr[4][4];
#pragma unroll
    for (int ks = 0; ks < 4; ++ks)
#pragma unroll
        for (int c = 0; c < 4; ++c) { const s16x4 lo = tr16(trbase + (32 * ks) * VN_LD + 16 * c), hi = tr16(trbase + (32 * ks + 4) * VN_LD + 16 * c);
            bfr[ks][c] = (bf16x8){lo[0], lo[1], lo[2], lo[3], hi[0], hi[1], hi[2], hi[3]}; }
    bf16x8 afr[GM_D][4]; u32x4v uu[GM_D][2], zz[GM_D][2]; float bsv[GM_D];
#define GM_LOAD_TILE(t_, sl_) do { const int p_ = (t_) * 16 + pr_; const GAS bf16* pr = proj + (size_t)(row0 + p_) * D_IN; \
        _Pragma("unroll") for (int ks = 0; ks < 4; ++ks) afr[sl_][ks] = *(const GAS bf16x8*)(wsb + (size_t)(g * 128 + (t_) * 16 + fr) * 128 + ks * 32 + 8 * fq); \
        uu[sl_][0] = *(const GAS u32x4v*)(pr + C_U + ch); uu[sl_][1] = *(const GAS u32x4v*)(pr + C_U + ch + 8); zz[sl_][0] = *(const GAS u32x4v*)(pr + C_ZB + ch); zz[sl_][1] = *(const GAS u32x4v*)(pr + C_ZB + ch + 8); \
        bsv[sl_] = b_s[g * 128 + p_]; } while (0)
#pragma unroll
    for (int t = 0; t < GM_D; ++t) GM_LOAD_TILE(t, t);
#pragma unroll
    for (int t = 0; t < 8; ++t) {
        constexpr int dummy = 0; (void)dummy;
        const int sl = t % GM_D;
        f32x4 acc[4];
#pragma unroll
        for (int c = 0; c < 4; ++c) acc[c] = (f32x4){0.f, 0.f, 0.f, 0.f};
#pragma unroll
        for (int ks = 0; ks < 4; ++ks)
#pragma unroll
            for (int c = 0; c < 4; ++c) acc[c] = __builtin_amdgcn_mfma_f32_16x16x32_bf16(afr[sl][ks], bfr[ks][c], acc[c], 0, 0, 0);
#pragma unroll
        for (int c = 0; c < 4; ++c)
#pragma unroll
            for (int e = 0; e < 4; e += 2) { const unsigned w = cvtpk(acc[c][e], acc[c][e + 1]); LAS bf16* sp = stg + (4 * fq + e) * 64 + 16 * c + fr; sp[0] = (bf16)(w & 0xffffu); sp[64] = (bf16)(w >> 16); }
        const u32x4v u0 = uu[sl][0], u1 = uu[sl][1], z0 = zz[sl][0], z1 = zz[sl][1]; const float bs1 = bsv[sl];
        const u32x4v s0 = *(const LAS u32x4v*)(stg + pr_ * 64 + 16 * cq), s1 = *(const LAS u32x4v*)(stg + pr_ * 64 + 16 * cq + 8);
        u32x4v o0, o1;
#pragma unroll
        for (int e = 0; e < 4; ++e) {
            o0[e] = cvtpk(bf2f(u0[e] & 0xffffu) * (bf2f(s0[e] & 0xffffu) + bs1) * silu_f(bf2f(z0[e] & 0xffffu)), bf2f(u0[e] >> 16) * (bf2f(s0[e] >> 16) + bs1) * silu_f(bf2f(z0[e] >> 16)));
            o1[e] = cvtpk(bf2f(u1[e] & 0xffffu) * (bf2f(s1[e] & 0xffffu) + bs1) * silu_f(bf2f(z1[e] & 0xffffu)), bf2f(u1[e] >> 16) * (bf2f(s1[e] >> 16) + bs1) * silu_f(bf2f(z1[e] >> 16))); }
        asm volatile("" ::: "memory");
        if (t + GM_D < 8) GM_LOAD_TILE(t + GM_D, sl);
        asm volatile("" ::: "memory");
        GAS bf16* op = MIX + (size_t)(row0 + t * 16 + pr_) * D + 512 + ch;
        *(GAS u32x4v*)op = o0; *(GAS u32x4v*)(op + 8) = o1;
    }
#undef GM_LOAD_TILE
    __syncthreads();
}

#define XB_TMO      128
#define XB_XCNT(j)  (256  + 64 * (j))
#define XB_XSUB(j)  (1280 + 64 * (j))
#define XB_XGEN(j)  (2304 + 64 * (j))
#define XB_TOP      3328
#define XB_TOPGEN   3392
#define XCD_BAR_WORDS 3456
#define XB_SPIN_CAP (1u << 18)

__device__ __forceinline__ unsigned xb_ld(unsigned* p)              { return __hip_atomic_load(p, __ATOMIC_RELAXED, __HIP_MEMORY_SCOPE_AGENT); }
__device__ __forceinline__ unsigned xb_add(unsigned* p, unsigned v) { return __hip_atomic_fetch_add(p, v, __ATOMIC_RELAXED, __HIP_MEMORY_SCOPE_AGENT); }
__device__ __forceinline__ unsigned xb_xcc_id() { return (unsigned)__builtin_amdgcn_s_getreg((3 << 11) | 20) & 0xFu; }
#define XB_SPIN(cond, bar) do { unsigned _sp = 0; while (cond) { __builtin_amdgcn_s_sleep(1); \
    if ((++_sp & 255u) == 0u) { if (xb_ld(&(bar)[XB_TMO])) break; if (_sp > XB_SPIN_CAP) { atomicAdd(&(bar)[XB_TMO], 1u); break; } } } } while (0)

struct XcdBarrier {
    unsigned* bar; unsigned x;
    volatile LAS unsigned* st;
};

__device__ __forceinline__ XcdBarrier xcd_barrier_post(unsigned* bar, volatile LAS unsigned* st) {
    XcdBarrier b; b.bar = bar; b.x = xb_xcc_id(); b.st = st;
    if (threadIdx.x == 0) (void)xb_add(&bar[XB_XCNT(b.x)], 1u);
    return b;
}
__device__ __forceinline__ void xcd_barrier_complete(unsigned* bar, unsigned x, unsigned& nloc, unsigned& nx) {
    const unsigned G = gridDim.x * gridDim.y * gridDim.z;
    unsigned sum, cnt, mine, sp = 0u;
    for (;;) {
        sum = 0u; cnt = 0u; mine = 0u;
#pragma unroll
        for (unsigned j = 0; j < 16; ++j) { const unsigned c = xb_ld(&bar[XB_XCNT(j)]); sum += c; cnt += (c > 0u) ? 1u : 0u; mine = (j == x) ? c : mine; }
        if (sum == G) break;
        __builtin_amdgcn_s_sleep(1);
        if ((++sp & 255u) == 0u) { if (xb_ld(&bar[XB_TMO])) break; if (sp > XB_SPIN_CAP) { atomicAdd(&bar[XB_TMO], 1u); break; } }
    }
    nloc = mine > 0u ? mine : 1u; nx = cnt > 0u ? cnt : 1u;
}

__device__ __forceinline__ void xcd_barrier(const XcdBarrier& b) {
    asm volatile("s_waitcnt vmcnt(0)" ::: "memory");
    __syncthreads();
    if (threadIdx.x == 0) {
        unsigned* bar = b.bar;
        __builtin_amdgcn_s_waitcnt(0);
        unsigned nloc = b.st[0], nx = b.st[1];
        if (nloc == 0u) { xcd_barrier_complete(bar, b.x, nloc, nx); b.st[0] = nloc; b.st[1] = nx; }
        const unsigned old = xb_add(&bar[XB_XSUB(b.x)], 1u);
        const unsigned gen = old / nloc;
        if (old + 1u == (gen + 1u) * nloc) {
            __builtin_amdgcn_fence(__ATOMIC_RELEASE, "agent");
            asm volatile("s_waitcnt vmcnt(0)" ::: "memory");
            const unsigned og = xb_add(&bar[XB_TOP], 1u);
            const unsigned tg = og / nx;
            if (og + 1u == (tg + 1u) * nx) xb_add(&bar[XB_TOPGEN], 1u);
            else XB_SPIN(xb_ld(&bar[XB_TOPGEN]) == tg, bar);
            __builtin_amdgcn_fence(__ATOMIC_ACQUIRE, "agent");
            xb_add(&bar[XB_XGEN(b.x)], 1u);
            asm volatile("s_waitcnt vmcnt(0)" ::: "memory");
        } else {
            XB_SPIN(xb_ld(&bar[XB_XGEN(b.x)]) == gen, bar);
            __builtin_amdgcn_fence(__ATOMIC_ACQUIRE, "agent");
            asm volatile("s_waitcnt vmcnt(0)" ::: "memory");
        }
    }
    __syncthreads();
}

#define SP_LOC(k, j) (4096 + 640 * (k) + 32 * (j))
#define SP_TOP(k)    (4096 + 640 * (k) + 512)
__device__ __forceinline__ void split_arrive(const XcdBarrier& b, int k) {
    const unsigned nloc = b.st[0];
    const unsigned old = xb_add(&b.bar[SP_LOC(k, b.x)], 1u);
    if (old + 1u == nloc) { __builtin_amdgcn_fence(__ATOMIC_RELEASE, "agent"); asm volatile("s_waitcnt vmcnt(0)" ::: "memory"); (void)xb_add(&b.bar[SP_TOP(k)], 1u); }
}
__device__ __forceinline__ void split_arrive_all(const XcdBarrier& b, int k) {
    asm volatile("s_waitcnt vmcnt(0)" ::: "memory"); __syncthreads();
    if (threadIdx.x == 0) split_arrive(b, k);
}
__device__ __forceinline__ void split_wait(const XcdBarrier& b, int k) {
    if (threadIdx.x == 0) { const unsigned nx = b.st[1]; unsigned* bar = b.bar; XB_SPIN(xb_ld(&bar[SP_TOP(k)]) < nx, bar);
        __builtin_amdgcn_fence(__ATOMIC_ACQUIRE, "agent"); asm volatile("s_waitcnt vmcnt(0)" ::: "memory"); }
    __syncthreads();
}

__device__ __forceinline__ int queue_pull(unsigned char* ws, size_t qoff, volatile LAS int* qslot) {
    if (threadIdx.x == 0) *qslot = (int)__hip_atomic_fetch_add((unsigned*)(ws + qoff), 1u, __ATOMIC_RELAXED, __HIP_MEMORY_SCOPE_AGENT);
    __syncthreads();
    const int t = *qslot;
    __syncthreads();
    return t;
}
__device__ __forceinline__ void phase3(const Params& P, LAS unsigned char* lds, const XcdBarrier& xb) {
    const int G = gridDim.x, bid = blockIdx.x;
    const bool bal = (G == 256);
    volatile LAS int* qslot = (volatile LAS int*)(lds + LDS_BYTES - 32);
    if (bal) {
        { const int b = bid & 7, q = (bid >> 3) & 15, h = q >> 1, dir = q & 1;
          split_wait(xb, 0);
          const bool fh = bid < 128;
          do_chain(P, lds, M_CTX + b * L_LAT, L_LAT, h, dir, fh ? (dir ? P.in[I_SB] : P.in[I_SF]) + (size_t)(b * 8 + h) * 4096 : nullptr, nullptr, fh ? 0 : 2048, 2048, fh ? 1 : 2, b * 16 + q); }
        split_arrive_all(xb, 7);
        split_wait(xb, 1);
        int q2 = -1;
        for (int first = 1;; first = 0) {
            int qq;
            if (first) { if (threadIdx.x == 0) *qslot = (int)__hip_atomic_fetch_add((unsigned*)(P.ws + CW_QUEUE), 2u, __ATOMIC_RELAXED, __HIP_MEMORY_SCOPE_AGENT); __syncthreads(); qq = *qslot; q2 = qq + 1; __syncthreads(); }
            else if (q2 >= 0) { qq = q2; q2 = -1; }
            else qq = queue_pull(P.ws, CW_QUEUE, qslot);
            if (qq >= 832) break;
            const int grp = qq / 5, rr = qq - 5 * grp, gu = (qq >= 640) ? (qq - 512) : ((rr == 4) ? grp : -1);
            if (gu >= 0) { do_gmlp(P, lds, gu); continue; }
            const int cc = grp * 4 + rr, b = cc >> 4, h = (cc >> 1) & 7, dir = cc & 1;
            do_chain(P, lds, b * L_CTX, L_CTX, h, dir, nullptr, P.out + (size_t)MT * D + (size_t)dir * STATE_ELEMS + (size_t)(b * 8 + h) * 4096, 0, L_CTX, 0, 0);
        }
        split_arrive_all(xb, 8);
        return;
    }
    for (int it = 0; it < (640 + G - 1) / G; ++it) {
        int m0, L, h, dir, p0, npt, mode, chain; const float* s0; float* sfin;
        {
            const int c = bid + it * G; if (c >= 640) continue;
            chain = 0; p0 = 0; mode = 0;
            if (c < 128) { const int b = c >> 4; h = (c >> 1) & 7; dir = c & 1; m0 = M_CTX + b * L_LAT; L = L_LAT; npt = L_LAT;
                s0 = (dir ? P.in[I_SB] : P.in[I_SF]) + (size_t)(b * 8 + h) * 4096; sfin = nullptr; }
            else { const int cc = c - 128, b = cc >> 4; h = (cc >> 1) & 7; dir = cc & 1; m0 = b * L_CTX; L = L_CTX; npt = L_CTX;
                s0 = nullptr; sfin = P.out + (size_t)MT * D + (size_t)dir * STATE_ELEMS + (size_t)(b * 8 + h) * 4096; }
        }
        do_chain(P, lds, m0, L, h, dir, s0, sfin, p0, npt, mode, chain);
    }
    if (!bal) { for (int u = bid; u < 320; u += G) do_gmlp(P, lds, u); }
}

__device__ __forceinline__ void phase35(const Params& P, LAS unsigned char* lds, int gw, int NGW, int wave, int lane) {
    if (gridDim.x != 256) return;
    const GAS bf16* Gm = (const GAS bf16*)(P.ws + WS_G); const GAS bf16* HM = (const GAS bf16*)(P.ws + WS_HMID); GAS bf16* CORR = (GAS bf16*)(P.ws + WS_CORR);
    const int lr = lane & 15, lg = lane >> 4;
    LAS bf16* stg = (LAS bf16*)(lds + wave * 2304);
    const int chain = gw >> 4, b = chain >> 4, h = (chain >> 1) & 7, dir = chain & 1;
    bf16x8 hb[4][2];
#pragma unroll
    for (int nt = 0; nt < 4; ++nt) { const GAS bf16* hp = HM + (size_t)chain * 4096 + (16 * nt + lr) * 64 + 8 * lg; hb[nt][0] = *(const GAS bf16x8*)hp; hb[nt][1] = *(const GAS bf16x8*)(hp + 32); }
    const GAS bf16* gp = Gm + ((size_t)chain * 2048 + (gw & 15) * 128 + lr) * 64 + 8 * lg;
    bf16x8 a0 = *(const GAS bf16x8*)gp, a1 = *(const GAS bf16x8*)(gp + 32);
#pragma unroll 1
    for (int i = 0; i < 8; ++i) {
        const bf16x8 c0 = a0, c1 = a1;
        if (i < 7) { a0 = *(const GAS bf16x8*)(gp + (size_t)(i + 1) * 1024); a1 = *(const GAS bf16x8*)(gp + (size_t)(i + 1) * 1024 + 32); }
#pragma unroll
        for (int nt = 0; nt < 4; ++nt) { f32x4 acc = MFMA16(c0, hb[nt][0], ((f32x4){0.f, 0.f, 0.f, 0.f})); acc = MFMA16(c1, hb[nt][1], acc);
            const unsigned w0 = cvtpk(acc[0], acc[1]), w1 = cvtpk(acc[2], acc[3]); LAS bf16* sp = stg + (4 * lg) * 72 + 16 * nt + lr;
            sp[0] = (bf16)(w0 & 0xffffu); sp[72] = (bf16)(w0 >> 16); sp[144] = (bf16)(w1 & 0xffffu); sp[216] = (bf16)(w1 >> 16); }
        const int tr = lane >> 2, vq = lane & 3, p = 2048 + ((gw & 15) * 8 + i) * 16 + tr, t = dir ? (L_LAT - 1 - p) : p;
        const u32x4v o0 = *(const LAS u32x4v*)(stg + tr * 72 + 16 * vq), o1 = *(const LAS u32x4v*)(stg + tr * 72 + 16 * vq + 8);
        GAS bf16* cp = CORR + ((size_t)(b * L_LAT + t)) * 512 + h * 64 + 16 * vq;
        *(GAS u32x4v*)cp = o0; *(GAS u32x4v*)(cp + 8) = o1;
    }
}

__device__ __forceinline__ void phase4(const Params& P, int gw, int NGW, int lane, int m_lo, int m_hi) {
    const GAS bf16* proj = (const GAS bf16*)(P.ws + WS_PROJ); GAS bf16* MIX = (GAS bf16*)(P.ws + WS_H); const GAS bf16* YD = (const GAS bf16*)P.out; const GAS float* BS = (const GAS float*)(P.ws + WS_BS);
    const GAS float* ts_mu = (const GAS float*)P.in[I_TSMU]; const GAS float* gn_w = (const GAS float*)P.in[I_GNW]; const GAS float* gn_b = (const GAS float*)P.in[I_GNB];
    const int ch = 8 * lane, hd = lane >> 3;
    float m0v[8], m1v[8], gw8[8], gb8[8];
#pragma unroll
    for (int e = 0; e < 8; ++e) { m0v[e] = ts_mu[C_V + ch + e]; m1v[e] = ts_mu[1536 + C_V + ch + e]; gw8[e] = gn_w[ch + e]; gb8[e] = gn_b[ch + e]; }
    for (int m = m_lo + gw; m < m_hi; m += NGW) {
        const int t = (m < M_CTX) ? (m & (L_CTX - 1)) : ((m - M_CTX) & (L_LAT - 1)), L = (m < M_CTX) ? L_CTX : L_LAT;
        const u32x4v yf = *(const GAS u32x4v*)(YD + (size_t)m * 512 + ch), yb = *(const GAS u32x4v*)(YD + ((size_t)MT + m) * 512 + ch);
        const GAS bf16* pr = proj + (size_t)m * D_IN;
        const u32x4v vc = *(const GAS u32x4v*)(pr + C_V + ch), za = *(const GAS u32x4v*)(pr + C_ZA + ch);
        u32x4v vp = (u32x4v){0u, 0u, 0u, 0u}, vn = (u32x4v){0u, 0u, 0u, 0u};
        if (t > 0) vp = *(const GAS u32x4v*)(pr + C_V + ch - D_IN);
        if (t < L - 1) vn = *(const GAS u32x4v*)(pr + C_V + ch + D_IN);
        const float bon = BS[(size_t)m * 8 + hd] + BS[((size_t)MT + m) * 8 + hd];
        u32x4v cr = (u32x4v){0u, 0u, 0u, 0u};
        if (m >= M_CTX && gridDim.x == 256) cr = *(const GAS u32x4v*)((const GAS bf16*)(P.ws + WS_CORR) + (size_t)(m - M_CTX) * 512 + ch);
        float y[8];
#pragma unroll
        for (int e = 0; e < 8; ++e) { const unsigned sh = (e & 1) ? 16u : 0u; y[e] = bf2f((yf[e >> 1] >> sh) & 0xffffu) + bf2f((yb[e >> 1] >> sh) & 0xffffu); }
        float s = 0.f;
#pragma unroll
        for (int e = 0; e < 8; ++e) { y[e] += bf2f((cr[e >> 1] >> ((e & 1) ? 16u : 0u)) & 0xffffu); s += y[e]; }
        const float mean = oct_sum(s) * (1.0f / 64.0f); float q = 0.f;
#pragma unroll
        for (int e = 0; e < 8; ++e) { y[e] -= mean; q += y[e] * y[e]; }
        const float rstd = 1.0f / sqrtf(oct_sum(q) * (1.0f / 64.0f) + GN_EPS);
        u32x4v o;
#pragma unroll
        for (int e2 = 0; e2 < 4; ++e2) { float r2[2];
#pragma unroll
            for (int hh = 0; hh < 2; ++hh) { const int e = 2 * e2 + hh; const unsigned sh = hh ? 16u : 0u;
                const float c0 = bf2f((vc[e2] >> sh) & 0xffffu), p0 = bf2f((vp[e2] >> sh) & 0xffffu), n0 = bf2f((vn[e2] >> sh) & 0xffffu), z = bf2f((za[e2] >> sh) & 0xffffu);
                const float v = c0 + m0v[e] * (p0 - c0) + m1v[e] * (n0 - c0);
                r2[hh] = (y[e] * rstd * gw8[e] + gb8[e] + bon * v) * silu_f(z); }
            o[e2] = cvtpk(r2[0], r2[1]); }
        *(GAS u32x4v*)(MIX + (size_t)m * D + ch) = o;
    }
}

__device__ __forceinline__ void phase45(const Params& P, LAS unsigned char* lds, const XcdBarrier& xb, int gw, int NGW, int wave, int lane) {
    split_wait(xb, 7);
    const GAS bf16* Gm = (const GAS bf16*)(P.ws + WS_G); const GAS bf16* HM = (const GAS bf16*)(P.ws + WS_HMID);
    const GAS bf16* proj = (const GAS bf16*)(P.ws + WS_PROJ); GAS bf16* MIX = (GAS bf16*)(P.ws + WS_H); const GAS bf16* YD = (const GAS bf16*)P.out; const GAS float* BS = (const GAS float*)(P.ws + WS_BS);
    const GAS float* ts_mu = (const GAS float*)P.in[I_TSMU]; const GAS float* gn_w = (const GAS float*)P.in[I_GNW]; const GAS float* gn_b = (const GAS float*)P.in[I_GNB];
    const int lr = lane & 15, lg = lane >> 4;
    LAS bf16* stg = (LAS bf16*)(lds + wave * 16640);
    const int tile = gw, b = tile >> 8, t0 = (tile & 255) * 16, dirs = (t0 >= 2048) ? 0 : 1;
    const int grow0 = (dirs ? (L_LAT - 1 - t0 - 15) : t0) - 2048;
#pragma unroll 1
    for (int hp2 = 0; hp2 < 4; ++hp2) {
        bf16x8 ga[2][2], hb[2][4][2];
#pragma unroll
        for (int q = 0; q < 2; ++q) { const int chain = b * 16 + (2 * hp2 + q) * 2 + dirs;
            const GAS bf16* gp = Gm + ((size_t)chain * 2048 + grow0 + lr) * 64 + 8 * lg; ga[q][0] = *(const GAS bf16x8*)gp; ga[q][1] = *(const GAS bf16x8*)(gp + 32);
#pragma unroll
            for (int nt = 0; nt < 4; ++nt) { const GAS bf16* hp = HM + (size_t)chain * 4096 + (16 * nt + lr) * 64 + 8 * lg; hb[q][nt][0] = *(const GAS bf16x8*)hp; hb[q][nt][1] = *(const GAS bf16x8*)(hp + 32); } }
#pragma unroll
        for (int q = 0; q < 2; ++q)
#pragma unroll
            for (int nt = 0; nt < 4; ++nt) { f32x4 acc = MFMA16(ga[q][0], hb[q][nt][0], ((f32x4){0.f, 0.f, 0.f, 0.f})); acc = MFMA16(ga[q][1], hb[q][nt][1], acc);
                const unsigned w0 = cvtpk(acc[0], acc[1]), w1 = cvtpk(acc[2], acc[3]); LAS bf16* sp = stg + (4 * lg) * 520 + (2 * hp2 + q) * 64 + 16 * nt + lr;
                sp[0] = (bf16)(w0 & 0xffffu); sp[520] = (bf16)(w0 >> 16); sp[1040] = (bf16)(w1 & 0xffffu); sp[1560] = (bf16)(w1 >> 16); }
    }
    const int ch = 8 * lane, hd = lane >> 3;
    float m0v[8], m1v[8], gw8[8], gb8[8];
#pragma unroll
    for (int e = 0; e < 8; ++e) { m0v[e] = ts_mu[C_V + ch + e]; m1v[e] = ts_mu[1536 + C_V + ch + e]; gw8[e] = gn_w[ch + e]; gb8[e] = gn_b[ch + e]; }
    const u32x4v zero4 = (u32x4v){0u, 0u, 0u, 0u};
    const GAS bf16* prow0 = proj + (size_t)(M_CTX + b * L_LAT + t0) * D_IN;
    u32x4v vprev = (t0 > 0) ? *(const GAS u32x4v*)(prow0 + C_V + ch - D_IN) : zero4, vcur = *(const GAS u32x4v*)(prow0 + C_V + ch), vnext = *(const GAS u32x4v*)(prow0 + C_V + ch + D_IN);
    u32x4v yf_n, yb_n, za_n; float bs0_n, bs1_n;
    { const int m = M_CTX + b * L_LAT + t0; yf_n = *(const GAS u32x4v*)(YD + (size_t)m * 512 + ch); yb_n = *(const GAS u32x4v*)(YD + ((size_t)MT + m) * 512 + ch); za_n = *(const GAS u32x4v*)(prow0 + C_ZA + ch);
      bs0_n = BS[(size_t)m * 8 + hd]; bs1_n = BS[((size_t)MT + m) * 8 + hd]; }
#pragma unroll 1
    for (int r = 0; r < 16; ++r) {
        const int t = t0 + r, m = M_CTX + b * L_LAT + t, pl = dirs ? (15 - r) : r;
        const u32x4v yf = yf_n, yb = yb_n, za = za_n, vc = vcur, vp = vprev, vn = vnext; const float bon = bs0_n + bs1_n;
        u32x4v vnn = zero4;
        if (r < 15) { const int m1 = m + 1; const GAS bf16* pr1 = proj + (size_t)m1 * D_IN;
            yf_n = *(const GAS u32x4v*)(YD + (size_t)m1 * 512 + ch); yb_n = *(const GAS u32x4v*)(YD + ((size_t)MT + m1) * 512 + ch); za_n = *(const GAS u32x4v*)(pr1 + C_ZA + ch);
            bs0_n = BS[(size_t)m1 * 8 + hd]; bs1_n = BS[((size_t)MT + m1) * 8 + hd];
            if (t + 2 < L_LAT) vnn = *(const GAS u32x4v*)(pr1 + C_V + ch + D_IN); }
        const u32x4v cr = *(const LAS u32x4v*)(stg + pl * 520 + ch);
        float y[8]; float s = 0.f;
#pragma unroll
        for (int e = 0; e < 8; ++e) { const unsigned sh = (e & 1) ? 16u : 0u; y[e] = bf2f((yf[e >> 1] >> sh) & 0xffffu) + bf2f((yb[e >> 1] >> sh) & 0xffffu) + bf2f((cr[e >> 1] >> sh) & 0xffffu); s += y[e]; }
        const float mean = oct_sum(s) * (1.0f / 64.0f); float q = 0.f;
#pragma unroll
        for (int e = 0; e < 8; ++e) { y[e] -= mean; q += y[e] * y[e]; }
        const float rstd = 1.0f / sqrtf(oct_sum(q) * (1.0f / 64.0f) + GN_EPS);
        u32x4v o;
#pragma unroll
        for (int e2 = 0; e2 < 4; ++e2) { float r2[2];
#pragma unroll
            for (int hh = 0; hh < 2; ++hh) { const int e = 2 * e2 + hh; const unsigned sh = hh ? 16u : 0u;
                const float c0 = bf2f((vc[e2] >> sh) & 0xffffu), p0 = bf2f((vp[e2] >> sh) & 0xffffu), n0 = bf2f((vn[e2] >> sh) & 0xffffu), z = bf2f((za[e2] >> sh) & 0xffffu);
                const float v = c0 + m0v[e] * (p0 - c0) + m1v[e] * (n0 - c0);
                r2[hh] = (y[e] * rstd * gw8[e] + gb8[e] + bon * v) * silu_f(z); }
            o[e2] = cvtpk(r2[0], r2[1]); }
        *(GAS u32x4v*)(MIX + (size_t)m * D + ch) = o;
        vprev = vcur; vcur = vnext; vnext = vnn;
    }
    split_arrive_all(xb, 9);
    split_wait(xb, 8);
    phase4(P, gw, NGW, lane, 0, M_CTX);
    split_arrive_all(xb, 10);
}

__device__ __forceinline__ void phase6(const Params& P, int gw, int NGW, int lane) {
    const GAS float* mod = (const GAS float*)(P.ws + WS_MOD); const GAS float* ln_post = (const GAS float*)P.in[I_LNPOST]; const GAS bf16* OB = (const GAS bf16*)(P.ws + WS_OUTB);
#pragma unroll 1
    for (int seg = 0; seg < 9; ++seg) {
        const int m_lo = (seg == 0) ? 0 : M_CTX + (seg - 1) * L_LAT, m_hi = (seg == 0) ? M_CTX : m_lo + L_LAT;
        const GAS float* gate = mod + seg * 3072 + 2048;
        f32x4 wg[4];
#pragma unroll
        for (int j = 0; j < 4; ++j) { const int col = 4 * (lane + 64 * j); wg[j] = *(const GAS f32x4*)(ln_post + col) * *(const GAS f32x4*)(gate + col); }
        for (int m = m_lo + gw; m < m_hi; m += NGW) {
            const GAS f32x4* xr = (const GAS f32x4*)x_row(P, m) + lane; GAS f32x4* orow = (GAS f32x4*)(P.out + (size_t)m * D) + lane;
            const GAS u32x2v* ob = (const GAS u32x2v*)(OB + (size_t)m * D) + lane;
            f32x4 o[4], xv[4]; float ss = 0.f;
#pragma unroll
            for (int j = 0; j < 4; ++j) { const u32x2v r = ob[64 * j]; xv[j] = xr[64 * j]; o[j][0] = bf2f(r.x & 0xffffu); o[j][1] = bf2f(r.x >> 16); o[j][2] = bf2f(r.y & 0xffffu); o[j][3] = bf2f(r.y >> 16);
                ss += (o[j][0] * o[j][0] + o[j][1] * o[j][1]) + (o[j][2] * o[j][2] + o[j][3] * o[j][3]); }
            const float rstd = 1.0f / sqrtf(wave_sum(ss) * (1.0f / D) + NORM_EPS);
#pragma unroll
            for (int j = 0; j < 4; ++j) orow[64 * j] = xv[j] + o[j] * rstd * wg[j];
        }
    }
}

__device__ __forceinline__ void phase0_dyn(const Params& P, LAS unsigned char* lds, const XcdBarrier& xb, int gw, int NGW, int wave, int lane) {
    typedef float f32x2 __attribute__((ext_vector_type(2)));
    float* mod = (float*)(P.ws + WS_MOD);
    const float* w_mod = P.in[I_WMOD]; const float* b_mod = P.in[I_BMOD]; const float* cc = P.in[I_C]; const float* cctx = P.in[I_CCTX];
    const int cgp = blockIdx.x & 31, rg = blockIdx.x >> 5, col = cgp * 96 + 2 * (lane < 48 ? lane : 0), r0 = rg * 128 + wave * 16;
    f32x2 acc[9];
#pragma unroll
    for (int v = 0; v < 9; ++v) acc[v] = (f32x2){0.f, 0.f};
    f32x2 w[16];
#pragma unroll
    for (int i = 0; i < 16; ++i) w[i] = *(const GAS f32x2*)((const GAS float*)w_mod + (size_t)(r0 + i) * 3072 + col);
#pragma unroll
    for (int i = 0; i < 16; ++i) {
#pragma unroll
        for (int v = 0; v < 9; ++v) { const float cv = (v == 0) ? cctx[r0 + i] : cc[(v - 1) * 1024 + r0 + i]; acc[v] += silu_f(cv) * w[i]; }
    }
    LAS f32x2* red = (LAS f32x2*)lds;
#pragma unroll
    for (int v = 0; v < 9; ++v) red[(wave * 9 + v) * 64 + lane] = acc[v];
    __syncthreads();
    { const int idx = threadIdx.x;
      if (idx < 9 * 48) { const int v = idx / 48, l = idx - 48 * v; f32x2 s = red[v * 64 + l];
#pragma unroll
        for (int w2 = 1; w2 < 8; ++w2) s += red[(w2 * 9 + v) * 64 + l];
        const int c2 = cgp * 96 + 2 * l;
        if (rg == 0) s += *(const f32x2*)(b_mod + c2);
        atomicAdd(mod + v * 3072 + c2, s[0]); atomicAdd(mod + v * 3072 + c2 + 1, s[1]); } }
    if (threadIdx.x == 0 && xb.st[0] == 0u) { unsigned nloc, nx; xcd_barrier_complete(xb.bar, xb.x, nloc, nx); xb.st[0] = nloc; xb.st[1] = nx; }
    split_arrive_all(xb, 11);
    weight_copies(P, lds, gw, NGW, wave, lane);
    split_wait(xb, 11);
}

__device__ __forceinline__ void phase1_dyn(const Params& P, const XcdBarrier& xb, int wave, int lane) {
    const int c = blockIdx.x, x = c & 7, i = c >> 3;
    f32x4 gs[4], sh[4];
    prenorm_mod(P, 1 + x, lane, gs, sh);
    const int m1 = M_CTX + L_LAT * x + 64 * i + 8 * wave;
    prenorm_rows(P, m1, 8, lane, gs, sh);
    split_arrive_all(xb, 4);
    if (i & 1) { prenorm_rows(P, m1 + 2048, 8, lane, gs, sh); prenorm_rows(P, m1 - 64 + 2048 + 6, 2, lane, gs, sh); }
    else prenorm_rows(P, m1 + 2048, 6, lane, gs, sh);
    split_arrive_all(xb, 5);
    prenorm_mod(P, 0, lane, gs, sh);
    const int m0 = 1024 * x + 32 * i + 4 * wave;
    prenorm_rows(P, m0, 4, lane, gs, sh);
    split_arrive_all(xb, 6);
}

struct Gemm1Order {
    int G, c; pg8::StaticOrder so;
    __device__ __forceinline__ void init(int G_, int c_) { G = G_; c = c_; so.init(MT, D_IN, G_, c_); }
    __device__ __forceinline__ bool next(int i, pg8::Unit& u) const {
        if (G != 256) return so.next(i, u);
        const int j = 32 * i + (c >> 3), x = c & 7; if (j >= 300) return false;
        if (j < 240) { const int grp = j / 60, idx = j - 60 * grp; u.pm = 32 + 16 * x + 4 * grp + (idx & 3); u.pn = idx >> 2; }
        else { const int jj = j - 240; u.pm = 4 * x + (jj & 3); u.pn = jj >> 2; }
        return true;
    }
    __device__ __forceinline__ void a_ready(const pg8::Unit&) const {}
    __device__ __forceinline__ void done(const pg8::Unit&, int ui) const {
        if (G == 256 && ui == 7) { asm volatile("s_waitcnt vmcnt(0)" ::: "memory"); __builtin_amdgcn_s_barrier();
            if (threadIdx.x == 0) split_arrive(xb, 0); }
        if (G == 256 && ui == 1) split_wait(xb, 5);
        if (G == 256 && ui == 5) split_wait(xb, 6);
    }
    XcdBarrier xb;
};

struct Gemm2Order {
    int G, c; pg8::StaticOrder so; XcdBarrier xb;
    __device__ __forceinline__ void init(int G_, int c_) { G = G_; c = c_; so.init(MT, D, G_, c_); }
    __device__ __forceinline__ bool next(int i, pg8::Unit& u) const {
        if (G != 256) return so.next(i, u);
        const int j = 32 * i + (c >> 3), x = c & 7; if (j >= 80) return false;
        if (j < 64) { u.pm = 32 + 16 * x + 8 * (j >> 5) + (j & 7); u.pn = (j & 31) >> 3; }
        else { const int jj = j - 64; u.pm = 4 * x + (jj & 3); u.pn = jj >> 2; }
        return true;
    }
    __device__ __forceinline__ void a_ready(const pg8::Unit&) const {}
    __device__ __forceinline__ void done(const pg8::Unit&, int ui) const {
        if (G == 256 && ui == 1) { asm volatile("s_waitcnt vmcnt(0)" ::: "memory"); __builtin_amdgcn_s_barrier();
            if (threadIdx.x == 0) split_arrive(xb, 2); }
        if (G == 256 && ui == 0) split_wait(xb, 10);
    }
};

__device__ __forceinline__ void phase6_dyn(const Params& P, LAS unsigned char* lds, const XcdBarrier& xb, int wave, int lane) {
    const GAS float* mod = (const GAS float*)(P.ws + WS_MOD); const GAS float* ln_post = (const GAS float*)P.in[I_LNPOST]; const GAS bf16* OB = (const GAS bf16*)(P.ws + WS_OUTB);
    volatile LAS int* qs = (volatile LAS int*)(lds + LDS_BYTES - 64);
    unsigned* qctr = (unsigned*)(P.ws + CW_QUEUE + 512);
    split_wait(xb, 2);
    if (threadIdx.x == 0) qs[0] = (int)__hip_atomic_fetch_add(qctr, 1u, __ATOMIC_RELAXED, __HIP_MEMORY_SCOPE_AGENT);
    __syncthreads();
    int cur = qs[0], par = 1, seg_cur = -1; bool late_ok = false;
    f32x4 wg[4];
    while (cur < 2560) {
        unsigned nxt = 0u;
        if (threadIdx.x == 0) nxt = __hip_atomic_fetch_add(qctr, 1u, __ATOMIC_RELAXED, __HIP_MEMORY_SCOPE_AGENT);
        if (cur >= 2048 && !late_ok) { split_wait(xb, 3); late_ok = true; }
        int pm;
        if (cur < 2048) pm = 32 + (cur >> 4); else pm = (cur - 2048) >> 4;
        const int m = pm * 256 + (cur & 15) * 16 + wave * 2, seg = (m < M_CTX) ? 0 : 1 + ((m - M_CTX) >> 12);
        f32x4 o[2][4], xv[2][4];
#pragma unroll
        for (int rr = 0; rr < 2; ++rr) { const GAS f32x4* xr = (const GAS f32x4*)x_row(P, m + rr) + lane; const GAS u32x2v* ob = (const GAS u32x2v*)(OB + (size_t)(m + rr) * D) + lane;
#pragma unroll
            for (int j = 0; j < 4; ++j) { const u32x2v r = ob[64 * j]; xv[rr][j] = __builtin_nontemporal_load(xr + 64 * j); o[rr][j][0] = bf2f(r.x & 0xffffu); o[rr][j][1] = bf2f(r.x >> 16); o[rr][j][2] = bf2f(r.y & 0xffffu); o[rr][j][3] = bf2f(r.y >> 16); } }
        if (seg != seg_cur) { seg_cur = seg; const GAS float* gate = mod + seg * 3072 + 2048;
#pragma unroll
            for (int j = 0; j < 4; ++j) { const int col = 4 * (lane + 64 * j); wg[j] = *(const GAS f32x4*)(ln_post + col) * *(const GAS f32x4*)(gate + col); } }
#pragma unroll
        for (int rr = 0; rr < 2; ++rr) { float ss = 0.f;
#pragma unroll
            for (int j = 0; j < 4; ++j) ss += (o[rr][j][0] * o[rr][j][0] + o[rr][j][1] * o[rr][j][1]) + (o[rr][j][2] * o[rr][j][2] + o[rr][j][3] * o[rr][j][3]);
            const float rstd = 1.0f / sqrtf(wave_sum(ss) * (1.0f / D) + NORM_EPS);
            GAS f32x4* orow = (GAS f32x4*)(P.out + (size_t)(m + rr) * D) + lane;
#pragma unroll
            for (int j = 0; j < 4; ++j) __builtin_nontemporal_store(xv[rr][j] + o[rr][j] * rstd * wg[j], orow + 64 * j); }
        if (threadIdx.x == 0) qs[par] = (int)nxt;
        __syncthreads();
        cur = qs[par]; par ^= 1;
    }
}

constexpr int N_PHASES = 8;
__global__ void __launch_bounds__(NTHREADS, 2) fwd_kernel(Params P) {
    extern __shared__ __attribute__((aligned(16))) unsigned char lds_raw[];
    LAS unsigned char* lds = (LAS unsigned char*)lds_raw;
    const int tid = threadIdx.x, lane = tid & 63, wave = __builtin_amdgcn_readfirstlane(tid >> 6);
    const int G = gridDim.x, gw = blockIdx.x * NWAVES + wave, NGW = G * NWAVES;
    const int lo = P.ph_lo, hi = P.ph_hi;
    volatile LAS unsigned* bst = (volatile LAS unsigned*)(lds + LDS_BYTES - 16);
    if (tid < 2) bst[tid] = 0u;
    __syncthreads();
    XcdBarrier bar = xcd_barrier_post((unsigned*)P.ws, bst);
#define IN(k) (lo <= (k) && (k) < hi)
#define SEAM(k) do { if (IN(k) && IN((k) + 1)) xcd_barrier(bar); } while (0)
#define PP(name) const Params* name = (const Params*)__builtin_amdgcn_kernarg_segment_ptr(); asm volatile("" : "+s"(name))
    if (IN(0)) { PP(q);
        if (G == 256) phase0_dyn(*q, lds, bar, gw, NGW, wave, lane);
        else { phase0(*q, lds, gw, NGW, wave, lane);
            if (G > 96) { if ((int)blockIdx.x >= 96) weight_copies(*q, lds, gw - 96 * NWAVES, NGW - 96 * NWAVES, wave, lane); }
            else weight_copies(*q, lds, gw, NGW, wave, lane); } }
    if (G != 256) SEAM(0);
    { PP(q); TS(q->ws, 0); }
    if (IN(1)) { PP(q); if (G == 256) phase1_dyn(*q, bar, wave, lane); else phase1(*q, gw, NGW, lane); }
    if (G != 256) SEAM(1); else split_wait(bar, 4);
    if (IN(2)) { PP(q); unsigned char* ws = q->ws; TS(ws, 1);
        pg8::Gemm g{(const pg8::bf16_t*)(ws + WS_H), (const pg8::bf16_t*)(ws + WS_WIN), MT, D_IN, D}; Gemm1Order S; S.init(G, (int)blockIdx.x); S.xb = bar;
        pg8::EpiBf16 E{(pg8::bf16_t*)(ws + WS_PROJ), D_IN, C_WD / 256};
        pg8::gemm_phase<pg8::EpiBf16, Gemm1Order, true, true>(lds, g, S, E);
        TS(ws, 2);
        if (G == 256 && tid == 0) split_arrive(bar, 1); }
    if (G != 256) SEAM(2);
    if (IN(3)) { PP(q); phase3(*q, lds, bar); TS(q->ws, 5); }
    if (G != 256) SEAM(3);
    { PP(q); TS(q->ws, 6); }
    if (G == 256) { if (IN(4)) { PP(q); phase45(*q, lds, bar, gw, NGW, wave, lane); TS(q->ws, 7); } }
    else { if (IN(4)) { PP(q); phase35(*q, lds, gw, NGW, wave, lane); }
        SEAM(4);
        if (IN(5)) { PP(q); phase4(*q, gw, NGW, lane, 0, MT); } }
    if (G != 256) SEAM(5); else split_wait(bar, 9);
    if (IN(6)) { PP(q); unsigned char* ws = q->ws; TS(ws, 8);
        pg8::Gemm g{(const pg8::bf16_t*)(ws + WS_H), (const pg8::bf16_t*)(ws + WS_WOUT), MT, D, D}; Gemm2Order S; S.init(G, (int)blockIdx.x); S.xb = bar;
        pg8::EpiBf16 E{(pg8::bf16_t*)(ws + WS_OUTB), D, -1};
        pg8::gemm_phase<pg8::EpiBf16, Gemm2Order, true, true>(lds, g, S, E); TS(ws, 9);
        if (G == 256 && tid == 0) split_arrive(bar, 3); }
    if (G != 256) SEAM(6);
    { PP(q); TS(q->ws, 10); }
    if (IN(7)) { PP(q); if (G == 256) phase6_dyn(*q, lds, bar, wave, lane); else phase6(*q, gw, NGW, lane);
#ifdef PROBE_KA
        { const unsigned* ts = (const unsigned*)(q->ws + CW_TS); unsigned t0 = 0xffffffffu;
          for (int b = 0; b < 256; ++b) t0 = min(t0, ts[b * 16]);
          float acc = (PROBE_RED == 1) ? 1e30f : 0.f; int n = 0;
          for (int b = 0; b < 256; ++b) { const bool in = (PROBE_SUB == 0) || (PROBE_SUB == 1 && b < 96) || (PROBE_SUB == 2 && b >= 96) || (PROBE_SUB == 3 && b >= 96 && b < 128) || (PROBE_SUB == 4 && b >= 128) || (PROBE_SUB == 5 && ((b >> 3) & 1) == 0) || (PROBE_SUB == 6 && ((b >> 3) & 1) == 1);
              if (!in) continue; const float v = (float)(int)(ts[b * 16 + PROBE_KA] - ((PROBE_KB < 0) ? t0 : ts[b * 16 + PROBE_KB]));
              acc = (PROBE_RED == 0) ? fmaxf(acc, v) : (PROBE_RED == 1) ? fminf(acc, v) : acc + v; ++n; }
          if (PROBE_RED == 2) acc /= (float)n;
          const float f = 1.0f + acc * PROBE_SCALE;
          float* nb = q->out + (size_t)MT * D + STATE_ELEMS;
          for (size_t i = (size_t)gw * 64 + lane; i < STATE_ELEMS; i += (size_t)NGW * 64) nb[i] *= f; }
#endif
    }
#undef PP
#undef IN
#undef SEAM
}

#ifndef N_LAUNCHES
#define N_LAUNCHES 1
#endif
extern "C" void kernel_launch(void* const* d_in, const int* in_sizes, int n_in, void* d_out, int out_size, void* d_ws, size_t ws_size, hipStream_t stream) {
    static int grid = 0;
    if (grid == 0) {
        if (n_in != 26 || ws_size < WS_END) { fprintf(stderr, "kernel_launch: unexpected n_in %d / ws_size %zu (need %zu)\n", n_in, ws_size, (size_t)WS_END); grid = -1; return; }
        int dev = 0, cus = 0, per_cu = 0;
        hipGetDevice(&dev); hipDeviceGetAttribute(&cus, hipDeviceAttributeMultiprocessorCount, dev);
        if (hipFuncSetAttribute((const void*)fwd_kernel, hipFuncAttributeMaxDynamicSharedMemorySize, LDS_BYTES) != hipSuccess) { fprintf(stderr, "kernel_launch: hipFuncSetAttribute failed\n"); grid = -1; return; }
        if (hipOccupancyMaxActiveBlocksPerMultiprocessor(&per_cu, (const void*)fwd_kernel, NTHREADS, LDS_BYTES) != hipSuccess || per_cu < 1) { fprintf(stderr, "kernel_launch: occupancy query says %d\n", per_cu); per_cu = 1; }
        (void)hipGetLastError();
        grid = cus * 1;
        fprintf(stderr, "kernel_launch: cus %d per_cu %d grid %d\n", cus, per_cu, grid);
    }
    if (grid < 0) return;
    hipMemsetAsync((char*)d_ws + WS_CTL, 0, CTL_ZERO_BYTES, stream);
    Params p{};
    for (int i = 0; i < 26; ++i) p.in[i] = (const float*)d_in[i];
    p.out = (float*)d_out; p.ws = (unsigned char*)d_ws;
    if (N_LAUNCHES == 1) {
        p.ph_lo = 0; p.ph_hi = N_PHASES;
        hipLaunchKernelGGL(fwd_kernel, dim3(grid), dim3(NTHREADS), LDS_BYTES, stream, p);
    } else {
        for (int ph = 0; ph < N_PHASES; ++ph) { p.ph_lo = ph; p.ph_hi = ph + 1; hipLaunchKernelGGL(fwd_kernel, dim3(grid), dim3(NTHREADS), LDS_BYTES, stream, p); }
    }
}
```

```cpp
#include <hip/hip_runtime.h>
#include <cstdio>
#include <cstdint>
namespace pg8 {
#define PG8_LAS __attribute__((address_space(3)))
typedef unsigned short bf16_t;
typedef short bf16x8 __attribute__((ext_vector_type(8)));
typedef float f32x4 __attribute__((ext_vector_type(4)));
typedef unsigned u32x4 __attribute__((ext_vector_type(4)));
constexpr int BM = 256, BK = 64, HALF = 128, HTB = HALF * BK * 2  , STAGE_BYTES = 8 * HTB, NXCD = 8, WGM = 8;

__host__ __device__ __forceinline__ int lds_byte(int r, int c) { const int st = (r >> 4) * 2 + (c >> 5), rr = r & 15, cc = c & 31, ob = rr * 64 + cc * 2; return st * 1024 + (ob ^ (((ob >> 9) & 1) << 5)); }
__host__ __device__ __forceinline__ void stage_rc(int b, int& R, int& C) { const int st = b / 1024, sb = b % 1024, swz = sb ^ (((sb >> 9) & 1) << 5); R = (st >> 1) * 16 + swz / 64; C = (st & 1) * 32 + (swz % 64) / 2; }
__host__ __device__ __forceinline__ int perm32(int rho) { const int n = rho >> 4, i = rho & 15; return 8 * (i >> 2) + 4 * n + (i & 3); }

struct Unit { int pm, pn; };
struct Gemm { const bf16_t* A; const bf16_t* Bt; int M, N, K; };

struct StaticOrder {
    int nM, nN, nwg, G, c;
    __host__ __device__ void init(int M, int N, int G_, int c_) { nM = M / BM; nN = N / BM; nwg = nM * nN; G = G_; c = c_; }
    __host__ __device__ bool next(int i, Unit& u) const {
        const long L = (long)i * G + c; if (L >= nwg) return false;
        int wgid = (int)L; { const int q = nwg / NXCD, r = nwg % NXCD, xcd = wgid % NXCD, off = wgid / NXCD; wgid = (xcd < r ? xcd * (q + 1) : r * (q + 1) + (xcd - r) * q) + off; }
        const int nig = WGM * nN, gid = wgid / nig, fm = gid * WGM, gsz = (nM - fm) < WGM ? (nM - fm) : WGM;
        u.pm = fm + ((wgid % nig) % gsz); u.pn = (wgid % nig) / gsz; return true;
    }
    __device__ __forceinline__ void a_ready(const Unit&) const {}
    __device__ __forceinline__ void done(const Unit&, int) const {}
};
typedef float f32x2p __attribute__((ext_vector_type(2)));
typedef __bf16 bf16x2p __attribute__((ext_vector_type(2)));
__device__ __forceinline__ unsigned cvt_pk_bf16(float lo, float hi) { f32x2p v; v.x = lo; v.y = hi; return __builtin_bit_cast(unsigned, __builtin_convertvector(v, bf16x2p)); }
struct EpiBf16 {
    static constexpr bool PERM = true, AFTER_DRAIN = false;
    bf16_t* O; int ldc; int tanh_pn;
    __device__ __forceinline__ void operator()(const f32x4 (&acc)[2][2][4][2], const Unit& u, int wr, int wc, int fr, int fq) const {
        const int row0 = u.pm * BM + wr * 64 + fr, col0 = u.pn * BM + wc * 32 + 8 * fq;
#pragma unroll
        for (int ai = 0; ai < 2; ++ai)
#pragma unroll
            for (int m = 0; m < 4; ++m) { bf16_t* rowp = O + (size_t)(row0 + ai * HALF + m * 16) * ldc + col0;
#pragma unroll
                for (int bj = 0; bj < 2; ++bj) { f32x4 v0 = acc[ai][bj][m][0], v1 = acc[ai][bj][m][1];
                    if (bj == 0 && u.pn == tanh_pn) {
#pragma unroll
                        for (int j = 0; j < 4; ++j) { v0[j] = 1.0f - 2.0f * __builtin_amdgcn_rcpf(1.0f + __builtin_amdgcn_exp2f(2.88539008f * v0[j])); v1[j] = 1.0f - 2.0f * __builtin_amdgcn_rcpf(1.0f + __builtin_amdgcn_exp2f(2.88539008f * v1[j])); } }
                    u32x4 w; w.x = cvt_pk_bf16(v0[0], v0[1]); w.y = cvt_pk_bf16(v0[2], v0[3]); w.z = cvt_pk_bf16(v1[0], v1[1]); w.w = cvt_pk_bf16(v1[2], v1[3]);
                    __builtin_nontemporal_store(w, (u32x4*)(rowp + bj * HALF)); } }
    }
};
struct EpiF32 {
    static constexpr bool PERM = false, AFTER_DRAIN = false;
    float* C; int ldc;
    __device__ __forceinline__ void operator()(const f32x4 (&acc)[2][2][4][2], const Unit& u, int wr, int wc, int fr, int fq) const {
        const int row0 = u.pm * BM + wr * 64 + fr, col0 = u.pn * BM + wc * 32 + 4 * fq;
#pragma unroll
        for (int ai = 0; ai < 2; ++ai)
#pragma unroll
            for (int m = 0; m < 4; ++m) { float* rowp = C + (size_t)(row0 + ai * HALF + m * 16) * ldc + col0;
#pragma unroll
                for (int bj = 0; bj < 2; ++bj)
#pragma unroll
                    for (int n = 0; n < 2; ++n) *(f32x4*)(rowp + bj * HALF + n * 16) = acc[ai][bj][m][n]; }
    }
};
template <class Epi, class Sched, bool ALIGN_EPI = false, bool SP2 = false>
__device__ __forceinline__ void gemm_phase(PG8_LAS unsigned char* lds, const Gemm g, const Sched& S, const Epi& E) {
    const int tid = threadIdx.x, wid = __builtin_amdgcn_readfirstlane(tid >> 6), lane = tid & 63, wr = wid >> 2, wc = wid & 3, fr = lane & 15, fq = lane >> 4;
    const int K = g.K, nt = K / BK;
    unsigned voffA[2], voffB[2];
#pragma unroll
    for (int i = 0; i < 2; ++i) { int R, C; stage_rc(tid * 16 + i * 8192, R, C); const int Rb = Epi::PERM ? ((R & ~31) + perm32(R & 31)) : R;
        voffA[i] = (unsigned)(R * K + C) * 2u; voffB[i] = (unsigned)(Rb * K + C) * 2u; }
    const size_t kstep = (size_t)(BK * 2);
    const size_t hstep = (size_t)HALF * K * 2;
    const size_t tstep = 2 * hstep;
    const unsigned ldsw = (unsigned)wid * 1024u;
    const int aoff = lds_byte(wr * 64 + fr, fq * 8), boff = lds_byte(wc * 32 + fr, fq * 8);
#define PG8_SA(b, h) (((b) * 2 + (h)) * HTB)
#define PG8_SB(b, h) ((4 + (b) * 2 + (h)) * HTB)
#define PG8_STAGE(bufoff, gbase, voff) do { _Pragma("unroll") for (int _i = 0; _i < 2; ++_i) \
        __builtin_amdgcn_global_load_lds((const unsigned*)((const char*)(gbase) + (voff)[_i]), (PG8_LAS unsigned*)(lds + (bufoff) + ldsw + _i * 8192), 16, 0, 0); } while (0)
#define PG8_LDA(dst, b, h) do { _Pragma("unroll") for (int m = 0; m < 4; ++m) _Pragma("unroll") for (int k = 0; k < 2; ++k) dst[m][k] = *(const PG8_LAS bf16x8*)(lds + PG8_SA(b, h) + aoff + m * 2048 + k * 1024); } while (0)
#define PG8_LDB(dst, b, h) do { _Pragma("unroll") for (int n = 0; n < 2; ++n) _Pragma("unroll") for (int k = 0; k < 2; ++k) dst[n][k] = *(const PG8_LAS bf16x8*)(lds + PG8_SB(b, h) + boff + n * 2048 + k * 1024); } while (0)
#define PG8_MMA(ai, bj, At, Bt) do { __builtin_amdgcn_s_setprio(1); _Pragma("unroll") for (int m = 0; m < 4; ++m) _Pragma("unroll") for (int n = 0; n < 2; ++n) _Pragma("unroll") for (int k = 0; k < 2; ++k) \
        acc[ai][bj][m][n] = __builtin_amdgcn_mfma_f32_16x16x32_bf16(Bt[n][k], At[m][k], acc[ai][bj][m][n], 0, 0, 0); __builtin_amdgcn_s_setprio(0); } while (0)
#define PG8_WAIT_V(n) asm volatile("s_waitcnt vmcnt(" #n ")" ::: "memory")
#define PG8_WAIT_L(n) asm volatile("s_waitcnt lgkmcnt(" #n ")" ::: "memory")
#define PG8_BAR __builtin_amdgcn_s_barrier()
#define PG8_SCHED __builtin_amdgcn_sched_barrier(0)
    Unit cur, nxt; int ui = 0;
    if (!S.next(0, cur)) return;
    f32x4 acc[2][2][4][2];
#pragma unroll
    for (int a = 0; a < 2; ++a)
#pragma unroll
        for (int b = 0; b < 2; ++b)
#pragma unroll
            for (int m = 0; m < 4; ++m)
#pragma unroll
                for (int n = 0; n < 2; ++n) acc[a][b][m][n] = (f32x4){0.f, 0.f, 0.f, 0.f};
    bf16x8 At[4][2], B0[2][2], B1[2][2];
    const char* cA = (const char*)g.A + (size_t)cur.pm * tstep; const char* cB = (const char*)g.Bt + (size_t)cur.pn * tstep;
    S.a_ready(cur);
    if constexpr (SP2) {
        PG8_STAGE(PG8_SB(0, 0), cB, voffB); PG8_STAGE(PG8_SB(0, 1), cB + hstep, voffB); PG8_STAGE(PG8_SA(0, 0), cA, voffA); PG8_STAGE(PG8_SA(0, 1), cA + hstep, voffA);
        if (wr == 1) PG8_BAR;
        PG8_WAIT_V(2); PG8_BAR;
        PG8_STAGE(PG8_SB(1, 0), cB + kstep, voffB); PG8_STAGE(PG8_SA(1, 0), cA + kstep, voffA); PG8_STAGE(PG8_SB(1, 1), cB + hstep + kstep, voffB);
        PG8_WAIT_V(6); PG8_BAR;
    } else {
        PG8_STAGE(PG8_SB(0, 0), cB, voffB); PG8_STAGE(PG8_SA(0, 0), cA, voffA); PG8_STAGE(PG8_SB(0, 1), cB + hstep, voffB); PG8_STAGE(PG8_SA(0, 1), cA + hstep, voffA);
        if (wr == 1) PG8_BAR;
        PG8_WAIT_V(4); PG8_BAR;
        PG8_STAGE(PG8_SB(1, 0), cB + kstep, voffB); PG8_STAGE(PG8_SA(1, 0), cA + kstep, voffA); PG8_STAGE(PG8_SB(1, 1), cB + hstep + kstep, voffB);
        PG8_WAIT_V(6); PG8_BAR;
    }
    for (;;) {
        const bool has_next = S.next(ui + 1, nxt);
        const char* nA = has_next ? (const char*)g.A + (size_t)nxt.pm * tstep : cA; const char* nB = has_next ? (const char*)g.Bt + (size_t)nxt.pn * tstep : cB;
        for (int t = 0; t < nt; t += 2) {
            const bool last = (t == nt - 2);
            const char* a1 = cA + (size_t)(t + 1) * kstep;
            const char* a2 = last ? nA : cA + (size_t)(t + 2) * kstep; const char* b2 = last ? nB : cB + (size_t)(t + 2) * kstep;
            const char* a3 = a2 + kstep; const char* b3 = b2 + kstep;
            if (last && has_next) S.a_ready(nxt);
            if constexpr (SP2) {
            PG8_LDB(B0, 0, 0); PG8_LDB(B1, 0, 1); PG8_SCHED; PG8_LDA(At, 0, 0); PG8_STAGE(PG8_SA(1, 1), a1 + hstep, voffA);
            PG8_WAIT_V(8); PG8_WAIT_L(0); PG8_BAR; PG8_MMA(0, 0, At, B0); PG8_MMA(0, 1, At, B1); PG8_BAR; PG8_SCHED;
            PG8_LDA(At, 0, 1); PG8_STAGE(PG8_SB(0, 0), b2, voffB); PG8_STAGE(PG8_SB(0, 1), b2 + hstep, voffB); PG8_STAGE(PG8_SA(0, 0), a2, voffA);
            PG8_WAIT_V(8); PG8_WAIT_L(0); PG8_BAR; PG8_MMA(1, 0, At, B0); PG8_MMA(1, 1, At, B1); PG8_BAR; PG8_SCHED;
            PG8_LDB(B0, 1, 0); PG8_LDB(B1, 1, 1); PG8_SCHED; PG8_LDA(At, 1, 0); PG8_STAGE(PG8_SA(0, 1), a2 + hstep, voffA);
            PG8_WAIT_V(8); PG8_WAIT_L(0); PG8_BAR; PG8_MMA(0, 0, At, B0); PG8_MMA(0, 1, At, B1); PG8_BAR; PG8_SCHED;
            PG8_LDA(At, 1, 1); PG8_STAGE(PG8_SB(1, 0), b3, voffB); PG8_STAGE(PG8_SB(1, 1), b3 + hstep, voffB); PG8_STAGE(PG8_SA(1, 0), a3, voffA);
            PG8_WAIT_V(8); PG8_WAIT_L(0); PG8_BAR; PG8_MMA(1, 0, At, B0); PG8_MMA(1, 1, At, B1); PG8_BAR; PG8_SCHED;
            } else {
            PG8_LDB(B0, 0, 0); PG8_SCHED; PG8_LDA(At, 0, 0); PG8_STAGE(PG8_SA(1, 1), a1 + hstep, voffA);
            PG8_WAIT_L(8); PG8_BAR; PG8_WAIT_L(0); PG8_MMA(0, 0, At, B0); PG8_BAR; PG8_SCHED;
            PG8_LDB(B1, 0, 1); PG8_STAGE(PG8_SB(0, 0), b2, voffB);
            PG8_BAR; PG8_WAIT_L(0); PG8_MMA(0, 1, At, B1); PG8_BAR;
            PG8_LDA(At, 0, 1); PG8_STAGE(PG8_SA(0, 0), a2, voffA);
            PG8_BAR; PG8_WAIT_L(0); PG8_MMA(1, 0, At, B0); PG8_BAR; PG8_SCHED;
            PG8_STAGE(PG8_SB(0, 1), b2 + hstep, voffB);
            PG8_WAIT_V(6); PG8_BAR; PG8_MMA(1, 1, At, B1); PG8_BAR;
            PG8_LDB(B0, 1, 0); PG8_SCHED; PG8_LDA(At, 1, 0); PG8_STAGE(PG8_SA(0, 1), a2 + hstep, voffA);
            PG8_WAIT_L(8); PG8_BAR; PG8_WAIT_L(0); PG8_MMA(0, 0, At, B0); PG8_BAR; PG8_SCHED;
            PG8_LDB(B1, 1, 1); PG8_STAGE(PG8_SB(1, 0), b3, voffB);
            PG8_BAR; PG8_WAIT_L(0); PG8_MMA(0, 1, At, B1); PG8_BAR;
            PG8_LDA(At, 1, 1); PG8_STAGE(PG8_SA(1, 0), a3, voffA);
            PG8_BAR; PG8_WAIT_L(0); PG8_MMA(1, 0, At, B0); PG8_BAR; PG8_SCHED;
            PG8_STAGE(PG8_SB(1, 1), b3 + hstep, voffB);
            PG8_WAIT_V(6); PG8_BAR; PG8_MMA(1, 1, At, B1); PG8_BAR;
            }
        }
        if constexpr (ALIGN_EPI) { if (wr == 0) PG8_BAR; }
        if constexpr (!Epi::AFTER_DRAIN) { E(acc, cur, wr, wc, fr, fq); S.done(cur, ui); }
        if (!has_next) break;
#pragma unroll
        for (int a = 0; a < 2; ++a)
#pragma unroll
            for (int b = 0; b < 2; ++b)
#pragma unroll
                for (int m = 0; m < 4; ++m)
#pragma unroll
                    for (int n = 0; n < 2; ++n) acc[a][b][m][n] = (f32x4){0.f, 0.f, 0.f, 0.f};
        cur = nxt; cA = nA; cB = nB; ++ui;
        if constexpr (ALIGN_EPI) { if (wr == 1) PG8_BAR; }
    }
    PG8_WAIT_V(0);
    if constexpr (!ALIGN_EPI) { if (wr == 0) PG8_BAR; }
    PG8_BAR;
    if constexpr (Epi::AFTER_DRAIN) { E.fused(acc, cur, wr, wc, fr, fq, lds, wid, lane); S.done(cur, ui); }
#undef PG8_SA
#undef PG8_SB
#undef PG8_STAGE
#undef PG8_LDA
#undef PG8_LDB
#undef PG8_MMA
#undef PG8_WAIT_V
#undef PG8_WAIT_L
#undef PG8_BAR
#undef PG8_SCHED
}
}

constexpr int D = 1024, M_CTX = 32 * 256, M_LAT = 8 * 4096, MT = M_CTX + M_LAT;
constexpr int L_CTX = 256, L_LAT = 4096, NB_CTX = 32, NB_LAT = 8;
constexpr int D_IN = 3840, D_A = 512, NH = 8, HD = 64;
constexpr int C_R = 0, C_K = 512, C_V = 1024, C_ZA = 1536, C_WD = 2048, C_AD = 2176, C_U = 2304, C_VB = 2816, C_ZB = 3328;
constexpr float NORM_EPS = 1e-6f, GN_EPS = 6.4e-4f;
constexpr size_t STATE_ELEMS = (size_t)NB_CTX * NH * HD * HD;

constexpr size_t MiB = 1u << 20;
constexpr size_t WS_CTL = 0, CTL_ZERO_BYTES = 192 * 1024;
constexpr size_t CW_QUEUE = 15 * 1024;
constexpr size_t WS_MOD = 64 * 1024;
constexpr size_t WS_WIN = 1 * MiB;
constexpr size_t WS_WOUT = 9 * MiB;
constexpr size_t WS_WSB = 11 * MiB;
constexpr size_t WS_BS = 12 * MiB;
constexpr size_t WS_H = 16 * MiB;
constexpr size_t WS_PROJ = 96 * MiB;
constexpr size_t WS_OUTB = WS_PROJ + 64 * MiB;
constexpr size_t WS_G = WS_PROJ + (size_t)MT * D_IN * 2;
constexpr size_t WS_HMID = WS_G + (size_t)128 * 2048 * 64 * 2;
constexpr size_t WS_CORR = WS_HMID + (size_t)128 * 4096 * 2;
constexpr size_t WS_END = WS_CORR + (size_t)M_LAT * 512 * 2;
static_assert((size_t)M_CTX * D_IN * 2 <= 64 * MiB && 64 * MiB + (size_t)MT * D * 2 <= (size_t)MT * D_IN * 2, "OUTB overlay");
static_assert(WS_WIN + (size_t)D_IN * D * 2 <= WS_WOUT && WS_BS + (size_t)2 * MT * 8 * 4 <= WS_H && WS_H + (size_t)MT * D * 2 <= WS_PROJ, "ws map");

constexpr int LDS_BYTES = 163840;
constexpr int NWAVES = 8, NTHREADS = 512;

#define LAS __attribute__((address_space(3)))
#define GAS __attribute__((address_space(1)))
typedef unsigned short bf16;
typedef float f32x4 __attribute__((ext_vector_type(4)));
typedef short bf16x8 __attribute__((ext_vector_type(8)));
typedef unsigned u32x4v __attribute__((ext_vector_type(4)));
typedef unsigned u32x2v __attribute__((ext_vector_type(2)));

__device__ __forceinline__ float bf2f(unsigned b) { return __uint_as_float(b << 16); }
__device__ __forceinline__ unsigned f2bf(float f) { unsigned u = __float_as_uint(f); return (u + 0x7fffu + ((u >> 16) & 1u)) >> 16; }
__device__ __forceinline__ unsigned pk2(float lo, float hi) { return f2bf(lo) | (f2bf(hi) << 16); }
template <int CTRL> __device__ __forceinline__ float dpp_f(float v) { return __int_as_float(__builtin_amdgcn_update_dpp(0, __float_as_int(v), CTRL, 0xf, 0xf, true)); }
__device__ __forceinline__ float quad_sum4(float v) { v += dpp_f<0xB1>(v); v += dpp_f<0x4E>(v); return v; }
__device__ __forceinline__ float wave_sum(float v) {
    v += dpp_f<0xB1>(v); v += dpp_f<0x4E>(v);
    v += dpp_f<0x141>(v); v += dpp_f<0x140>(v);
    v += __int_as_float(__builtin_amdgcn_ds_swizzle(__float_as_int(v), 0x401F));
    return __int_as_float(__builtin_amdgcn_readlane(__float_as_int(v), 0)) + __int_as_float(__builtin_amdgcn_readlane(__float_as_int(v), 32));
}
__device__ __forceinline__ float silu_f(float x) { return x * __builtin_amdgcn_rcpf(1.0f + __builtin_amdgcn_exp2f(-1.44269504f * x)); }
__device__ __forceinline__ float sigmoid_f(float x) { return 1.0f / (1.0f + __expf(-x)); }

struct Params { const float* in[26]; float* out; unsigned char* ws; int ph_lo, ph_hi; };

#ifdef PROBE_KA
constexpr size_t CW_TS = 48 * 1024;
__device__ __forceinline__ void ts_mark(int k) { if (threadIdx.x == 0) { const Params* q = (const Params*)__builtin_amdgcn_kernarg_segment_ptr(); asm volatile("" : "+s"(q));
    ((unsigned*)(q->ws + CW_TS))[blockIdx.x * 16 + k] = (unsigned)__builtin_amdgcn_s_memrealtime(); } }
#define TS(ws, k) ts_mark(k)
#else
#define TS(ws, k) do {} while (0)
#endif
enum { I_XP = 0, I_XS, I_C, I_SF, I_SB, I_CCTX, I_LNPRE, I_LNPOST, I_WMOD, I_BMOD, I_WIN, I_TSMU, I_W0, I_WUP, I_A0, I_AUP, I_KK, I_KA, I_RK, I_GNW, I_GNB, I_SLG, I_SLB, I_WS, I_BSS, I_WOUT };

__device__ __forceinline__ void transpose_item(const float* W, int K, int N, bf16* WT, LAS float* scr, int item, int lane) {
    const int nblk = N / 32, kb = item / nblk, nb = item % nblk, k0 = 64 * kb, n0 = 32 * nb;
    float tv[32];
#pragma unroll
    for (int i = 0; i < 32; ++i) tv[i] = ((const GAS float*)W)[(size_t)(k0 + 2 * i + (lane >> 5)) * N + n0 + (lane & 31)];
#pragma unroll
    for (int i = 0; i < 32; ++i) scr[(2 * i + (lane >> 5)) * 33 + (lane & 31)] = tv[i];
    asm volatile("s_waitcnt lgkmcnt(0)" ::: "memory");
    const int c = lane & 7;
#pragma unroll
    for (int j = 0; j < 4; ++j) { const int n = (lane >> 3) + 8 * j; const LAS float* s = scr + (8 * c) * 33 + n;
        u32x4v o; o.x = pk2(s[0 * 33], s[1 * 33]); o.y = pk2(s[2 * 33], s[3 * 33]); o.z = pk2(s[4 * 33], s[5 * 33]); o.w = pk2(s[6 * 33], s[7 * 33]);
        *(u32x4v*)(WT + (size_t)(n0 + n) * K + k0 + 8 * c) = o; }
    asm volatile("s_waitcnt lgkmcnt(0)" ::: "memory");
}

__device__ __forceinline__ void phase0(const Params& P, LAS unsigned char* lds, int gw, int NGW, int wave, int lane) {
    unsigned char* ws = P.ws;
    float* mod = (float*)(ws + WS_MOD);
    const float* w_mod = P.in[I_WMOD]; const float* b_mod = P.in[I_BMOD]; const float* cc = P.in[I_C]; const float* cctx = P.in[I_CCTX];
    if (blockIdx.x < 96 && gridDim.x >= 96) {
        const int cgp = blockIdx.x % 12, rg = blockIdx.x / 12, col = cgp * 256 + lane * 4, r0 = rg * 128 + wave * 16;
        f32x4 acc[9];
#pragma unroll
        for (int v = 0; v < 9; ++v) acc[v] = (f32x4){0.f, 0.f, 0.f, 0.f};
        f32x4 w[16];
#pragma unroll
        for (int i = 0; i < 16; ++i) w[i] = *(const GAS f32x4*)((const GAS float*)w_mod + (size_t)(r0 + i) * 3072 + col);
#pragma unroll
        for (int i = 0; i < 16; ++i) {
#pragma unroll
            for (int v = 0; v < 9; ++v) { const float cv = (v == 0) ? cctx[r0 + i] : cc[(v - 1) * 1024 + r0 + i]; acc[v] += silu_f(cv) * w[i]; }
        }
        LAS f32x4* red = (LAS f32x4*)lds;
#pragma unroll
        for (int v = 0; v < 9; ++v) red[(wave * 9 + v) * 64 + lane] = acc[v];
        __syncthreads();
        for (int idx = wave * 64 + lane; idx < 9 * 64; idx += 512) {
            f32x4 s = red[idx];
#pragma unroll
            for (int w2 = 1; w2 < 8; ++w2) s += red[w2 * 576 + idx];
            const int v = idx >> 6, l = idx & 63, c2 = cgp * 256 + l * 4;
            if (rg == 0) s += *(const f32x4*)(b_mod + c2);
#pragma unroll
            for (int e = 0; e < 4; ++e) atomicAdd(mod + v * 3072 + c2 + e, s[e]);
        }
        __syncthreads();
    } else if (gridDim.x < 96) {
        for (int task = gw; task < 12 * 64; task += NGW) {
            const int cgp = task % 12, rs = task / 12, col = cgp * 256 + lane * 4;
            f32x4 acc[9];
#pragma unroll
            for (int v = 0; v < 9; ++v) acc[v] = (f32x4){0.f, 0.f, 0.f, 0.f};
            for (int i = rs * 16; i < rs * 16 + 16; ++i) { const f32x4 w = *(const GAS f32x4*)((const GAS float*)w_mod + (size_t)i * 3072 + col);
#pragma unroll
                for (int v = 0; v < 9; ++v) { const float cv = (v == 0) ? cctx[i] : cc[(v - 1) * 1024 + i]; acc[v] += silu_f(cv) * w; } }
            if (rs == 0) { const f32x4 b = *(const f32x4*)(b_mod + col);
#pragma unroll
                for (int v = 0; v < 9; ++v) acc[v] += b; }
#pragma unroll
            for (int v = 0; v < 9; ++v)
#pragma unroll
                for (int e = 0; e < 4; ++e) atomicAdd(mod + v * 3072 + col + e, acc[v][e]);
        }
    }
}

__device__ __forceinline__ void weight_copies(const Params& P, LAS unsigned char* lds, int gw, int NGW, int wave, int lane) {
    unsigned char* ws = P.ws;
    LAS float* scr = (LAS float*)(lds + wave * 16384);
    constexpr int I_1 = (D / 64) * (D_IN / 32), I_2 = (D / 64) * (D / 32);
    for (int it = gw; it < I_1 + I_2; it += NGW) {
        if (it < I_1) transpose_item(P.in[I_WIN], D, D_IN, (bf16*)(ws + WS_WIN), scr, it, lane);
        else transpose_item(P.in[I_WOUT], D, D, (bf16*)(ws + WS_WOUT), scr, it - I_1, lane);
    }
    { const float* w_s = P.in[I_WS]; bf16* wsb = (bf16*)(ws + WS_WSB);
      for (int i = gw * 64 + lane; i < 8 * 128 * 128 / 4; i += NGW * 64) { const f32x4 v = *(const f32x4*)(w_s + (size_t)i * 4); u32x2v o; o.x = pk2(v[0], v[1]); o.y = pk2(v[2], v[3]); *(u32x2v*)(wsb + (size_t)i * 4) = o; } }
}


__device__ __forceinline__ const GAS float* x_row(const Params& P, int m) { return (const GAS float*)(m < M_CTX ? P.in[I_XP] + (size_t)m * D : P.in[I_XS] + (size_t)(m - M_CTX) * D); }
__device__ __forceinline__ int mod_index(int m) { return m < M_CTX ? 0 : 1 + (m - M_CTX) / L_LAT; }

__device__ __forceinline__ void prenorm_rows(const Params& P, int m0, int nrows, int lane, const f32x4 (&gs)[4], const f32x4 (&sh)[4]) {
    f32x4 vn[4];
    { const GAS f32x4* xr = (const GAS f32x4*)x_row(P, m0) + lane;
#pragma unroll
      for (int j = 0; j < 4; ++j) vn[j] = xr[64 * j]; }
#pragma unroll 1
    for (int r = 0; r < nrows; ++r) {
        const int m = m0 + r;
        f32x4 v[4];
#pragma unroll
        for (int j = 0; j < 4; ++j) v[j] = vn[j];
        if (r + 1 < nrows) { const GAS f32x4* xr = (const GAS f32x4*)x_row(P, m + 1) + lane;
#pragma unroll
            for (int j = 0; j < 4; ++j) vn[j] = xr[64 * j]; }
        float ss = 0.f;
#pragma unroll
        for (int j = 0; j < 4; ++j) ss += (v[j].x * v[j].x + v[j].y * v[j].y) + (v[j].z * v[j].z + v[j].w * v[j].w);
        const float rstd = 1.0f / sqrtf(wave_sum(ss) * (1.0f / D) + NORM_EPS);
        GAS u32x2v* o8 = (GAS u32x2v*)((GAS bf16*)(P.ws + WS_H) + (size_t)m * D) + lane;
#pragma unroll
        for (int j = 0; j < 4; ++j) { const f32x4 o = v[j] * rstd * gs[j] + sh[j]; u32x2v w; w.x = pg8::cvt_pk_bf16(o.x, o.y); w.y = pg8::cvt_pk_bf16(o.z, o.w); o8[64 * j] = w; }
    }
}
__device__ __forceinline__ void prenorm_mod(const Params& P, int seg, int lane, f32x4 (&gs)[4], f32x4 (&sh)[4]) {
    const GAS float* mod = (const GAS float*)(P.ws + WS_MOD); const GAS float* ln_pre = (const GAS float*)P.in[I_LNPRE];
    const GAS float* shift = mod + seg * 3072; const GAS float* scale = shift + 1024;
#pragma unroll
    for (int j = 0; j < 4; ++j) { const int col = 4 * (lane + 64 * j); gs[j] = *(const GAS f32x4*)(ln_pre + col) * (1.0f + *(const GAS f32x4*)(scale + col)); sh[j] = *(const GAS f32x4*)(shift + col); }
}
__device__ __forceinline__ void phase1(const Params& P, int gw, int NGW, int lane) {
    const GAS float* mod = (const GAS float*)(P.ws + WS_MOD); const GAS float* ln_pre = (const GAS float*)P.in[I_LNPRE]; GAS bf16* H = (GAS bf16*)(P.ws + WS_H);
#pragma unroll 1
    for (int seg = 0; seg < 9; ++seg) {
        const int m_lo = (seg == 0) ? 0 : M_CTX + (seg - 1) * L_LAT, m_hi = (seg == 0) ? M_CTX : m_lo + L_LAT;
        const GAS float* shift = mod + seg * 3072; const GAS float* scale = shift + 1024;
        f32x4 gs[4], sh[4];
#pragma unroll
        for (int j = 0; j < 4; ++j) { const int col = 4 * (lane + 64 * j); gs[j] = *(const GAS f32x4*)(ln_pre + col) * (1.0f + *(const GAS f32x4*)(scale + col)); sh[j] = *(const GAS f32x4*)(shift + col); }
        for (int m = m_lo + gw; m < m_hi; m += NGW) {
            const GAS f32x4* xr = (const GAS f32x4*)x_row(P, m) + lane;
            f32x4 v[4]; float ss = 0.f;
#pragma unroll
            for (int j = 0; j < 4; ++j) { v[j] = xr[64 * j]; ss += (v[j].x * v[j].x + v[j].y * v[j].y) + (v[j].z * v[j].z + v[j].w * v[j].w); }
            const float rstd = 1.0f / sqrtf(wave_sum(ss) * (1.0f / D) + NORM_EPS);
            GAS u32x2v* o8 = (GAS u32x2v*)(H + (size_t)m * D) + lane;
#pragma unroll
            for (int j = 0; j < 4; ++j) { const f32x4 o = v[j] * rstd * gs[j] + sh[j]; u32x2v w; w.x = pk2(o.x, o.y); w.y = pk2(o.z, o.w); o8[64 * j] = w; }
        }
    }
}

constexpr int CH_RKV_LD = 200, CH_TW_LD = 72, CH_I1_LD = 72, CH_I2_LD = 40, CH_G_LD = 40;
constexpr int CH_RKV = 0, CH_TW = 26400, CH_AD = 35616, CH_WUPT = 44832, CH_AUPT = 54048, CH_IMG = 63264, CH_IMG_STRIDE = 30720;
constexpr int CH_GRAM_STRIDE = 17920;
constexpr int CH_HF = 124704, CH_N2 = 141088, CH_EC = 141344, CH_BPART = 141856, CH_KTAB = 142880, CH_HF2 = 143648, CH_END = 160032;
static_assert(2 * CH_GRAM_STRIDE <= CH_WUPT && CH_IMG + 2 * CH_IMG_STRIDE == CH_HF && CH_END <= LDS_BYTES - 64, "chain LDS map");

typedef unsigned short us4 __attribute__((ext_vector_type(4)));
#define MFMA16(a, b, c) __builtin_amdgcn_mfma_f32_16x16x32_bf16((a), (b), (c), 0, 0, 0)
__device__ __forceinline__ bf16x8 ldfrag(const LAS bf16* img, int ld, int row0, int k0, int lane) { return *(const LAS bf16x8*)(img + (row0 + (lane & 15)) * ld + k0 + 8 * (lane >> 4)); }
typedef float f32x2c __attribute__((ext_vector_type(2)));
typedef __bf16 bf16x2c __attribute__((ext_vector_type(2)));
__device__ __forceinline__ unsigned cvtpk(float lo, float hi) { f32x2c v; v.x = lo; v.y = hi; return __builtin_bit_cast(unsigned, __builtin_convertvector(v, bf16x2c)); }
__device__ __forceinline__ void st_nm(LAS bf16* img, int ld, int n0, int m0, f32x4 c, int lane) {
    u32x2v o; o.x = cvtpk(c[0], c[1]); o.y = cvtpk(c[2], c[3]); *(LAS u32x2v*)(img + (n0 + (lane & 15)) * ld + m0 + 4 * (lane >> 4)) = o; }
__device__ __forceinline__ void st_mn(LAS bf16* img, int ld, int m0, int n0, f32x4 c, int lane) {
#pragma unroll
    for (int e = 0; e < 4; e += 2) { const unsigned w = cvtpk(c[e], c[e + 1]); LAS bf16* p = img + (m0 + 4 * (lane >> 4) + e) * ld + n0 + (lane & 15); p[0] = (bf16)(w & 0xffffu); p[ld] = (bf16)(w >> 16); } }
__device__ __forceinline__ float fast_sigmoid(float x) { return __builtin_amdgcn_rcpf(1.0f + __builtin_amdgcn_exp2f(-1.44269504f * x)); }
__device__ __forceinline__ float fast_tanh(float x) { return 1.0f - 2.0f * __builtin_amdgcn_rcpf(1.0f + __builtin_amdgcn_exp2f(2.88539008f * x)); }
__device__ __forceinline__ float row16_sum(float v) { v += dpp_f<0xB1>(v); v += dpp_f<0x4E>(v); v += dpp_f<0x141>(v); v += dpp_f<0x140>(v); return v; }
__device__ __forceinline__ float oct_sum(float v) { v += dpp_f<0xB1>(v); v += dpp_f<0x4E>(v); v += dpp_f<0x141>(v); return v; }

typedef short bf16x4 __attribute__((ext_vector_type(4)));
#define MF16(a, b, c) __builtin_amdgcn_mfma_f32_16x16x16bf16_1k((a), (b), (c), 0, 0, 0)
__device__ __forceinline__ bf16x4 frag4(f32x4 c) { u32x2v o; o.x = cvtpk(c[0], c[1]); o.y = cvtpk(c[2], c[3]); return __builtin_bit_cast(bf16x4, o); }
__device__ __forceinline__ bf16x4 ldfrag4(const LAS bf16* img, int ld, int row0, int k0, int lane) { return *(const LAS bf16x4*)(img + (row0 + (lane & 15)) * ld + k0 + 4 * (lane >> 4)); }
typedef short s16x4c __attribute__((ext_vector_type(4)));
__device__ __forceinline__ bf16x8 ldfrag_tr(const LAS bf16* img, int ld, int col0, int k0, int lane) {
    const LAS bf16* p = img + (k0 + 8 * (lane >> 4) + ((lane & 15) >> 2)) * ld + col0 + 4 * (lane & 3);
    const s16x4c lo = __builtin_amdgcn_ds_read_tr16_b64_v4i16((LAS s16x4c*)p), hi = __builtin_amdgcn_ds_read_tr16_b64_v4i16((LAS s16x4c*)(p + 4 * ld));
    return (bf16x8){lo[0], lo[1], lo[2], lo[3], hi[0], hi[1], hi[2], hi[3]}; }
__device__ __forceinline__ bf16x4 ldfrag4_tr(const LAS bf16* img, int ld, int col0, int k0, int lane) {
    const LAS bf16* p = img + (k0 + 4 * (lane >> 4) + ((lane & 15) >> 2)) * ld + col0 + 4 * (lane & 3);
    return __builtin_bit_cast(bf16x4, __builtin_amdgcn_ds_read_tr16_b64_v4i16((LAS s16x4c*)p)); }
#define OPQ(v) asm volatile("" : "+v"(v))
struct RawRegs { u32x4v v[6]; };
__device__ __forceinline__ void chain_prefetch(RawRegs& R, const GAS bf16* proj, int m0, int L, int h, int dir, int ss, int tid, int p0) {
    OPQ(tid);
    const int qm = tid >> 3, pc = tid & 7, p = p0 + ss * 64 + qm, t = dir ? (L - 1 - p) : p;
    const GAS bf16* row = proj + (size_t)(m0 + t) * D_IN;
#pragma unroll
    for (int x = 0; x < 3; ++x) R.v[x] = *(const GAS u32x4v*)(row + x * 512 + h * 64 + pc * 8);
    R.v[4] = *(const GAS u32x4v*)(row + C_WD + dir * 64 + pc * 8);
    R.v[5] = *(const GAS u32x4v*)(row + C_AD + dir * 64 + pc * 8);
    u32x4v hv = (u32x4v){0u, 0u, 0u, 0u};
    if (tid < 48) { const int hi = tid >= 24, rem = hi ? tid - 24 : tid, x = rem >> 3, pc2 = rem & 7, ph = hi ? p0 + ss * 64 + 64 : p0 + ss * 64 - 1;
        if (ph >= 0 && ph < L) { const int th = dir ? (L - 1 - ph) : ph; hv = *(const GAS u32x4v*)(proj + (size_t)(m0 + th) * D_IN + x * 512 + h * 64 + pc2 * 8); } }
    R.v[3] = hv;
}
__device__ __forceinline__ void chain_stage_raw(const RawRegs& R, LAS unsigned char* lds, int tid) {
    OPQ(tid);
    const int qm = tid >> 3, pc = tid & 7;
#pragma unroll
    for (int x = 0; x < 3; ++x) *(LAS u32x4v*)(lds + CH_RKV + ((qm + 1) * CH_RKV_LD + x * 64 + pc * 8) * 2) = R.v[x];
    if (tid < 48) { const int hi = tid >= 24, rem = hi ? tid - 24 : tid, x = rem >> 3, pc2 = rem & 7;
        *(LAS u32x4v*)(lds + CH_RKV + ((hi ? 65 : 0) * CH_RKV_LD + x * 64 + pc2 * 8) * 2) = R.v[3]; }
    *(LAS u32x4v*)(lds + CH_TW + (qm * CH_TW_LD + pc * 8) * 2) = R.v[4];
    *(LAS u32x4v*)(lds + CH_AD + (qm * CH_TW_LD + pc * 8) * 2) = R.v[5];
}

__device__ __forceinline__ void do_chain(const Params& P, LAS unsigned char* lds, int m0, int L, int h, int dir, const float* s0, float* sfin, int p0, int npt, int mode, int chain) {
    const int tid = threadIdx.x, lane0 = tid & 63, wave = __builtin_amdgcn_readfirstlane(tid >> 6);
    const int grp = wave >> 2, cc = wave & 3;
#define STAGE_LANE() int ln_ = lane0; OPQ(ln_); const int lane = ln_, lr = lane & 15, lg = lane >> 4, c = 16 * cc + lr, vcol = c; (void)lr; (void)lg; (void)c; (void)vcol
    const GAS bf16* proj = (const GAS bf16*)(P.ws + WS_PROJ);
    GAS bf16* YD = (GAS bf16*)P.out; GAS float* BS = (GAS float*)(P.ws + WS_BS);
    const int nss = npt / 64;
    const int cj = h * 64 + 16 * cc + (lane0 & 15);
    const GAS float* ts_mu = (const GAS float*)P.in[I_TSMU];
    const float mlo_r = ts_mu[(dir ? 1536 : 0) + C_R + cj], mhi_r = ts_mu[(dir ? 0 : 1536) + C_R + cj];
    const float mlo_k = ts_mu[(dir ? 1536 : 0) + C_K + cj], mhi_k = ts_mu[(dir ? 0 : 1536) + C_K + cj];
    const float mlo_v = ts_mu[(dir ? 1536 : 0) + C_V + cj], mhi_v = ts_mu[(dir ? 0 : 1536) + C_V + cj];
    const float mc_r = 1.0f - mlo_r - mhi_r, mc_k = 1.0f - mlo_k - mhi_k, mc_v = 1.0f - mlo_v - mhi_v;
    const float w0c = -1.44269504f * ((const GAS float*)P.in[I_W0])[dir * 512 + cj], a0c = -1.44269504f * ((const GAS float*)P.in[I_A0])[dir * 512 + cj];
    const float kkc = ((const GAS float*)P.in[I_KK])[dir * 512 + cj], kac = ((const GAS float*)P.in[I_KA])[dir * 512 + cj], rkc = ((const GAS float*)P.in[I_RK])[dir * 512 + cj], kac1 = 1.0f - kac;
    LAS float* ktab = (LAS float*)(lds + CH_KTAB);
    if (tid < 64) { const int c8 = h * 64 + tid; ktab[tid] = ((const GAS float*)P.in[I_KK])[dir * 512 + c8]; ktab[64 + tid] = ts_mu[(dir ? 1536 : 0) + C_K + c8]; ktab[128 + tid] = ts_mu[(dir ? 0 : 1536) + C_K + c8]; }
    { LAS bf16* wupt = (LAS bf16*)(lds + CH_WUPT); LAS bf16* aupt = (LAS bf16*)(lds + CH_AUPT);
      const GAS float* wu = (const GAS float*)P.in[I_WUP] + (size_t)dir * 64 * 512 + h * 64; const GAS float* au = (const GAS float*)P.in[I_AUP] + (size_t)dir * 64 * 512 + h * 64;
#pragma unroll 1
      for (int kb = 0; kb < 2; ++kb) { float wv[4], av[4];
#pragma unroll
          for (int k = 0; k < 4; ++k) { const int idx = tid + 512 * (4 * kb + k), i = idx >> 6, c2 = idx & 63; wv[k] = wu[(size_t)i * 512 + c2]; av[k] = au[(size_t)i * 512 + c2]; }
#pragma unroll
          for (int k = 0; k < 4; ++k) { const int idx = tid + 512 * (4 * kb + k), i = idx >> 6, c2 = idx & 63; wupt[c2 * CH_TW_LD + i] = (bf16)f2bf(wv[k]); aupt[c2 * CH_TW_LD + i] = (bf16)f2bf(av[k]); } } }
    if (grp == 0) { STAGE_LANE(); LAS f32x4* hf = (LAS f32x4*)(lds + CH_HF) + cc * 256 + lane;
#pragma unroll
        for (int mt = 0; mt < 4; ++mt) hf[64 * mt] = s0 ? *(const f32x4*)(s0 + vcol * 64 + 16 * mt + 4 * lg) : (f32x4){0.f, 0.f, 0.f, 0.f};
        if (mode == 2) { LAS f32x4* hf2 = (LAS f32x4*)(lds + CH_HF2) + cc * 256 + lane;
#pragma unroll
            for (int mt = 0; mt < 4; ++mt) { f32x4 id;
#pragma unroll
                for (int e = 0; e < 4; ++e) id[e] = (mt == cc && lr == 4 * lg + e) ? 1.f : 0.f;
                hf2[64 * mt] = id; } }
    }
    RawRegs RR;
    chain_prefetch(RR, proj, m0, L, h, dir, 0, tid, p0);
    chain_stage_raw(RR, lds, tid);
    __syncthreads();
    LAS unsigned char* img = lds + CH_IMG + grp * CH_IMG_STRIDE;
    LAS bf16* I2_A = (LAS bf16*)(img), *I2_B = (LAS bf16*)(img + 5120), *I2_K = (LAS bf16*)(img + 10240), *I2_V = (LAS bf16*)(img + 15360), *I2_R = (LAS bf16*)(img + 20480), *I2_Q = (LAS bf16*)(img + 25600);
    LAS unsigned char* gram = lds + grp * CH_GRAM_STRIDE;
    LAS bf16* GX = (LAS bf16*)(gram), *GXT = (LAS bf16*)(gram + 2560), *GYT = (LAS bf16*)(gram + 5120), *GT = (LAS bf16*)(gram + 7680);
    LAS bf16* GLAK = (LAS bf16*)(gram + 10240), *GMRB = (LAS bf16*)(gram + 12800), *GMRK = (LAS bf16*)(gram + 15360);
    LAS float* n2s = (LAS float*)(lds + CH_N2); LAS float* ecs = (LAS float*)(lds + CH_EC); LAS float* bpart = (LAS float*)(lds + CH_BPART);
    const LAS bf16* rkv = (const LAS bf16*)(lds + CH_RKV);
    const f32x4 z4 = (f32x4){0.f, 0.f, 0.f, 0.f};

    for (int ss = 0; ss < nss; ++ss) {
        { STAGE_LANE(); const int tk = lane >> 3, cg = lane & 7, q = 8 * wave + tk + 1;
          const LAS bf16* kp = rkv + q * CH_RKV_LD + 64 + 8 * cg;
          const u32x4v lo = *(const LAS u32x4v*)(kp - CH_RKV_LD), mi = *(const LAS u32x4v*)kp, hi = *(const LAS u32x4v*)(kp + CH_RKV_LD);
          float s = 0.f;
#pragma unroll
          for (int hh2 = 0; hh2 < 2; ++hh2) { const f32x4 ckk = *(const LAS f32x4*)(ktab + 8 * cg + 4 * hh2), clo = *(const LAS f32x4*)(ktab + 64 + 8 * cg + 4 * hh2), chi = *(const LAS f32x4*)(ktab + 128 + 8 * cg + 4 * hh2);
#pragma unroll
              for (int e2 = 0; e2 < 4; ++e2) { const int e = 4 * hh2 + e2; const unsigned sh = (e & 1) ? 16u : 0u; const float kl = bf2f((lo[e >> 1] >> sh) & 0xffffu), kc = bf2f((mi[e >> 1] >> sh) & 0xffffu), kh = bf2f((hi[e >> 1] >> sh) & 0xffffu);
                  const float k = (kc + clo[e2] * (kl - kc) + chi[e2] * (kh - kc)) * ckk[e2]; s += k * k; } }
          s = oct_sum(s);
          if (cg == 0) n2s[8 * wave + tk] = __builtin_amdgcn_rsqf(s + 1e-12f); }
        f32x4 wl[2], al[2];
        { STAGE_LANE(); const LAS bf16* tw = (const LAS bf16*)(lds + CH_TW); const LAS bf16* ad = (const LAS bf16*)(lds + CH_AD);
          const LAS bf16* wupt = (const LAS bf16*)(lds + CH_WUPT); const LAS bf16* aupt = (const LAS bf16*)(lds + CH_AUPT);
#pragma unroll
          for (int tt = 0; tt < 2; ++tt) { wl[tt] = z4; al[tt] = z4;
#pragma unroll
              for (int ks = 0; ks < 2; ++ks) {
                  wl[tt] = MFMA16(ldfrag(tw, CH_TW_LD, 32 * grp + 16 * tt, 32 * ks, lane), ldfrag(wupt, CH_TW_LD, 16 * cc, 32 * ks, lane), wl[tt]);
                  al[tt] = MFMA16(ldfrag(ad, CH_TW_LD, 32 * grp + 16 * tt, 32 * ks, lane), ldfrag(aupt, CH_TW_LD, 16 * cc, 32 * ks, lane), al[tt]); } } }
        __syncthreads();
        { STAGE_LANE(); float lw[2][4];
#pragma unroll
          for (int tt = 0; tt < 2; ++tt)
#pragma unroll
              for (int e = 0; e < 4; ++e) lw[tt][e] = -0.87506130f * __builtin_amdgcn_rcpf(1.0f + __builtin_amdgcn_exp2f(__builtin_fmaf(wl[tt][e], -1.44269504f, w0c)));
          float gin[2][4], run[2];
#pragma unroll
          for (int tt = 0; tt < 2; ++tt) { gin[tt][0] = lw[tt][0]; gin[tt][1] = gin[tt][0] + lw[tt][1]; gin[tt][2] = gin[tt][1] + lw[tt][2]; gin[tt][3] = gin[tt][2] + lw[tt][3]; run[tt] = gin[tt][3]; }
          float off[2], tot0;
          { float r1 = run[0]; float t1 = __shfl_up(r1, 16); if (lg >= 1) r1 += t1; float t2 = __shfl_up(r1, 32); if (lg >= 2) r1 += t2; off[0] = r1 - run[0]; tot0 = __shfl(r1, 48 + lr); }
          { float r1 = run[1]; float t1 = __shfl_up(r1, 16); if (lg >= 1) r1 += t1; float t2 = __shfl_up(r1, 32); if (lg >= 2) r1 += t2; off[1] = r1 - run[1] + tot0;
            const float tot = __shfl(r1, 48 + lr) + tot0; if (lg == 0) ecs[grp * 64 + c] = __builtin_amdgcn_exp2f(tot); }
#pragma unroll
          for (int tt = 0; tt < 2; ++tt) {
              const int q0 = 32 * grp + 16 * tt + 4 * lg;
              float xr[6], xk[6], xv[6];
              { const LAS bf16* tp = rkv + (q0 + (lr >> 2)) * CH_RKV_LD + 16 * cc + 4 * (lr & 3);
#pragma unroll
                for (int x = 0; x < 3; ++x) { const s16x4c lo = __builtin_amdgcn_ds_read_tr16_b64_v4i16((LAS s16x4c*)(tp + 64 * x)), hi = __builtin_amdgcn_ds_read_tr16_b64_v4i16((LAS s16x4c*)(tp + 64 * x + 4 * CH_RKV_LD));
                    float* dst = (x == 0) ? xr : (x == 1) ? xk : xv;
#pragma unroll
                    for (int e = 0; e < 4; ++e) dst[e] = bf2f((unsigned)(unsigned short)lo[e]);
                    dst[4] = bf2f((unsigned)(unsigned short)hi[0]); dst[5] = bf2f((unsigned)(unsigned short)hi[1]); } }
              const f32x4 n2 = *(const LAS f32x4*)(n2s + 32 * grp + 16 * tt + 4 * lg);
              f32x4 fa, fb, fk, fr, fv; float exprev = 1.f;
#pragma unroll
              for (int e = 0; e < 4; ++e) {
                  const float r = mc_r * xr[e + 1] + mlo_r * xr[e] + mhi_r * xr[e + 2];
                  const float k = mc_k * xk[e + 1] + mlo_k * xk[e] + mhi_k * xk[e + 2];
                  const float v = mc_v * xv[e + 1] + mlo_v * xv[e] + mhi_v * xv[e + 2];
                  const float a = __builtin_amdgcn_rcpf(1.0f + __builtin_amdgcn_exp2f(__builtin_fmaf(al[tt][e], -1.44269504f, a0c)));
                  const float kk = k * kkc * n2[e];
                  const float kdv = k * __builtin_fmaf(a, kac, kac1);
                  const float g = gin[tt][e] + off[tt];
                  const float ex = __builtin_amdgcn_exp2f(g), ie = __builtin_amdgcn_exp2f(-g), ep = (e == 0) ? __builtin_amdgcn_exp2f(g - lw[tt][e]) : exprev; exprev = ex;
                  fa[e] = -kk * ep; fb[e] = kk * a * ie; fk[e] = kdv * ie; fr[e] = r * ex; fv[e] = v; }
              const f32x4 fq = fr * rkc;
              const int t0 = 16 * tt + 4 * lg;
              u32x2v oa, ob, ok, orr, ov, oq; oq.x = cvtpk(fq[0], fq[1]); oq.y = cvtpk(fq[2], fq[3]);
              oa.x = cvtpk(fa[0], fa[1]); oa.y = cvtpk(fa[2], fa[3]); ob.x = cvtpk(fb[0], fb[1]); ob.y = cvtpk(fb[2], fb[3]); ok.x = cvtpk(fk[0], fk[1]); ok.y = cvtpk(fk[2], fk[3]);
              orr.x = cvtpk(fr[0], fr[1]); orr.y = cvtpk(fr[2], fr[3]); ov.x = cvtpk(fv[0], fv[1]); ov.y = cvtpk(fv[2], fv[3]);
              *(LAS u32x2v*)(I2_A + c * CH_I2_LD + t0) = oa; *(LAS u32x2v*)(I2_B + c * CH_I2_LD + t0) = ob; *(LAS u32x2v*)(I2_K + c * CH_I2_LD + t0) = ok; *(LAS u32x2v*)(I2_V + c * CH_I2_LD + t0) = ov; *(LAS u32x2v*)(I2_R + c * CH_I2_LD + t0) = orr; *(LAS u32x2v*)(I2_Q + c * CH_I2_LD + t0) = oq;
          } }
        __syncthreads();
        f32x4 kv[4];
        { STAGE_LANE();
          if (cc != 0) { const bf16x8 vb = ldfrag(I2_V, CH_I2_LD, 16 * cc, 0, lane);
#pragma unroll
            for (int mt = 0; mt < 4; ++mt) kv[mt] = MFMA16(ldfrag(I2_K, CH_I2_LD, 16 * mt, 0, lane), vb, z4); }
          if (cc != 0) {
              const LAS bf16* GA = (cc < 2) ? I2_A : I2_R; const LAS bf16* GB = (cc & 1) ? I2_K : I2_B;
              f32x4 g00 = z4, g10 = z4, g11 = z4;
              bf16x8 fa[2][2], fb[2][2];
#pragma unroll
              for (int ks = 0; ks < 2; ++ks) { fa[ks][0] = ldfrag_tr(GA, CH_I2_LD, 0, 32 * ks, lane); fa[ks][1] = ldfrag_tr(GA, CH_I2_LD, 16, 32 * ks, lane); fb[ks][0] = ldfrag_tr(GB, CH_I2_LD, 0, 32 * ks, lane); fb[ks][1] = ldfrag_tr(GB, CH_I2_LD, 16, 32 * ks, lane); }
#pragma unroll
              for (int ks = 0; ks < 2; ++ks) { g00 = MFMA16(fa[ks][0], fb[ks][0], g00); g10 = MFMA16(fa[ks][1], fb[ks][0], g10); g11 = MFMA16(fa[ks][1], fb[ks][1], g11); }
              const bool strict = cc < 2;
#pragma unroll
              for (int e = 0; e < 4; ++e) { const int m = 4 * lg + e; const bool keep = strict ? (lr < m) : (lr <= m); g00[e] = keep ? g00[e] : 0.f; g11[e] = keep ? g11[e] : 0.f; }
              if (cc == 3) {
                  f32x4 d0 = z4, d1 = z4;
#pragma unroll
                  for (int ks = 0; ks < 2; ++ks) { d0 = MFMA16(ldfrag_tr(I2_Q, CH_I2_LD, 0, 32 * ks, lane), ldfrag_tr(I2_K, CH_I2_LD, 0, 32 * ks, lane), d0);
                      d1 = MFMA16(ldfrag_tr(I2_Q, CH_I2_LD, 16, 32 * ks, lane), ldfrag_tr(I2_K, CH_I2_LD, 16, 32 * ks, lane), d1); }
                  if ((lr >> 2) == lg) { const int e = lr & 3; const float b0 = (e == 0) ? d0[0] : (e == 1) ? d0[1] : (e == 2) ? d0[2] : d0[3], b1 = (e == 0) ? d1[0] : (e == 1) ? d1[1] : (e == 2) ? d1[2] : d1[3];
                      const int p = p0 + ss * 64 + 32 * grp + lr, t = dir ? (L - 1 - p) : p, t2 = dir ? (t - 16) : (t + 16);
                      BS[((size_t)dir * MT + m0 + t) * 8 + h] = b0; BS[((size_t)dir * MT + m0 + t2) * 8 + h] = b1; }
              }
              LAS bf16* dst = (cc == 1) ? GLAK : (cc == 2) ? GMRB : GMRK;
              st_mn(dst, CH_G_LD, 0, 0, g00, lane); st_mn(dst, CH_G_LD, 16, 0, g10, lane); st_mn(dst, CH_G_LD, 16, 16, g11, lane); st_mn(dst, CH_G_LD, 0, 16, z4, lane);
          } else {
              f32x4 x00 = z4, x11 = z4, t00 = z4, t01 = z4, t11 = z4;
              { bf16x8 fa[2][2], fb[2][2];
#pragma unroll
                for (int ks = 0; ks < 2; ++ks) { fa[ks][0] = ldfrag_tr(I2_A, CH_I2_LD, 0, 32 * ks, lane); fa[ks][1] = ldfrag_tr(I2_A, CH_I2_LD, 16, 32 * ks, lane); fb[ks][0] = ldfrag_tr(I2_B, CH_I2_LD, 0, 32 * ks, lane); fb[ks][1] = ldfrag_tr(I2_B, CH_I2_LD, 16, 32 * ks, lane); }
#pragma unroll
                for (int ks = 0; ks < 2; ++ks) { x00 = MFMA16(fa[ks][0], fb[ks][0], x00); x11 = MFMA16(fa[ks][1], fb[ks][1], x11);
                    t00 = MFMA16(fb[ks][0], fa[ks][0], t00); t01 = MFMA16(fb[ks][0], fa[ks][1], t01); t11 = MFMA16(fb[ks][1], fa[ks][1], t11); } }
              f32x4 y00, y10, y11, yt11;
#pragma unroll
              for (int e = 0; e < 4; ++e) { const int m = 4 * lg + e; x00[e] = (lr < m) ? x00[e] : 0.f; x11[e] = (lr < m) ? x11[e] : 0.f; t00[e] = (m < lr) ? t00[e] : 0.f; t11[e] = (m < lr) ? t11[e] : 0.f; y00[e] = (lr == m) ? 1.f : 0.f; }
              y11 = y00; yt11 = y00;
#pragma unroll 1
              for (int lev = 0; lev < 4; ++lev) {
                  const bf16x4 fx00 = frag4(x00), fx11 = frag4(x11), ft00 = frag4(t00), ft11 = frag4(t11), fy00 = frag4(y00), fy11 = frag4(y11);
                  y00 = MF16(ft00, fy00, y00); y11 = MF16(ft11, fy11, y11); yt11 = MF16(fy11, ft11, yt11);
                  if (lev < 3) { const f32x4 n00 = MF16(ft00, fx00, z4), n11 = MF16(ft11, fx11, z4), m00 = MF16(fx00, ft00, z4), m11 = MF16(fx11, ft11, z4);
                      x00 = n00; x11 = n11; t00 = m00; t11 = m11; }
              }
              { const f32x4 zz = MF16(frag4(t01), frag4(y00), z4);
                y10 = MF16(frag4(yt11), frag4(zz), z4); }
              st_mn(GT, CH_G_LD, 0, 0, y00, lane); st_mn(GT, CH_G_LD, 16, 0, y10, lane); st_mn(GT, CH_G_LD, 16, 16, y11, lane); st_mn(GT, CH_G_LD, 0, 16, z4, lane);
              { const bf16x8 vb = ldfrag(I2_V, CH_I2_LD, 16 * cc, 0, lane);
#pragma unroll
                for (int mt = 0; mt < 4; ++mt) kv[mt] = MFMA16(ldfrag(I2_K, CH_I2_LD, 16 * mt, 0, lane), vb, z4); }
          } }
        if (ss + 1 < nss) chain_prefetch(RR, proj, m0, L, h, dir, ss + 1, tid, p0);
        __syncthreads();
        f32x4 y0[2], u0[2]; bf16x4 apf[2][4];
        { STAGE_LANE(); const bf16x8 vb = ldfrag(I2_V, CH_I2_LD, 16 * cc, 0, lane);
          const f32x4 w0 = MFMA16(ldfrag(GLAK, CH_G_LD, 0, 0, lane), vb, z4), w1 = MFMA16(ldfrag(GLAK, CH_G_LD, 16, 0, lane), vb, z4);
          y0[0] = MFMA16(ldfrag(GMRK, CH_G_LD, 0, 0, lane), vb, z4); y0[1] = MFMA16(ldfrag(GMRK, CH_G_LD, 16, 0, lane), vb, z4);
          { const bf16x8 ta0 = ldfrag(GT, CH_G_LD, 0, 0, lane), ta1 = ldfrag(GT, CH_G_LD, 16, 0, lane);
#pragma unroll
            for (int mt = 0; mt < 4; ++mt) { const bf16x8 at = ldfrag(I2_A, CH_I2_LD, 16 * mt, 0, lane); apf[0][mt] = frag4(MFMA16(at, ta0, z4)); apf[1][mt] = frag4(MFMA16(at, ta1, z4)); } }
          const bf16x4 fw0 = frag4(w0), fw1 = frag4(w1);
          u0[0] = MF16(ldfrag4(GT, CH_G_LD, 0, 0, lane), fw0, z4);
          u0[1] = MF16(ldfrag4(GT, CH_G_LD, 16, 16, lane), fw1, MF16(ldfrag4(GT, CH_G_LD, 16, 0, lane), fw0, z4)); }
        { STAGE_LANE(); LAS f32x4* hf = (LAS f32x4*)(lds + CH_HF) + cc * 256 + lane;
          bf16x4 rf[2][4], bfr[4][2], mbf[3]; f32x4 ecv[4];
#pragma unroll
          for (int mt = 0; mt < 4; ++mt) {
              bfr[mt][0] = ldfrag4(I2_B, CH_I2_LD, 16 * mt, 0, lane); bfr[mt][1] = ldfrag4(I2_B, CH_I2_LD, 16 * mt, 16, lane); ecv[mt] = *(const LAS f32x4*)(ecs + grp * 64 + 16 * mt + 4 * lg); }
#define LOAD_PART_B() do { _Pragma("unroll") for (int mt = 0; mt < 4; ++mt) { rf[0][mt] = ldfrag4_tr(I2_R, CH_I2_LD, 0, 16 * mt, lane); rf[1][mt] = ldfrag4_tr(I2_R, CH_I2_LD, 16, 16 * mt, lane); } \
          mbf[0] = ldfrag4(GMRB, CH_G_LD, 0, 0, lane); mbf[1] = ldfrag4(GMRB, CH_G_LD, 16, 0, lane); mbf[2] = ldfrag4(GMRB, CH_G_LD, 16, 16, lane); } while (0)
          if (grp == 1) LOAD_PART_B();
          bf16x4 fH[4], fU0, fU1, fHP[4], fUP0, fUP1;
#pragma unroll
          for (int mt = 0; mt < 4; ++mt) fHP[mt] = (bf16x4){0, 0, 0, 0};
          fUP0 = fUP1 = (bf16x4){0, 0, 0, 0};
#pragma unroll 1
          for (int sg = 0; sg < 2; ++sg) {
              if (grp == sg) {
                  __builtin_amdgcn_s_setprio(2);
                  f32x4 hh[4];
#pragma unroll
                  for (int mt = 0; mt < 4; ++mt) { hh[mt] = hf[64 * mt]; fH[mt] = frag4(hh[mt]); }
                  f32x4 uu0 = u0[0], uu1 = u0[1];
#pragma unroll
                  for (int mt = 0; mt < 4; ++mt) { uu0 = MF16(apf[0][mt], fH[mt], uu0); uu1 = MF16(apf[1][mt], fH[mt], uu1); }
                  fU0 = frag4(uu0); fU1 = frag4(uu1);
#pragma unroll
                  for (int mt = 0; mt < 4; ++mt) { f32x4 acc = hh[mt] + kv[mt]; acc = MF16(bfr[mt][0], fU0, acc); acc = MF16(bfr[mt][1], fU1, acc); hf[64 * mt] = acc * ecv[mt]; }
                  if (mode == 2) {
                      LAS f32x4* hf2 = (LAS f32x4*)(lds + CH_HF2) + cc * 256 + lane; f32x4 hp[4];
#pragma unroll
                      for (int mt = 0; mt < 4; ++mt) { hp[mt] = hf2[64 * mt]; fHP[mt] = frag4(hp[mt]); }
                      f32x4 up0 = z4, up1 = z4;
#pragma unroll
                      for (int mt = 0; mt < 4; ++mt) { up0 = MF16(apf[0][mt], fHP[mt], up0); up1 = MF16(apf[1][mt], fHP[mt], up1); }
                      fUP0 = frag4(up0); fUP1 = frag4(up1);
#pragma unroll
                      for (int mt = 0; mt < 4; ++mt) { f32x4 acc = MF16(bfr[mt][0], fUP0, hp[mt]); acc = MF16(bfr[mt][1], fUP1, acc); hf2[64 * mt] = acc * ecv[mt]; }
                  }
              }
              __builtin_amdgcn_s_setprio(0);
              __syncthreads();
              if (grp == sg) {
                  if (sg == 0) LOAD_PART_B();
                  f32x4 yy0 = y0[0], yy1 = y0[1];
#pragma unroll
                  for (int mt = 0; mt < 4; ++mt) { yy0 = MF16(rf[0][mt], fH[mt], yy0); yy1 = MF16(rf[1][mt], fH[mt], yy1); }
                  yy0 = MF16(mbf[0], fU0, yy0); yy1 = MF16(mbf[2], fU1, MF16(mbf[1], fU0, yy1));
#pragma unroll
                  for (int e = 0; e < 4; ++e) { const int p = p0 + ss * 64 + 32 * sg + 4 * lg + e, t = dir ? (L - 1 - p) : p, t2 = dir ? (t - 16) : (t + 16);
                      YD[((size_t)dir * MT + m0 + t) * 512 + h * 64 + vcol] = (bf16)f2bf(yy0[e]); YD[((size_t)dir * MT + m0 + t2) * 512 + h * 64 + vcol] = (bf16)f2bf(yy1[e]); }
                  if (mode == 2) {
                      f32x4 g0 = z4, g1 = z4;
#pragma unroll
                      for (int mt = 0; mt < 4; ++mt) { g0 = MF16(rf[0][mt], fHP[mt], g0); g1 = MF16(rf[1][mt], fHP[mt], g1); }
                      g0 = MF16(mbf[0], fUP0, g0); g1 = MF16(mbf[2], fUP1, MF16(mbf[1], fUP0, g1));
                      GAS bf16* G = (GAS bf16*)(P.ws + WS_G) + ((size_t)chain * 2048 + (ss * 64 + 32 * sg + 4 * lg)) * 64 + vcol;
#pragma unroll
                      for (int e = 0; e < 4; e += 2) { const unsigned w0 = cvtpk(g0[e], g0[e + 1]), w1 = cvtpk(g1[e], g1[e + 1]);
                          G[(size_t)e * 64] = (bf16)(w0 & 0xffffu); G[(size_t)(e + 1) * 64] = (bf16)(w0 >> 16); G[(size_t)(e + 16) * 64] = (bf16)(w1 & 0xffffu); G[(size_t)(e + 17) * 64] = (bf16)(w1 >> 16); }
                  }
              }
          }
#undef LOAD_PART_B
        }
        if (ss + 1 < nss) { chain_stage_raw(RR, lds, tid); __syncthreads(); }
    }
    if (grp == 1 && (sfin || mode == 1)) { STAGE_LANE(); const LAS f32x4* hf = (const LAS f32x4*)(lds + CH_HF) + cc * 256 + lane;
        if (mode == 1) { GAS bf16* hm = (GAS bf16*)(P.ws + WS_HMID) + (size_t)chain * 4096 + vcol * 64;
#pragma unroll
            for (int mt = 0; mt < 4; ++mt) { const f32x4 hv = hf[64 * mt]; u32x2v o; o.x = cvtpk(hv[0], hv[1]); o.y = cvtpk(hv[2], hv[3]); *(GAS u32x2v*)(hm + 16 * mt + 4 * lg) = o; } }
        else {
#pragma unroll
            for (int mt = 0; mt < 4; ++mt) *(f32x4*)(sfin + vcol * 64 + 16 * mt + 4 * lg) = hf[64 * mt]; }
    }
    __syncthreads();
#undef STAGE_LANE
}
constexpr int VN_LD = 520;
constexpr int GM_STG = 128 * VN_LD * 2;
static_assert(GM_STG + 8 * 2048 <= LDS_BYTES - 64, "gMLP LDS map");
typedef short s16x4 __attribute__((ext_vector_type(4)));
__device__ __forceinline__ s16x4 tr16(const LAS bf16* p) { return __builtin_amdgcn_ds_read_tr16_b64_v4i16((LAS s16x4*)p); }
__device__ __forceinline__ void do_gmlp(const Params& P, LAS unsigned char* lds, int unit) {
    const int tid = threadIdx.x, lane = tid & 63, wave = __builtin_amdgcn_readfirstlane(tid >> 6);
    const GAS bf16* proj = (const GAS bf16*)(P.ws + WS_PROJ); GAS bf16* MIX = (GAS bf16*)(P.ws + WS_H); const GAS bf16* wsb = (const GAS bf16*)(P.ws + WS_WSB);
    LAS bf16* vn = (LAS bf16*)lds;
    const int row0 = unit * 128;
    { const GAS float* g = (const GAS float*)P.in[I_SLG]; const GAS float* b = (const GAS float*)P.in[I_SLB];
      float gg[8], bb[8];
#pragma unroll
      for (int e = 0; e < 8; ++e) { gg[e] = g[lane * 8 + e]; bb[e] = b[lane * 8 + e]; }
      u32x4v rawv[16];
#pragma unroll
      for (int i = 0; i < 16; ++i) rawv[i] = *(const GAS u32x4v*)(proj + (size_t)(row0 + wave * 16 + i) * D_IN + C_VB + lane * 8);
#pragma unroll
      for (int i = 0; i < 16; ++i) { const int tok = wave * 16 + i; const u32x4v raw = rawv[i];
        float x[8]; x[0] = bf2f(raw.x & 0xffffu); x[1] = bf2f(raw.x >> 16); x[2] = bf2f(raw.y & 0xffffu); x[3] = bf2f(raw.y >> 16); x[4] = bf2f(raw.z & 0xffffu); x[5] = bf2f(raw.z >> 16); x[6] = bf2f(raw.w & 0xffffu); x[7] = bf2f(raw.w >> 16);
        float s = 0.f;
#pragma unroll
        for (int e = 0; e < 8; ++e) s += x[e];
        const float mean = wave_sum(s) * (1.0f / 512.0f); float q = 0.f;
#pragma unroll
        for (int e = 0; e < 8; ++e) { x[e] -= mean; q += x[e] * x[e]; }
        const float rstd = 1.0f / sqrtf(wave_sum(q) * (1.0f / 512.0f) + NORM_EPS);
        u32x4v o;
#pragma unroll
        for (int e = 0; e < 4; ++e) o[e] = cvtpk(x[2 * e] * rstd * gg[2 * e] + bb[2 * e], x[2 * e + 1] * rstd * gg[2 * e + 1] + bb[2 * e + 1]);
        *(LAS u32x4v*)(vn + tok * VN_LD + lane * 8) = o; } }
    __syncthreads();
    const int g = wave, fr = lane & 15, fq = lane >> 4;
    const GAS float* b_s = (const GAS float*)P.in[I_BSS];
    LAS bf16* stg = (LAS bf16*)(lds + GM_STG + wave * 2048);
    const LAS bf16* trbase = vn + (8 * fq + (fr >> 2)) * VN_LD + g * 64 + 4 * (fr & 3);
    const int pr_ = lane >> 2, cq = lane & 3, ch = g * 64 + 16 * cq;
    constexpr int GM_D = 3;
    bf16x8 bfr[4][4];
#pragma unroll
    for (int ks = 0; ks < 4; ++ks)
#pragma unroll
        for (int c = 0; c < 4; ++c) { const s16x4 lo = tr16(trbase + (32 * ks) * VN_LD + 16 * c), hi = tr16(trbase + (32 * ks + 4) * VN_LD + 16 * c);
            bfr[ks][c] = (bf16x8){lo[0], lo[1], lo[2], lo[3], hi[0], hi[1], hi[2], hi[3]}; }
    bf16x8 afr[GM_D][4]; u32x4v uu[GM_D][2], zz[GM_D][2]; float bsv[GM_D];
#define GM_LOAD_TILE(t_, sl_) do { const int p_ = (t_) * 16 + pr_; const GAS bf16* pr = proj + (size_t)(row0 + p_) * D_IN; \
        _Pragma("unroll") for (int ks = 0; ks < 4; ++ks) afr[sl_][ks] = *(const GAS bf16x8*)(wsb + (size_t)(g * 128 + (t_) * 16 + fr) * 128 + ks * 32 + 8 * fq); \
        uu[sl_][0] = *(const GAS u32x4v*)(pr + C_U + ch); uu[sl_][1] = *(const GAS u32x4v*)(pr + C_U + ch + 8); zz[sl_][0] = *(const GAS u32x4v*)(pr + C_ZB + ch); zz[sl_][1] = *(const GAS u32x4v*)(pr + C_ZB + ch + 8); \
        bsv[sl_] = b_s[g * 128 + p_]; } while (0)
#pragma unroll
    for (int t = 0; t < GM_D; ++t) GM_LOAD_TILE(t, t);
#pragma unroll
    for (int t = 0; t < 8; ++t) {
        constexpr int dummy = 0; (void)dummy;
        const int sl = t % GM_D;
        f32x4 acc[4];
#pragma unroll
        for (int c = 0; c < 4; ++c) acc[c] = (f32x4){0.f, 0.f, 0.f, 0.f};
#pragma unroll
        for (int ks = 0; ks < 4; ++ks)
#pragma unroll
            for (int c = 0; c < 4; ++c) acc[c] = __builtin_amdgcn_mfma_f32_16x16x32_bf16(afr[sl][ks], bfr[ks][c], acc[c], 0, 0, 0);
#pragma unroll
        for (int c = 0; c < 4; ++c)
#pragma unroll
            for (int e = 0; e < 4; e += 2) { const unsigned w = cvtpk(acc[c][e], acc[c][e + 1]); LAS bf16* sp = stg + (4 * fq + e) * 64 + 16 * c + fr; sp[0] = (bf16)(w & 0xffffu); sp[64] = (bf16)(w >> 16); }
        const u32x4v u0 = uu[sl][0], u1 = uu[sl][1], z0 = zz[sl][0], z1 = zz[sl][1]; const float bs1 = bsv[sl];
        const u32x4v s0 = *(const LAS u32x4v*)(stg + pr_ * 64 + 16 * cq), s1 = *(const LAS u32x4v*)(stg + pr_ * 64 + 16 * cq + 8);
        u32x4v o0, o1;
#pragma unroll
        for (int e = 0; e < 4; ++e) {
            o0[e] = cvtpk(bf2f(u0[e] & 0xffffu) * (bf2f(s0[e] & 0xffffu) + bs1) * silu_f(bf2f(z0[e] & 0xffffu)), bf2f(u0[e] >> 16) * (bf2f(s0[e] >> 16) + bs1) * silu_f(bf2f(z0[e] >> 16)));
            o1[e] = cvtpk(bf2f(u1[e] & 0xffffu) * (bf2f(s1[e] & 0xffffu) + bs1) * silu_f(bf2f(z1[e] & 0xffffu)), bf2f(u1[e] >> 16) * (bf2f(s1[e] >> 16) + bs1) * silu_f(bf2f(z1[e] >> 16))); }
        asm volatile("" ::: "memory");
        if (t + GM_D < 8) GM_LOAD_TILE(t + GM_D, sl);
        asm volatile("" ::: "memory");
        GAS bf16* op = MIX + (size_t)(row0 + t * 16 + pr_) * D + 512 + ch;
        *(GAS u32x4v*)op = o0; *(GAS u32x4v*)(op + 8) = o1;
    }
#undef GM_LOAD_TILE
    __syncthreads();
}

#define XB_TMO      128
#define XB_XCNT(j)  (256  + 64 * (j))
#define XB_XSUB(j)  (1280 + 64 * (j))
#define XB_XGEN(j)  (2304 + 64 * (j))
#define XB_TOP      3328
#define XB_TOPGEN   3392
#define XCD_BAR_WORDS 3456
#define XB_SPIN_CAP (1u << 18)

__device__ __forceinline__ unsigned xb_ld(unsigned* p)              { return __hip_atomic_load(p, __ATOMIC_RELAXED, __HIP_MEMORY_SCOPE_AGENT); }
__device__ __forceinline__ unsigned xb_add(unsigned* p, unsigned v) { return __hip_atomic_fetch_add(p, v, __ATOMIC_RELAXED, __HIP_MEMORY_SCOPE_AGENT); }
__device__ __forceinline__ unsigned xb_xcc_id() { return (unsigned)__builtin_amdgcn_s_getreg((3 << 11) | 20) & 0xFu; }
#define XB_SPIN(cond, bar) do { unsigned _sp = 0; while (cond) { __builtin_amdgcn_s_sleep(1); \
    if ((++_sp & 255u) == 0u) { if (xb_ld(&(bar)[XB_TMO])) break; if (_sp > XB_SPIN_CAP) { atomicAdd(&(bar)[XB_TMO], 1u); break; } } } } while (0)

struct XcdBarrier {
    unsigned* bar; unsigned x;
    volatile LAS unsigned* st;
};

__device__ __forceinline__ XcdBarrier xcd_barrier_post(unsigned* bar, volatile LAS unsigned* st) {
    XcdBarrier b; b.bar = bar; b.x = xb_xcc_id(); b.st = st;
    if (threadIdx.x == 0) (void)xb_add(&bar[XB_XCNT(b.x)], 1u);
    return b;
}
__device__ __forceinline__ void xcd_barrier_complete(unsigned* bar, unsigned x, unsigned& nloc, unsigned& nx) {
    const unsigned G = gridDim.x * gridDim.y * gridDim.z;
    unsigned sum, cnt, mine, sp = 0u;
    for (;;) {
        sum = 0u; cnt = 0u; mine = 0u;
#pragma unroll
        for (unsigned j = 0; j < 16; ++j) { const unsigned c = xb_ld(&bar[XB_XCNT(j)]); sum += c; cnt += (c > 0u) ? 1u : 0u; mine = (j == x) ? c : mine; }
        if (sum == G) break;
        __builtin_amdgcn_s_sleep(1);
        if ((++sp & 255u) == 0u) { if (xb_ld(&bar[XB_TMO])) break; if (sp > XB_SPIN_CAP) { atomicAdd(&bar[XB_TMO], 1u); break; } }
    }
    nloc = mine > 0u ? mine : 1u; nx = cnt > 0u ? cnt : 1u;
}

__device__ __forceinline__ void xcd_barrier(const XcdBarrier& b) {
    asm volatile("s_waitcnt vmcnt(0)" ::: "memory");
    __syncthreads();
    if (threadIdx.x == 0) {
        unsigned* bar = b.bar;
        __builtin_amdgcn_s_waitcnt(0);
        unsigned nloc = b.st[0], nx = b.st[1];
        if (nloc == 0u) { xcd_barrier_complete(bar, b.x, nloc, nx); b.st[0] = nloc; b.st[1] = nx; }
        const unsigned old = xb_add(&bar[XB_XSUB(b.x)], 1u);
        const unsigned gen = old / nloc;
        if (old + 1u == (gen + 1u) * nloc) {
            __builtin_amdgcn_fence(__ATOMIC_RELEASE, "agent");
            asm volatile("s_waitcnt vmcnt(0)" ::: "memory");
            const unsigned og = xb_add(&bar[XB_TOP], 1u);
            const unsigned tg = og / nx;
            if (og + 1u == (tg + 1u) * nx) xb_add(&bar[XB_TOPGEN], 1u);
            else XB_SPIN(xb_ld(&bar[XB_TOPGEN]) == tg, bar);
            __builtin_amdgcn_fence(__ATOMIC_ACQUIRE, "agent");
            xb_add(&bar[XB_XGEN(b.x)], 1u);
            asm volatile("s_waitcnt vmcnt(0)" ::: "memory");
        } else {
            XB_SPIN(xb_ld(&bar[XB_XGEN(b.x)]) == gen, bar);
            __builtin_amdgcn_fence(__ATOMIC_ACQUIRE, "agent");
            asm volatile("s_waitcnt vmcnt(0)" ::: "memory");
        }
    }
    __syncthreads();
}

#define SP_LOC(k, j) (4096 + 640 * (k) + 32 * (j))
#define SP_TOP(k)    (4096 + 640 * (k) + 512)
__device__ __forceinline__ void split_arrive(const XcdBarrier& b, int k) {
    const unsigned nloc = b.st[0];
    const unsigned old = xb_add(&b.bar[SP_LOC(k, b.x)], 1u);
    if (old + 1u == nloc) { __builtin_amdgcn_fence(__ATOMIC_RELEASE, "agent"); asm volatile("s_waitcnt vmcnt(0)" ::: "memory"); (void)xb_add(&b.bar[SP_TOP(k)], 1u); }
}
__device__ __forceinline__ void split_arrive_all(const XcdBarrier& b, int k) {
    asm volatile("s_waitcnt vmcnt(0)" ::: "memory"); __syncthreads();
    if (threadIdx.x == 0) split_arrive(b, k);
}
__device__ __forceinline__ void split_wait(const XcdBarrier& b, int k) {
    if (threadIdx.x == 0) { const unsigned nx = b.st[1]; unsigned* bar = b.bar; XB_SPIN(xb_ld(&bar[SP_TOP(k)]) < nx, bar);
        __builtin_amdgcn_fence(__ATOMIC_ACQUIRE, "agent"); asm volatile("s_waitcnt vmcnt(0)" ::: "memory"); }
    __syncthreads();
}

__device__ __forceinline__ int queue_pull(unsigned char* ws, size_t qoff, volatile LAS int* qslot) {
    if (threadIdx.x == 0) *qslot = (int)__hip_atomic_fetch_add((unsigned*)(ws + qoff), 1u, __ATOMIC_RELAXED, __HIP_MEMORY_SCOPE_AGENT);
    __syncthreads();
    const int t = *qslot;
    __syncthreads();
    return t;
}
__device__ __forceinline__ void phase3(const Params& P, LAS unsigned char* lds, const XcdBarrier& xb) {
    const int G = gridDim.x, bid = blockIdx.x;
    const bool bal = (G == 256);
    volatile LAS int* qslot = (volatile LAS int*)(lds + LDS_BYTES - 32);
    if (bal) {
        { const int b = bid & 7, q = (bid >> 3) & 15, h = q >> 1, dir = q & 1;
          split_wait(xb, 0);
          const bool fh = bid < 128;
          do_chain(P, lds, M_CTX + b * L_LAT, L_LAT, h, dir, fh ? (dir ? P.in[I_SB] : P.in[I_SF]) + (size_t)(b * 8 + h) * 4096 : nullptr, nullptr, fh ? 0 : 2048, 2048, fh ? 1 : 2, b * 16 + q); }
        split_arrive_all(xb, 7);
        split_wait(xb, 1);
        int q2 = -1;
        for (int first = 1;; first = 0) {
            int qq;
            if (first) { if (threadIdx.x == 0) *qslot = (int)__hip_atomic_fetch_add((unsigned*)(P.ws + CW_QUEUE), 2u, __ATOMIC_RELAXED, __HIP_MEMORY_SCOPE_AGENT); __syncthreads(); qq = *qslot; q2 = qq + 1; __syncthreads(); }
            else if (q2 >= 0) { qq = q2; q2 = -1; }
            else qq = queue_pull(P.ws, CW_QUEUE, qslot);
            if (qq >= 832) break;
            const int grp = qq / 5, rr = qq - 5 * grp, gu = (qq >= 640) ? (qq - 512) : ((rr == 4) ? grp : -1);
            if (gu >= 0) { do_gmlp(P, lds, gu); continue; }
            const int cc = grp * 4 + rr, b = cc >> 4, h = (cc >> 1) & 7, dir = cc & 1;
            do_chain(P, lds, b * L_CTX, L_CTX, h, dir, nullptr, P.out + (size_t)MT * D + (size_t)dir * STATE_ELEMS + (size_t)(b * 8 + h) * 4096, 0, L_CTX, 0, 0);
        }
        split_arrive_all(xb, 8);
        return;
    }
    for (int it = 0; it < (640 + G - 1) / G; ++it) {
        int m0, L, h, dir, p0, npt, mode, chain; const float* s0; float* sfin;
        {
            const int c = bid + it * G; if (c >= 640) continue;
            chain = 0; p0 = 0; mode = 0;
            if (c < 128) { const int b = c >> 4; h = (c >> 1) & 7; dir = c & 1; m0 = M_CTX + b * L_LAT; L = L_LAT; npt = L_LAT;
                s0 = (dir ? P.in[I_SB] : P.in[I_SF]) + (size_t)(b * 8 + h) * 4096; sfin = nullptr; }
            else { const int cc = c - 128, b = cc >> 4; h = (cc >> 1) & 7; dir = cc & 1; m0 = b * L_CTX; L = L_CTX; npt = L_CTX;
                s0 = nullptr; sfin = P.out + (size_t)MT * D + (size_t)dir * STATE_ELEMS + (size_t)(b * 8 + h) * 4096; }
        }
        do_chain(P, lds, m0, L, h, dir, s0, sfin, p0, npt, mode, chain);
    }
    if (!bal) { for (int u = bid; u < 320; u += G) do_gmlp(P, lds, u); }
}

__device__ __forceinline__ void phase35(const Params& P, LAS unsigned char* lds, int gw, int NGW, int wave, int lane) {
    if (gridDim.x != 256) return;
    const GAS bf16* Gm = (const GAS bf16*)(P.ws + WS_G); const GAS bf16* HM = (const GAS bf16*)(P.ws + WS_HMID); GAS bf16* CORR = (GAS bf16*)(P.ws + WS_CORR);
    const int lr = lane & 15, lg = lane >> 4;
    LAS bf16* stg = (LAS bf16*)(lds + wave * 2304);
    const int chain = gw >> 4, b = chain >> 4, h = (chain >> 1) & 7, dir = chain & 1;
    bf16x8 hb[4][2];
#pragma unroll
    for (int nt = 0; nt < 4; ++nt) { const GAS bf16* hp = HM + (size_t)chain * 4096 + (16 * nt + lr) * 64 + 8 * lg; hb[nt][0] = *(const GAS bf16x8*)hp; hb[nt][1] = *(const GAS bf16x8*)(hp + 32); }
    const GAS bf16* gp = Gm + ((size_t)chain * 2048 + (gw & 15) * 128 + lr) * 64 + 8 * lg;
    bf16x8 a0 = *(const GAS bf16x8*)gp, a1 = *(const GAS bf16x8*)(gp + 32);
#pragma unroll 1
    for (int i = 0; i < 8; ++i) {
        const bf16x8 c0 = a0, c1 = a1;
        if (i < 7) { a0 = *(const GAS bf16x8*)(gp + (size_t)(i + 1) * 1024); a1 = *(const GAS bf16x8*)(gp + (size_t)(i + 1) * 1024 + 32); }
#pragma unroll
        for (int nt = 0; nt < 4; ++nt) { f32x4 acc = MFMA16(c0, hb[nt][0], ((f32x4){0.f, 0.f, 0.f, 0.f})); acc = MFMA16(c1, hb[nt][1], acc);
            const unsigned w0 = cvtpk(acc[0], acc[1]), w1 = cvtpk(acc[2], acc[3]); LAS bf16* sp = stg + (4 * lg) * 72 + 16 * nt + lr;
            sp[0] = (bf16)(w0 & 0xffffu); sp[72] = (bf16)(w0 >> 16); sp[144] = (bf16)(w1 & 0xffffu); sp[216] = (bf16)(w1 >> 16); }
        const int tr = lane >> 2, vq = lane & 3, p = 2048 + ((gw & 15) * 8 + i) * 16 + tr, t = dir ? (L_LAT - 1 - p) : p;
        const u32x4v o0 = *(const LAS u32x4v*)(stg + tr * 72 + 16 * vq), o1 = *(const LAS u32x4v*)(stg + tr * 72 + 16 * vq + 8);
        GAS bf16* cp = CORR + ((size_t)(b * L_LAT + t)) * 512 + h * 64 + 16 * vq;
        *(GAS u32x4v*)cp = o0; *(GAS u32x4v*)(cp + 8) = o1;
    }
}

__device__ __forceinline__ void phase4(const Params& P, int gw, int NGW, int lane, int m_lo, int m_hi) {
    const GAS bf16* proj = (const GAS bf16*)(P.ws + WS_PROJ); GAS bf16* MIX = (GAS bf16*)(P.ws + WS_H); const GAS bf16* YD = (const GAS bf16*)P.out; const GAS float* BS = (const GAS float*)(P.ws + WS_BS);
    const GAS float* ts_mu = (const GAS float*)P.in[I_TSMU]; const GAS float* gn_w = (const GAS float*)P.in[I_GNW]; const GAS float* gn_b = (const GAS float*)P.in[I_GNB];
    const int ch = 8 * lane, hd = lane >> 3;
    float m0v[8], m1v[8], gw8[8], gb8[8];
#pragma unroll
    for (int e = 0; e < 8; ++e) { m0v[e] = ts_mu[C_V + ch + e]; m1v[e] = ts_mu[1536 + C_V + ch + e]; gw8[e] = gn_w[ch + e]; gb8[e] = gn_b[ch + e]; }
    for (int m = m_lo + gw; m < m_hi; m += NGW) {
        const int t = (m < M_CTX) ? (m & (L_CTX - 1)) : ((m - M_CTX) & (L_LAT - 1)), L = (m < M_CTX) ? L_CTX : L_LAT;
        const u32x4v yf = *(const GAS u32x4v*)(YD + (size_t)m * 512 + ch), yb = *(const GAS u32x4v*)(YD + ((size_t)MT + m) * 512 + ch);
        const GAS bf16* pr = proj + (size_t)m * D_IN;
        const u32x4v vc = *(const GAS u32x4v*)(pr + C_V + ch), za = *(const GAS u32x4v*)(pr + C_ZA + ch);
        u32x4v vp = (u32x4v){0u, 0u, 0u, 0u}, vn = (u32x4v){0u, 0u, 0u, 0u};
        if (t > 0) vp = *(const GAS u32x4v*)(pr + C_V + ch - D_IN);
        if (t < L - 1) vn = *(const GAS u32x4v*)(pr + C_V + ch + D_IN);
        const float bon = BS[(size_t)m * 8 + hd] + BS[((size_t)MT + m) * 8 + hd];
        u32x4v cr = (u32x4v){0u, 0u, 0u, 0u};
        if (m >= M_CTX && gridDim.x == 256) cr = *(const GAS u32x4v*)((const GAS bf16*)(P.ws + WS_CORR) + (size_t)(m - M_CTX) * 512 + ch);
        float y[8];
#pragma unroll
        for (int e = 0; e < 8; ++e) { const unsigned sh = (e & 1) ? 16u : 0u; y[e] = bf2f((yf[e >> 1] >> sh) & 0xffffu) + bf2f((yb[e >> 1] >> sh) & 0xffffu); }
        float s = 0.f;
#pragma unroll
        for (int e = 0; e < 8; ++e) { y[e] += bf2f((cr[e >> 1] >> ((e & 1) ? 16u : 0u)) & 0xffffu); s += y[e]; }
        const float mean = oct_sum(s) * (1.0f / 64.0f); float q = 0.f;
#pragma unroll
        for (int e = 0; e < 8; ++e) { y[e] -= mean; q += y[e] * y[e]; }
        const float rstd = 1.0f / sqrtf(oct_sum(q) * (1.0f / 64.0f) + GN_EPS);
        u32x4v o;
#pragma unroll
        for (int e2 = 0; e2 < 4; ++e2) { float r2[2];
#pragma unroll
            for (int hh = 0; hh < 2; ++hh) { const int e = 2 * e2 + hh; const unsigned sh = hh ? 16u : 0u;
                const float c0 = bf2f((vc[e2] >> sh) & 0xffffu), p0 = bf2f((vp[e2] >> sh) & 0xffffu), n0 = bf2f((vn[e2] >> sh) & 0xffffu), z = bf2f((za[e2] >> sh) & 0xffffu);
                const float v = c0 + m0v[e] * (p0 - c0) + m1v[e] * (n0 - c0);
                r2[hh] = (y[e] * rstd * gw8[e] + gb8[e] + bon * v) * silu_f(z); }
            o[e2] = cvtpk(r2[0], r2[1]); }
        *(GAS u32x4v*)(MIX + (size_t)m * D + ch) = o;
    }
}

__device__ __forceinline__ void phase45(const Params& P, LAS unsigned char* lds, const XcdBarrier& xb, int gw, int NGW, int wave, int lane) {
    split_wait(xb, 7);
    const GAS bf16* Gm = (const GAS bf16*)(P.ws + WS_G); const GAS bf16* HM = (const GAS bf16*)(P.ws + WS_HMID);
    const GAS bf16* proj = (const GAS bf16*)(P.ws + WS_PROJ); GAS bf16* MIX = (GAS bf16*)(P.ws + WS_H); const GAS bf16* YD = (const GAS bf16*)P.out; const GAS float* BS = (const GAS float*)(P.ws + WS_BS);
    const GAS float* ts_mu = (const GAS float*)P.in[I_TSMU]; const GAS float* gn_w = (const GAS float*)P.in[I_GNW]; const GAS float* gn_b = (const GAS float*)P.in[I_GNB];
    const int lr = lane & 15, lg = lane >> 4;
    LAS bf16* stg = (LAS bf16*)(lds + wave * 16640);
    const int tile = gw, b = tile >> 8, t0 = (tile & 255) * 16, dirs = (t0 >= 2048) ? 0 : 1;
    const int grow0 = (dirs ? (L_LAT - 1 - t0 - 15) : t0) - 2048;
#pragma unroll 1
    for (int hp2 = 0; hp2 < 4; ++hp2) {
        bf16x8 ga[2][2], hb[2][4][2];
#pragma unroll
        for (int q = 0; q < 2; ++q) { const int chain = b * 16 + (2 * hp2 + q) * 2 + dirs;
            const GAS bf16* gp = Gm + ((size_t)chain * 2048 + grow0 + lr) * 64 + 8 * lg; ga[q][0] = *(const GAS bf16x8*)gp; ga[q][1] = *(const GAS bf16x8*)(gp + 32);
#pragma unroll
            for (int nt = 0; nt < 4; ++nt) { const GAS bf16* hp = HM + (size_t)chain * 4096 + (16 * nt + lr) * 64 + 8 * lg; hb[q][nt][0] = *(const GAS bf16x8*)hp; hb[q][nt][1] = *(const GAS bf16x8*)(hp + 32); } }
#pragma unroll
        for (int q = 0; q < 2; ++q)
#pragma unroll
            for (int nt = 0; nt < 4; ++nt) { f32x4 acc = MFMA16(ga[q][0], hb[q][nt][0], ((f32x4){0.f, 0.f, 0.f, 0.f})); acc = MFMA16(ga[q][1], hb[q][nt][1], acc);
                const unsigned w0 = cvtpk(acc[0], acc[1]), w1 = cvtpk(acc[2], acc[3]); LAS bf16* sp = stg + (4 * lg) * 520 + (2 * hp2 + q) * 64 + 16 * nt + lr;
                sp[0] = (bf16)(w0 & 0xffffu); sp[520] = (bf16)(w0 >> 16); sp[1040] = (bf16)(w1 & 0xffffu); sp[1560] = (bf16)(w1 >> 16); }
    }
    const int ch = 8 * lane, hd = lane >> 3;
    float m0v[8], m1v[8], gw8[8], gb8[8];
#pragma unroll
    for (int e = 0; e < 8; ++e) { m0v[e] = ts_mu[C_V + ch + e]; m1v[e] = ts_mu[1536 + C_V + ch + e]; gw8[e] = gn_w[ch + e]; gb8[e] = gn_b[ch + e]; }
    const u32x4v zero4 = (u32x4v){0u, 0u, 0u, 0u};
    const GAS bf16* prow0 = proj + (size_t)(M_CTX + b * L_LAT + t0) * D_IN;
    u32x4v vprev = (t0 > 0) ? *(const GAS u32x4v*)(prow0 + C_V + ch - D_IN) : zero4, vcur = *(const GAS u32x4v*)(prow0 + C_V + ch), vnext = *(const GAS u32x4v*)(prow0 + C_V + ch + D_IN);
    u32x4v yf_n, yb_n, za_n; float bs0_n, bs1_n;
    { const int m = M_CTX + b * L_LAT + t0; yf_n = *(const GAS u32x4v*)(YD + (size_t)m * 512 + ch); yb_n = *(const GAS u32x4v*)(YD + ((size_t)MT + m) * 512 + ch); za_n = *(const GAS u32x4v*)(prow0 + C_ZA + ch);
      bs0_n = BS[(size_t)m * 8 + hd]; bs1_n = BS[((size_t)MT + m) * 8 + hd]; }
#pragma unroll 1
    for (int r = 0; r < 16; ++r) {
        const int t = t0 + r, m = M_CTX + b * L_LAT + t, pl = dirs ? (15 - r) : r;
        const u32x4v yf = yf_n, yb = yb_n, za = za_n, vc = vcur, vp = vprev, vn = vnext; const float bon = bs0_n + bs1_n;
        u32x4v vnn = zero4;
        if (r < 15) { const int m1 = m + 1; const GAS bf16* pr1 = proj + (size_t)m1 * D_IN;
            yf_n = *(const GAS u32x4v*)(YD + (size_t)m1 * 512 + ch); yb_n = *(const GAS u32x4v*)(YD + ((size_t)MT + m1) * 512 + ch); za_n = *(const GAS u32x4v*)(pr1 + C_ZA + ch);
            bs0_n = BS[(size_t)m1 * 8 + hd]; bs1_n = BS[((size_t)MT + m1) * 8 + hd];
            if (t + 2 < L_LAT) vnn = *(const GAS u32x4v*)(pr1 + C_V + ch + D_IN); }
        const u32x4v cr = *(const LAS u32x4v*)(stg + pl * 520 + ch);
        float y[8]; float s = 0.f;
#pragma unroll
        for (int e = 0; e < 8; ++e) { const unsigned sh = (e & 1) ? 16u : 0u; y[e] = bf2f((yf[e >> 1] >> sh) & 0xffffu) + bf2f((yb[e >> 1] >> sh) & 0xffffu) + bf2f((cr[e >> 1] >> sh) & 0xffffu); s += y[e]; }
        const float mean = oct_sum(s) * (1.0f / 64.0f); float q = 0.f;
#pragma unroll
        for (int e = 0; e < 8; ++e) { y[e] -= mean; q += y[e] * y[e]; }
        const float rstd = 1.0f / sqrtf(oct_sum(q) * (1.0f / 64.0f) + GN_EPS);
        u32x4v o;
#pragma unroll
        for (int e2 = 0; e2 < 4; ++e2) { float r2[2];
#pragma unroll
            for (int hh = 0; hh < 2; ++hh) { const int e = 2 * e2 + hh; const unsigned sh = hh ? 16u : 0u;
                const float c0 = bf2f((vc[e2] >> sh) & 0xffffu), p0 = bf2f((vp[e2] >> sh) & 0xffffu), n0 = bf2f((vn[e2] >> sh) & 0xffffu), z = bf2f((za[e2] >> sh) & 0xffffu);
                const float v = c0 + m0v[e] * (p0 - c0) + m1v[e] * (n0 - c0);
                r2[hh] = (y[e] * rstd * gw8[e] + gb8[e] + bon * v) * silu_f(z); }
            o[e2] = cvtpk(r2[0], r2[1]); }
        *(GAS u32x4v*)(MIX + (size_t)m * D + ch) = o;
        vprev = vcur; vcur = vnext; vnext = vnn;
    }
    split_arrive_all(xb, 9);
    split_wait(xb, 8);
    phase4(P, gw, NGW, lane, 0, M_CTX);
    split_arrive_all(xb, 10);
}

__device__ __forceinline__ void phase6(const Params& P, int gw, int NGW, int lane) {
    const GAS float* mod = (const GAS float*)(P.ws + WS_MOD); const GAS float* ln_post = (const GAS float*)P.in[I_LNPOST]; const GAS bf16* OB = (const GAS bf16*)(P.ws + WS_OUTB);
#pragma unroll 1
    for (int seg = 0; seg < 9; ++seg) {
        const int m_lo = (seg == 0) ? 0 : M_CTX + (seg - 1) * L_LAT, m_hi = (seg == 0) ? M_CTX : m_lo + L_LAT;
        const GAS float* gate = mod + seg * 3072 + 2048;
        f32x4 wg[4];
#pragma unroll
        for (int j = 0; j < 4; ++j) { const int col = 4 * (lane + 64 * j); wg[j] = *(const GAS f32x4*)(ln_post + col) * *(const GAS f32x4*)(gate + col); }
        for (int m = m_lo + gw; m < m_hi; m += NGW) {
            const GAS f32x4* xr = (const GAS f32x4*)x_row(P, m) + lane; GAS f32x4* orow = (GAS f32x4*)(P.out + (size_t)m * D) + lane;
            const GAS u32x2v* ob = (const GAS u32x2v*)(OB + (size_t)m * D) + lane;
            f32x4 o[4], xv[4]; float ss = 0.f;
#pragma unroll
            for (int j = 0; j < 4; ++j) { const u32x2v r = ob[64 * j]; xv[j] = xr[64 * j]; o[j][0] = bf2f(r.x & 0xffffu); o[j][1] = bf2f(r.x >> 16); o[j][2] = bf2f(r.y & 0xffffu); o[j][3] = bf2f(r.y >> 16);
                ss += (o[j][0] * o[j][0] + o[j][1] * o[j][1]) + (o[j][2] * o[j][2] + o[j][3] * o[j][3]); }
            const float rstd = 1.0f / sqrtf(wave_sum(ss) * (1.0f / D) + NORM_EPS);
#pragma unroll
            for (int j = 0; j < 4; ++j) orow[64 * j] = xv[j] + o[j] * rstd * wg[j];
        }
    }
}

__device__ __forceinline__ void phase0_dyn(const Params& P, LAS unsigned char* lds, const XcdBarrier& xb, int gw, int NGW, int wave, int lane) {
    typedef float f32x2 __attribute__((ext_vector_type(2)));
    float* mod = (float*)(P.ws + WS_MOD);
    const float* w_mod = P.in[I_WMOD]; const float* b_mod = P.in[I_BMOD]; const float* cc = P.in[I_C]; const float* cctx = P.in[I_CCTX];
    const int cgp = blockIdx.x & 31, rg = blockIdx.x >> 5, col = cgp * 96 + 2 * (lane < 48 ? lane : 0), r0 = rg * 128 + wave * 16;
    f32x2 acc[9];
#pragma unroll
    for (int v = 0; v < 9; ++v) acc[v] = (f32x2){0.f, 0.f};
    f32x2 w[16];
#pragma unroll
    for (int i = 0; i < 16; ++i) w[i] = *(const GAS f32x2*)((const GAS float*)w_mod + (size_t)(r0 + i) * 3072 + col);
#pragma unroll
    for (int i = 0; i < 16; ++i) {
#pragma unroll
        for (int v = 0; v < 9; ++v) { const float cv = (v == 0) ? cctx[r0 + i] : cc[(v - 1) * 1024 + r0 + i]; acc[v] += silu_f(cv) * w[i]; }
    }
    LAS f32x2* red = (LAS f32x2*)lds;
#pragma unroll
    for (int v = 0; v < 9; ++v) red[(wave * 9 + v) * 64 + lane] = acc[v];
    __syncthreads();
    { const int idx = threadIdx.x;
      if (idx < 9 * 48) { const int v = idx / 48, l = idx - 48 * v; f32x2 s = red[v * 64 + l];
#pragma unroll
        for (int w2 = 1; w2 < 8; ++w2) s += red[(w2 * 9 + v) * 64 + l];
        const int c2 = cgp * 96 + 2 * l;
        if (rg == 0) s += *(const f32x2*)(b_mod + c2);
        atomicAdd(mod + v * 3072 + c2, s[0]); atomicAdd(mod + v * 3072 + c2 + 1, s[1]); } }
    if (threadIdx.x == 0 && xb.st[0] == 0u) { unsigned nloc, nx; xcd_barrier_complete(xb.bar, xb.x, nloc, nx); xb.st[0] = nloc; xb.st[1] = nx; }
    split_arrive_all(xb, 11);
    weight_copies(P, lds, gw, NGW, wave, lane);
    split_wait(xb, 11);
}

__device__ __forceinline__ void phase1_dyn(const Params& P, const XcdBarrier& xb, int wave, int lane) {
    const int c = blockIdx.x, x = c & 7, i = c >> 3;
    f32x4 gs[4], sh[4];
    prenorm_mod(P, 1 + x, lane, gs, sh);
    const int m1 = M_CTX + L_LAT * x + 64 * i + 8 * wave;
    prenorm_rows(P, m1, 8, lane, gs, sh);
    split_arrive_all(xb, 4);
    if (i & 1) { prenorm_rows(P, m1 + 2048, 8, lane, gs, sh); prenorm_rows(P, m1 - 64 + 2048 + 6, 2, lane, gs, sh); }
    else prenorm_rows(P, m1 + 2048, 6, lane, gs, sh);
    split_arrive_all(xb, 5);
    prenorm_mod(P, 0, lane, gs, sh);
    const int m0 = 1024 * x + 32 * i + 4 * wave;
    prenorm_rows(P, m0, 4, lane, gs, sh);
    split_arrive_all(xb, 6);
}

struct Gemm1Order {
    int G, c; pg8::StaticOrder so;
    __device__ __forceinline__ void init(int G_, int c_) { G = G_; c = c_; so.init(MT, D_IN, G_, c_); }
    __device__ __forceinline__ bool next(int i, pg8::Unit& u) const {
        if (G != 256) return so.next(i, u);
        const int j = 32 * i + (c >> 3), x = c & 7; if (j >= 300) return false;
        if (j < 240) { const int grp = j / 60, idx = j - 60 * grp; u.pm = 32 + 16 * x + 4 * grp + (idx & 3); u.pn = idx >> 2; }
        else { const int jj = j - 240; u.pm = 4 * x + (jj & 3); u.pn = jj >> 2; }
        return true;
    }
    __device__ __forceinline__ void a_ready(const pg8::Unit&) const {}
    __device__ __forceinline__ void done(const pg8::Unit&, int ui) const {
        if (G == 256 && ui == 7) { asm volatile("s_waitcnt vmcnt(0)" ::: "memory"); __builtin_amdgcn_s_barrier();
            if (threadIdx.x == 0) split_arrive(xb, 0); }
        if (G == 256 && ui == 1) split_wait(xb, 5);
        if (G == 256 && ui == 5) split_wait(xb, 6);
    }
    XcdBarrier xb;
};

struct Gemm2Order {
    int G, c; pg8::StaticOrder so; XcdBarrier xb;
    __device__ __forceinline__ void init(int G_, int c_) { G = G_; c = c_; so.init(MT, D, G_, c_); }
    __device__ __forceinline__ bool next(int i, pg8::Unit& u) const {
        if (G != 256) return so.next(i, u);
        const int j = 32 * i + (c >> 3), x = c & 7; if (j >= 80) return false;
        if (j < 64) { u.pm = 32 + 16 * x + 8 * (j >> 5) + (j & 7); u.pn = (j & 31) >> 3; }
        else { const int jj = j - 64; u.pm = 4 * x + (jj & 3); u.pn = jj >> 2; }
        return true;
    }
    __device__ __forceinline__ void a_ready(const pg8::Unit&) const {}
    __device__ __forceinline__ void done(const pg8::Unit&, int ui) const {
        if (G == 256 && ui == 1) { asm volatile("s_waitcnt vmcnt(0)" ::: "memory"); __builtin_amdgcn_s_barrier();
            if (threadIdx.x == 0) split_arrive(xb, 2); }
        if (G == 256 && ui == 0) split_wait(xb, 10);
    }
};

__device__ __forceinline__ void phase6_dyn(const Params& P, LAS unsigned char* lds, const XcdBarrier& xb, int wave, int lane) {
    const GAS float* mod = (const GAS float*)(P.ws + WS_MOD); const GAS float* ln_post = (const GAS float*)P.in[I_LNPOST]; const GAS bf16* OB = (const GAS bf16*)(P.ws + WS_OUTB);
    volatile LAS int* qs = (volatile LAS int*)(lds + LDS_BYTES - 64);
    unsigned* qctr = (unsigned*)(P.ws + CW_QUEUE + 512);
    split_wait(xb, 2);
    if (threadIdx.x == 0) qs[0] = (int)__hip_atomic_fetch_add(qctr, 1u, __ATOMIC_RELAXED, __HIP_MEMORY_SCOPE_AGENT);
    __syncthreads();
    int cur = qs[0], par = 1, seg_cur = -1; bool late_ok = false;
    f32x4 wg[4];
    while (cur < 2560) {
        unsigned nxt = 0u;
        if (threadIdx.x == 0) nxt = __hip_atomic_fetch_add(qctr, 1u, __ATOMIC_RELAXED, __HIP_MEMORY_SCOPE_AGENT);
        if (cur >= 2048 && !late_ok) { split_wait(xb, 3); late_ok = true; }
        int pm;
        if (cur < 2048) pm = 32 + (cur >> 4); else pm = (cur - 2048) >> 4;
        const int m = pm * 256 + (cur & 15) * 16 + wave * 2, seg = (m < M_CTX) ? 0 : 1 + ((m - M_CTX) >> 12);
        f32x4 o[2][4], xv[2][4];
#pragma unroll
        for (int rr = 0; rr < 2; ++rr) { const GAS f32x4* xr = (const GAS f32x4*)x_row(P, m + rr) + lane; const GAS u32x2v* ob = (const GAS u32x2v*)(OB + (size_t)(m + rr) * D) + lane;
#pragma unroll
            for (int j = 0; j < 4; ++j) { const u32x2v r = ob[64 * j]; xv[rr][j] = xr[64 * j]; o[rr][j][0] = bf2f(r.x & 0xffffu); o[rr][j][1] = bf2f(r.x >> 16); o[rr][j][2] = bf2f(r.y & 0xffffu); o[rr][j][3] = bf2f(r.y >> 16); } }
        if (seg != seg_cur) { seg_cur = seg; const GAS float* gate = mod + seg * 3072 + 2048;
#pragma unroll
            for (int j = 0; j < 4; ++j) { const int col = 4 * (lane + 64 * j); wg[j] = *(const GAS f32x4*)(ln_post + col) * *(const GAS f32x4*)(gate + col); } }
#pragma unroll
        for (int rr = 0; rr < 2; ++rr) { float ss = 0.f;
#pragma unroll
            for (int j = 0; j < 4; ++j) ss += (o[rr][j][0] * o[rr][j][0] + o[rr][j][1] * o[rr][j][1]) + (o[rr][j][2] * o[rr][j][2] + o[rr][j][3] * o[rr][j][3]);
            const float rstd = 1.0f / sqrtf(wave_sum(ss) * (1.0f / D) + NORM_EPS);
            GAS f32x4* orow = (GAS f32x4*)(P.out + (size_t)(m + rr) * D) + lane;
#pragma unroll
            for (int j = 0; j < 4; ++j) orow[64 * j] = xv[rr][j] + o[rr][j] * rstd * wg[j]; }
        if (threadIdx.x == 0) qs[par] = (int)nxt;
        __syncthreads();
        cur = qs[par]; par ^= 1;
    }
}

constexpr int N_PHASES = 8;
__global__ void __launch_bounds__(NTHREADS, 2) fwd_kernel(Params P) {
    extern __shared__ __attribute__((aligned(16))) unsigned char lds_raw[];
    LAS unsigned char* lds = (LAS unsigned char*)lds_raw;
    const int tid = threadIdx.x, lane = tid & 63, wave = __builtin_amdgcn_readfirstlane(tid >> 6);
    const int G = gridDim.x, gw = blockIdx.x * NWAVES + wave, NGW = G * NWAVES;
    const int lo = P.ph_lo, hi = P.ph_hi;
    volatile LAS unsigned* bst = (volatile LAS unsigned*)(lds + LDS_BYTES - 16);
    if (tid < 2) bst[tid] = 0u;
    __syncthreads();
    XcdBarrier bar = xcd_barrier_post((unsigned*)P.ws, bst);
#define IN(k) (lo <= (k) && (k) < hi)
#define SEAM(k) do { if (IN(k) && IN((k) + 1)) xcd_barrier(bar); } while (0)
#define PP(name) const Params* name = (const Params*)__builtin_amdgcn_kernarg_segment_ptr(); asm volatile("" : "+s"(name))
    if (IN(0)) { PP(q);
        if (G == 256) phase0_dyn(*q, lds, bar, gw, NGW, wave, lane);
        else { phase0(*q, lds, gw, NGW, wave, lane);
            if (G > 96) { if ((int)blockIdx.x >= 96) weight_copies(*q, lds, gw - 96 * NWAVES, NGW - 96 * NWAVES, wave, lane); }
            else weight_copies(*q, lds, gw, NGW, wave, lane); } }
    if (G != 256) SEAM(0);
    { PP(q); TS(q->ws, 0); }
    if (IN(1)) { PP(q); if (G == 256) phase1_dyn(*q, bar, wave, lane); else phase1(*q, gw, NGW, lane); }
    if (G != 256) SEAM(1); else split_wait(bar, 4);
    if (IN(2)) { PP(q); unsigned char* ws = q->ws; TS(ws, 1);
        pg8::Gemm g{(const pg8::bf16_t*)(ws + WS_H), (const pg8::bf16_t*)(ws + WS_WIN), MT, D_IN, D}; Gemm1Order S; S.init(G, (int)blockIdx.x); S.xb = bar;
        pg8::EpiBf16 E{(pg8::bf16_t*)(ws + WS_PROJ), D_IN, C_WD / 256};
        pg8::gemm_phase<pg8::EpiBf16, Gemm1Order, true, true>(lds, g, S, E);
        TS(ws, 2);
        if (G == 256 && tid == 0) split_arrive(bar, 1); }
    if (G != 256) SEAM(2);
    if (IN(3)) { PP(q); phase3(*q, lds, bar); TS(q->ws, 5); }
    if (G != 256) SEAM(3);
    { PP(q); TS(q->ws, 6); }
    if (G == 256) { if (IN(4)) { PP(q); phase45(*q, lds, bar, gw, NGW, wave, lane); TS(q->ws, 7); } }
    else { if (IN(4)) { PP(q); phase35(*q, lds, gw, NGW, wave, lane); }
        SEAM(4);
        if (IN(5)) { PP(q); phase4(*q, gw, NGW, lane, 0, MT); } }
    if (G != 256) SEAM(5); else split_wait(bar, 9);
    if (IN(6)) { PP(q); unsigned char* ws = q->ws; TS(ws, 8);
        pg8::Gemm g{(const pg8::bf16_t*)(ws + WS_H), (const pg8::bf16_t*)(ws + WS_WOUT), MT, D, D}; Gemm2Order S; S.init(G, (int)blockIdx.x); S.xb = bar;
        pg8::EpiBf16 E{(pg8::bf16_t*)(ws + WS_OUTB), D, -1};
        pg8::gemm_phase<pg8::EpiBf16, Gemm2Order, true, true>(lds, g, S, E); TS(ws, 9);
        if (G == 256 && tid == 0) split_arrive(bar, 3); }
    if (G != 256) SEAM(6);
    { PP(q); TS(q->ws, 10); }
    if (IN(7)) { PP(q); if (G == 256) phase6_dyn(*q, lds, bar, wave, lane); else phase6(*q, gw, NGW, lane);
#ifdef PROBE_KA
        { const unsigned* ts = (const unsigned*)(q->ws + CW_TS); unsigned t0 = 0xffffffffu;
          for (int b = 0; b < 256; ++b) t0 = min(t0, ts[b * 16]);
          float acc = (PROBE_RED == 1) ? 1e30f : 0.f; int n = 0;
          for (int b = 0; b < 256; ++b) { const bool in = (PROBE_SUB == 0) || (PROBE_SUB == 1 && b < 96) || (PROBE_SUB == 2 && b >= 96) || (PROBE_SUB == 3 && b >= 96 && b < 128) || (PROBE_SUB == 4 && b >= 128) || (PROBE_SUB == 5 && ((b >> 3) & 1) == 0) || (PROBE_SUB == 6 && ((b >> 3) & 1) == 1);
              if (!in) continue; const float v = (float)(int)(ts[b * 16 + PROBE_KA] - ((PROBE_KB < 0) ? t0 : ts[b * 16 + PROBE_KB]));
              acc = (PROBE_RED == 0) ? fmaxf(acc, v) : (PROBE_RED == 1) ? fminf(acc, v) : acc + v; ++n; }
          if (PROBE_RED == 2) acc /= (float)n;
          const float f = 1.0f + acc * PROBE_SCALE;
          float* nb = q->out + (size_t)MT * D + STATE_ELEMS;
          for (size_t i = (size_t)gw * 64 + lane; i < STATE_ELEMS; i += (size_t)NGW * 64) nb[i] *= f; }
#endif
    }
#undef PP
#undef IN
#undef SEAM
}

#ifndef N_LAUNCHES
#define N_LAUNCHES 1
#endif
extern "C" void kernel_launch(void* const* d_in, const int* in_sizes, int n_in, void* d_out, int out_size, void* d_ws, size_t ws_size, hipStream_t stream) {
    static int grid = 0;
    if (grid == 0) {
        if (n_in != 26 || ws_size < WS_END) { fprintf(stderr, "kernel_launch: unexpected n_in %d / ws_size %zu (need %zu)\n", n_in, ws_size, (size_t)WS_END); grid = -1; return; }
        int dev = 0, cus = 0, per_cu = 0;
        hipGetDevice(&dev); hipDeviceGetAttribute(&cus, hipDeviceAttributeMultiprocessorCount, dev);
        if (hipFuncSetAttribute((const void*)fwd_kernel, hipFuncAttributeMaxDynamicSharedMemorySize, LDS_BYTES) != hipSuccess) { fprintf(stderr, "kernel_launch: hipFuncSetAttribute failed\n"); grid = -1; return; }
        if (hipOccupancyMaxActiveBlocksPerMultiprocessor(&per_cu, (const void*)fwd_kernel, NTHREADS, LDS_BYTES) != hipSuccess || per_cu < 1) { fprintf(stderr, "kernel_launch: occupancy query says %d\n", per_cu); per_cu = 1; }
        (void)hipGetLastError();
        grid = cus * 1;
        fprintf(stderr, "kernel_launch: cus %d per_cu %d grid %d\n", cus, per_cu, grid);
    }
    if (grid < 0) return;
    hipMemsetAsync((char*)d_ws + WS_CTL, 0, CTL_ZERO_BYTES, stream);
    Params p{};
    for (int i = 0; i < 26; ++i) p.in[i] = (const float*)d_in[i];
    p.out = (float*)d_out; p.ws = (unsigned char*)d_ws;
    if (N_LAUNCHES == 1) {
        p.ph_lo = 0; p.ph_hi = N_PHASES;
        hipLaunchKernelGGL(fwd_kernel, dim3(grid), dim3(NTHREADS), LDS_BYTES, stream, p);
    } else {
        for (int ph = 0; ph < N_PHASES; ++ph) { p.ph_lo = ph; p.ph_hi = ph + 1; hipLaunchKernelGGL(fwd_kernel, dim3(grid), dim3(NTHREADS), LDS_BYTES, stream, p); }
    }
}
```

```cpp
#include <hip/hip_runtime.h>
#include <cstdio>
#include <cstdint>
namespace pg8 {
#define PG8_LAS __attribute__((address_space(3)))
typedef unsigned short bf16_t;
typedef short bf16x8 __attribute__((ext_vector_type(8)));
typedef float f32x4 __attribute__((ext_vector_type(4)));
typedef unsigned u32x4 __attribute__((ext_vector_type(4)));
constexpr int BM = 256, BK = 64, HALF = 128, HTB = HALF * BK * 2  , STAGE_BYTES = 8 * HTB, NXCD = 8, WGM = 8;

__host__ __device__ __forceinline__ int lds_byte(int r, int c) { const int st = (r >> 4) * 2 + (c >> 5), rr = r & 15, cc = c & 31, ob = rr * 64 + cc * 2; return st * 1024 + (ob ^ (((ob >> 9) & 1) << 5)); }
__host__ __device__ __forceinline__ void stage_rc(int b, int& R, int& C) { const int st = b / 1024, sb = b % 1024, swz = sb ^ (((sb >> 9) & 1) << 5); R = (st >> 1) * 16 + swz / 64; C = (st & 1) * 32 + (swz % 64) / 2; }
__host__ __device__ __forceinline__ int perm32(int rho) { const int n = rho >> 4, i = rho & 15; return 8 * (i >> 2) + 4 * n + (i & 3); }

struct Unit { int pm, pn; };
struct Gemm { const bf16_t* A; const bf16_t* Bt; int M, N, K; };

struct StaticOrder {
    int nM, nN, nwg, G, c;
    __host__ __device__ void init(int M, int N, int G_, int c_) { nM = M / BM; nN = N / BM; nwg = nM * nN; G = G_; c = c_; }
    __host__ __device__ bool next(int i, Unit& u) const {
        const long L = (long)i * G + c; if (L >= nwg) return false;
        int wgid = (int)L; { const int q = nwg / NXCD, r = nwg % NXCD, xcd = wgid % NXCD, off = wgid / NXCD; wgid = (xcd < r ? xcd * (q + 1) : r * (q + 1) + (xcd - r) * q) + off; }
        const int nig = WGM * nN, gid = wgid / nig, fm = gid * WGM, gsz = (nM - fm) < WGM ? (nM - fm) : WGM;
        u.pm = fm + ((wgid % nig) % gsz); u.pn = (wgid % nig) / gsz; return true;
    }
    __device__ __forceinline__ void a_ready(const Unit&) const {}
    __device__ __forceinline__ void done(const Unit&, int) const {}
};
typedef float f32x2p __attribute__((ext_vector_type(2)));
typedef __bf16 bf16x2p __attribute__((ext_vector_type(2)));
__device__ __forceinline__ unsigned cvt_pk_bf16(float lo, float hi) { f32x2p v; v.x = lo; v.y = hi; return __builtin_bit_cast(unsigned, __builtin_convertvector(v, bf16x2p)); }
struct EpiBf16 {
    static constexpr bool PERM = true, AFTER_DRAIN = false;
    bf16_t* O; int ldc; int tanh_pn;
    __device__ __forceinline__ void operator()(const f32x4 (&acc)[2][2][4][2], const Unit& u, int wr, int wc, int fr, int fq) const {
        const int row0 = u.pm * BM + wr * 64 + fr, col0 = u.pn * BM + wc * 32 + 8 * fq;
#pragma unroll
        for (int ai = 0; ai < 2; ++ai)
#pragma unroll
            for (int m = 0; m < 4; ++m) { bf16_t* rowp = O + (size_t)(row0 + ai * HALF + m * 16) * ldc + col0;
#pragma unroll
                for (int bj = 0; bj < 2; ++bj) { f32x4 v0 = acc[ai][bj][m][0], v1 = acc[ai][bj][m][1];
                    if (bj == 0 && u.pn == tanh_pn) {
#pragma unroll
                        for (int j = 0; j < 4; ++j) { v0[j] = 1.0f - 2.0f * __builtin_amdgcn_rcpf(1.0f + __builtin_amdgcn_exp2f(2.88539008f * v0[j])); v1[j] = 1.0f - 2.0f * __builtin_amdgcn_rcpf(1.0f + __builtin_amdgcn_exp2f(2.88539008f * v1[j])); } }
                    u32x4 w; w.x = cvt_pk_bf16(v0[0], v0[1]); w.y = cvt_pk_bf16(v0[2], v0[3]); w.z = cvt_pk_bf16(v1[0], v1[1]); w.w = cvt_pk_bf16(v1[2], v1[3]);
                    __builtin_nontemporal_store(w, (u32x4*)(rowp + bj * HALF)); } }
    }
};
struct EpiF32 {
    static constexpr bool PERM = false, AFTER_DRAIN = false;
    float* C; int ldc;
    __device__ __forceinline__ void operator()(const f32x4 (&acc)[2][2][4][2], const Unit& u, int wr, int wc, int fr, int fq) const {
        const int row0 = u.pm * BM + wr * 64 + fr, col0 = u.pn * BM + wc * 32 + 4 * fq;
#pragma unroll
        for (int ai = 0; ai < 2; ++ai)
#pragma unroll
            for (int m = 0; m < 4; ++m) { float* rowp = C + (size_t)(row0 + ai * HALF + m * 16) * ldc + col0;
#pragma unroll
                for (int bj = 0; bj < 2; ++bj)
#pragma unroll
                    for (int n = 0; n < 2; ++n) *(f32x4*)(rowp + bj * HALF + n * 16) = acc[ai][bj][m][n]; }
    }
};
template <class Epi, class Sched, bool ALIGN_EPI = false, bool SP2 = false>
__device__ __forceinline__ void gemm_phase(PG8_LAS unsigned char* lds, const Gemm g, const Sched& S, const Epi& E) {
    const int tid = threadIdx.x, wid = __builtin_amdgcn_readfirstlane(tid >> 6), lane = tid & 63, wr = wid >> 2, wc = wid & 3, fr = lane & 15, fq = lane >> 4;
    const int K = g.K, nt = K / BK;
    unsigned voffA[2], voffB[2];
#pragma unroll
    for (int i = 0; i < 2; ++i) { int R, C; stage_rc(tid * 16 + i * 8192, R, C); const int Rb = Epi::PERM ? ((R & ~31) + perm32(R & 31)) : R;
        voffA[i] = (unsigned)(R * K + C) * 2u; voffB[i] = (unsigned)(Rb * K + C) * 2u; }
    const size_t kstep = (size_t)(BK * 2);
    const size_t hstep = (size_t)HALF * K * 2;
    const size_t tstep = 2 * hstep;
    const unsigned ldsw = (unsigned)wid * 1024u;
    const int aoff = lds_byte(wr * 64 + fr, fq * 8), boff = lds_byte(wc * 32 + fr, fq * 8);
#define PG8_SA(b, h) (((b) * 2 + (h)) * HTB)
#define PG8_SB(b, h) ((4 + (b) * 2 + (h)) * HTB)
#define PG8_STAGE(bufoff, gbase, voff) do { _Pragma("unroll") for (int _i = 0; _i < 2; ++_i) \
        __builtin_amdgcn_global_load_lds((const unsigned*)((const char*)(gbase) + (voff)[_i]), (PG8_LAS unsigned*)(lds + (bufoff) + ldsw + _i * 8192), 16, 0, 0); } while (0)
#define PG8_LDA(dst, b, h) do { _Pragma("unroll") for (int m = 0; m < 4; ++m) _Pragma("unroll") for (int k = 0; k < 2; ++k) dst[m][k] = *(const PG8_LAS bf16x8*)(lds + PG8_SA(b, h) + aoff + m * 2048 + k * 1024); } while (0)
#define PG8_LDB(dst, b, h) do { _Pragma("unroll") for (int n = 0; n < 2; ++n) _Pragma("unroll") for (int k = 0; k < 2; ++k) dst[n][k] = *(const PG8_LAS bf16x8*)(lds + PG8_SB(b, h) + boff + n * 2048 + k * 1024); } while (0)
#define PG8_MMA(ai, bj, At, Bt) do { __builtin_amdgcn_s_setprio(1); _Pragma("unroll") for (int m = 0; m < 4; ++m) _Pragma("unroll") for (int n = 0; n < 2; ++n) _Pragma("unroll") for (int k = 0; k < 2; ++k) \
        acc[ai][bj][m][n] = __builtin_amdgcn_mfma_f32_16x16x32_bf16(Bt[n][k], At[m][k], acc[ai][bj][m][n], 0, 0, 0); __builtin_amdgcn_s_setprio(0); } while (0)
#define PG8_WAIT_V(n) asm volatile("s_waitcnt vmcnt(" #n ")" ::: "memory")
#define PG8_WAIT_L(n) asm volatile("s_waitcnt lgkmcnt(" #n ")" ::: "memory")
#define PG8_BAR __builtin_amdgcn_s_barrier()
#define PG8_SCHED __builtin_amdgcn_sched_barrier(0)
    Unit cur, nxt; int ui = 0;
    if (!S.next(0, cur)) return;
    f32x4 acc[2][2][4][2];
#pragma unroll
    for (int a = 0; a < 2; ++a)
#pragma unroll
        for (int b = 0; b < 2; ++b)
#pragma unroll
            for (int m = 0; m < 4; ++m)
#pragma unroll
                for (int n = 0; n < 2; ++n) acc[a][b][m][n] = (f32x4){0.f, 0.f, 0.f, 0.f};
    bf16x8 At[4][2], B0[2][2], B1[2][2];
    const char* cA = (const char*)g.A + (size_t)cur.pm * tstep; const char* cB = (const char*)g.Bt + (size_t)cur.pn * tstep;
    S.a_ready(cur);
    if constexpr (SP2) {
        PG8_STAGE(PG8_SB(0, 0), cB, voffB); PG8_STAGE(PG8_SB(0, 1), cB + hstep, voffB); PG8_STAGE(PG8_SA(0, 0), cA, voffA); PG8_STAGE(PG8_SA(0, 1), cA + hstep, voffA);
        if (wr == 1) PG8_BAR;
        PG8_WAIT_V(2); PG8_BAR;
        PG8_STAGE(PG8_SB(1, 0), cB + kstep, voffB); PG8_STAGE(PG8_SA(1, 0), cA + kstep, voffA); PG8_STAGE(PG8_SB(1, 1), cB + hstep + kstep, voffB);
        PG8_WAIT_V(6); PG8_BAR;
    } else {
        PG8_STAGE(PG8_SB(0, 0), cB, voffB); PG8_STAGE(PG8_SA(0, 0), cA, voffA); PG8_STAGE(PG8_SB(0, 1), cB + hstep, voffB); PG8_STAGE(PG8_SA(0, 1), cA + hstep, voffA);
        if (wr == 1) PG8_BAR;
        PG8_WAIT_V(4); PG8_BAR;
        PG8_STAGE(PG8_SB(1, 0), cB + kstep, voffB); PG8_STAGE(PG8_SA(1, 0), cA + kstep, voffA); PG8_STAGE(PG8_SB(1, 1), cB + hstep + kstep, voffB);
        PG8_WAIT_V(6); PG8_BAR;
    }
    for (;;) {
        const bool has_next = S.next(ui + 1, nxt);
        const char* nA = has_next ? (const char*)g.A + (size_t)nxt.pm * tstep : cA; const char* nB = has_next ? (const char*)g.Bt + (size_t)nxt.pn * tstep : cB;
        for (int t = 0; t < nt; t += 2) {
            const bool last = (t == nt - 2);
            const char* a1 = cA + (size_t)(t + 1) * kstep;
            const char* a2 = last ? nA : cA + (size_t)(t + 2) * kstep; const char* b2 = last ? nB : cB + (size_t)(t + 2) * kstep;
            const char* a3 = a2 + kstep; const char* b3 = b2 + kstep;
            if (last && has_next) S.a_ready(nxt);
            if constexpr (SP2) {
            PG8_LDB(B0, 0, 0); PG8_LDB(B1, 0, 1); PG8_SCHED; PG8_LDA(At, 0, 0); PG8_STAGE(PG8_SA(1, 1), a1 + hstep, voffA);
            PG8_WAIT_V(8); PG8_WAIT_L(0); PG8_BAR; PG8_MMA(0, 0, At, B0); PG8_MMA(0, 1, At, B1); PG8_BAR; PG8_SCHED;
            PG8_LDA(At, 0, 1); PG8_STAGE(PG8_SB(0, 0), b2, voffB); PG8_STAGE(PG8_SB(0, 1), b2 + hstep, voffB); PG8_STAGE(PG8_SA(0, 0), a2, voffA);
            PG8_WAIT_V(8); PG8_WAIT_L(0); PG8_BAR; PG8_MMA(1, 0, At, B0); PG8_MMA(1, 1, At, B1); PG8_BAR; PG8_SCHED;
            PG8_LDB(B0, 1, 0); PG8_LDB(B1, 1, 1); PG8_SCHED; PG8_LDA(At, 1, 0); PG8_STAGE(PG8_SA(0, 1), a2 + hstep, voffA);
            PG8_WAIT_V(8); PG8_WAIT_L(0); PG8_BAR; PG8_MMA(0, 0, At, B0); PG8_MMA(0, 1, At, B1); PG8_BAR; PG8_SCHED;
            PG8_LDA(At, 1, 1); PG8_STAGE(PG8_SB(1, 0), b3, voffB); PG8_STAGE(PG8_SB(1, 1), b3 + hstep, voffB); PG8_STAGE(PG8_SA(1, 0), a3, voffA);
            PG8_WAIT_V(8); PG8_WAIT_L(0); PG8_BAR; PG8_MMA(1, 0, At, B0); PG8_MMA(1, 1, At, B1); PG8_BAR; PG8_SCHED;
            } else {
            PG8_LDB(B0, 0, 0); PG8_SCHED; PG8_LDA(At, 0, 0); PG8_STAGE(PG8_SA(1, 1), a1 + hstep, voffA);
            PG8_WAIT_L(8); PG8_BAR; PG8_WAIT_L(0); PG8_MMA(0, 0, At, B0); PG8_BAR; PG8_SCHED;
            PG8_LDB(B1, 0, 1); PG8_STAGE(PG8_SB(0, 0), b2, voffB);
            PG8_BAR; PG8_WAIT_L(0); PG8_MMA(0, 1, At, B1); PG8_BAR;
            PG8_LDA(At, 0, 1); PG8_STAGE(PG8_SA(0, 0), a2, voffA);
            PG8_BAR; PG8_WAIT_L(0); PG8_MMA(1, 0, At, B0); PG8_BAR; PG8_SCHED;
            PG8_STAGE(PG8_SB(0, 1), b2 + hstep, voffB);
            PG8_WAIT_V(6); PG8_BAR; PG8_MMA(1, 1, At, B1); PG8_BAR;
            PG8_LDB(B0, 1, 0); PG8_SCHED; PG8_LDA(At, 1, 0); PG8_STAGE(PG8_SA(0, 1), a2 + hstep, voffA);
            PG8_WAIT_L(8); PG8_BAR; PG8_WAIT_L(0); PG8_MMA(0, 0, At, B0); PG8_BAR; PG8_SCHED;
            PG8_LDB(B1, 1, 1); PG8_STAGE(PG8_SB(1, 0), b3, voffB);
            PG8_BAR; PG8_WAIT_L(0); PG8_MMA(0, 1, At, B1); PG8_BAR;
            PG8_LDA(At, 1, 1); PG8_STAGE(PG8_SA(1, 0), a3, voffA);
            PG8_BAR; PG8_WAIT_L(0); PG8_MMA(1, 0, At, B0); PG8_BAR; PG8_SCHED;
            PG8_STAGE(PG8_SB(1, 1), b3 + hstep, voffB);
            PG8_WAIT_V(6); PG8_BAR; PG8_MMA(1, 1, At, B1); PG8_BAR;
            }
        }
        if constexpr (ALIGN_EPI) { if (wr == 0) PG8_BAR; }
        if constexpr (!Epi::AFTER_DRAIN) { E(acc, cur, wr, wc, fr, fq); S.done(cur, ui); }
        if (!has_next) break;
#pragma unroll
        for (int a = 0; a < 2; ++a)
#pragma unroll
            for (int b = 0; b < 2; ++b)
#pragma unroll
                for (int m = 0; m < 4; ++m)
#pragma unroll
                    for (int n = 0; n < 2; ++n) acc[a][b][m][n] = (f32x4){0.f, 0.f, 0.f, 0.f};
        cur = nxt; cA = nA; cB = nB; ++ui;
        if constexpr (ALIGN_EPI) { if (wr == 1) PG8_BAR; }
    }
    PG8_WAIT_V(0);
    if constexpr (!ALIGN_EPI) { if (wr == 0) PG8_BAR; }
    PG8_BAR;
    if constexpr (Epi::AFTER_DRAIN) { E.fused(acc, cur, wr, wc, fr, fq, lds, wid, lane); S.done(cur, ui); }
#undef PG8_SA
#undef PG8_SB
#undef PG8_STAGE
#undef PG8_LDA
#undef PG8_LDB
#undef PG8_MMA
#undef PG8_WAIT_V
#undef PG8_WAIT_L
#undef PG8_BAR
#undef PG8_SCHED
}
}

constexpr int D = 1024, M_CTX = 32 * 256, M_LAT = 8 * 4096, MT = M_CTX + M_LAT;
constexpr int L_CTX = 256, L_LAT = 4096, NB_CTX = 32, NB_LAT = 8;
constexpr int D_IN = 3840, D_A = 512, NH = 8, HD = 64;
constexpr int C_R = 0, C_K = 512, C_V = 1024, C_ZA = 1536, C_WD = 2048, C_AD = 2176, C_U = 2304, C_VB = 2816, C_ZB = 3328;
constexpr float NORM_EPS = 1e-6f, GN_EPS = 6.4e-4f;
constexpr size_t STATE_ELEMS = (size_t)NB_CTX * NH * HD * HD;

constexpr size_t MiB = 1u << 20;
constexpr size_t WS_CTL = 0, CTL_ZERO_BYTES = 192 * 1024;
constexpr size_t CW_QUEUE = 15 * 1024;
constexpr size_t WS_MOD = 64 * 1024;
constexpr size_t WS_WIN = 1 * MiB;
constexpr size_t WS_WOUT = 9 * MiB;
constexpr size_t WS_WSB = 11 * MiB;
constexpr size_t WS_BS = 12 * MiB;
constexpr size_t WS_H = 412 * MiB;
constexpr size_t WS_PROJ = 96 * MiB;
constexpr size_t WS_OUTB = WS_PROJ + 64 * MiB;
constexpr size_t WS_G = 16 * MiB;
constexpr size_t WS_HMID = WS_G + (size_t)128 * 2048 * 64 * 2;
constexpr size_t WS_CORR = WS_HMID + (size_t)128 * 4096 * 2;
constexpr size_t WS_END = WS_H + (size_t)MT * D * 2;
static_assert(WS_CORR + (size_t)M_LAT * 512 * 2 <= WS_PROJ && WS_PROJ + (size_t)MT * D_IN * 2 <= WS_H, "ws map 2");
static_assert((size_t)M_CTX * D_IN * 2 <= 64 * MiB && 64 * MiB + (size_t)MT * D * 2 <= (size_t)MT * D_IN * 2, "OUTB overlay");
static_assert(WS_WIN + (size_t)D_IN * D * 2 <= WS_WOUT && WS_BS + (size_t)2 * MT * 8 * 4 <= WS_G, "ws map");

constexpr int LDS_BYTES = 163840;
constexpr int NWAVES = 8, NTHREADS = 512;

#define LAS __attribute__((address_space(3)))
#define GAS __attribute__((address_space(1)))
typedef unsigned short bf16;
typedef float f32x4 __attribute__((ext_vector_type(4)));
typedef short bf16x8 __attribute__((ext_vector_type(8)));
typedef unsigned u32x4v __attribute__((ext_vector_type(4)));
typedef unsigned u32x2v __attribute__((ext_vector_type(2)));

__device__ __forceinline__ float bf2f(unsigned b) { return __uint_as_float(b << 16); }
__device__ __forceinline__ unsigned f2bf(float f) { unsigned u = __float_as_uint(f); return (u + 0x7fffu + ((u >> 16) & 1u)) >> 16; }
__device__ __forceinline__ unsigned pk2(float lo, float hi) { return f2bf(lo) | (f2bf(hi) << 16); }
template <int CTRL> __device__ __forceinline__ float dpp_f(float v) { return __int_as_float(__builtin_amdgcn_update_dpp(0, __float_as_int(v), CTRL, 0xf, 0xf, true)); }
__device__ __forceinline__ float quad_sum4(float v) { v += dpp_f<0xB1>(v); v += dpp_f<0x4E>(v); return v; }
__device__ __forceinline__ float wave_sum(float v) {
    v += dpp_f<0xB1>(v); v += dpp_f<0x4E>(v);
    v += dpp_f<0x141>(v); v += dpp_f<0x140>(v);
    v += __int_as_float(__builtin_amdgcn_ds_swizzle(__float_as_int(v), 0x401F));
    return __int_as_float(__builtin_amdgcn_readlane(__float_as_int(v), 0)) + __int_as_float(__builtin_amdgcn_readlane(__float_as_int(v), 32));
}
__device__ __forceinline__ float silu_f(float x) { return x * __builtin_amdgcn_rcpf(1.0f + __builtin_amdgcn_exp2f(-1.44269504f * x)); }
__device__ __forceinline__ float sigmoid_f(float x) { return 1.0f / (1.0f + __expf(-x)); }

struct Params { const float* in[26]; float* out; unsigned char* ws; int ph_lo, ph_hi; };

#ifdef PROBE_KA
constexpr size_t CW_TS = 48 * 1024;
__device__ __forceinline__ void ts_mark(int k) { if (threadIdx.x == 0) { const Params* q = (const Params*)__builtin_amdgcn_kernarg_segment_ptr(); asm volatile("" : "+s"(q));
    ((unsigned*)(q->ws + CW_TS))[blockIdx.x * 16 + k] = (unsigned)__builtin_amdgcn_s_memrealtime(); } }
#define TS(ws, k) ts_mark(k)
#else
#define TS(ws, k) do {} while (0)
#endif
enum { I_XP = 0, I_XS, I_C, I_SF, I_SB, I_CCTX, I_LNPRE, I_LNPOST, I_WMOD, I_BMOD, I_WIN, I_TSMU, I_W0, I_WUP, I_A0, I_AUP, I_KK, I_KA, I_RK, I_GNW, I_GNB, I_SLG, I_SLB, I_WS, I_BSS, I_WOUT };

__device__ __forceinline__ void transpose_item(const float* W, int K, int N, bf16* WT, LAS float* scr, int item, int lane) {
    const int nblk = N / 32, kb = item / nblk, nb = item % nblk, k0 = 64 * kb, n0 = 32 * nb;
    float tv[32];
#pragma unroll
    for (int i = 0; i < 32; ++i) tv[i] = ((const GAS float*)W)[(size_t)(k0 + 2 * i + (lane >> 5)) * N + n0 + (lane & 31)];
#pragma unroll
    for (int i = 0; i < 32; ++i) scr[(2 * i + (lane >> 5)) * 33 + (lane & 31)] = tv[i];
    asm volatile("s_waitcnt lgkmcnt(0)" ::: "memory");
    const int c = lane & 7;
#pragma unroll
    for (int j = 0; j < 4; ++j) { const int n = (lane >> 3) + 8 * j; const LAS float* s = scr + (8 * c) * 33 + n;
        u32x4v o; o.x = pk2(s[0 * 33], s[1 * 33]); o.y = pk2(s[2 * 33], s[3 * 33]); o.z = pk2(s[4 * 33], s[5 * 33]); o.w = pk2(s[6 * 33], s[7 * 33]);
        *(u32x4v*)(WT + (size_t)(n0 + n) * K + k0 + 8 * c) = o; }
    asm volatile("s_waitcnt lgkmcnt(0)" ::: "memory");
}

__device__ __forceinline__ void phase0(const Params& P, LAS unsigned char* lds, int gw, int NGW, int wave, int lane) {
    unsigned char* ws = P.ws;
    float* mod = (float*)(ws + WS_MOD);
    const float* w_mod = P.in[I_WMOD]; const float* b_mod = P.in[I_BMOD]; const float* cc = P.in[I_C]; const float* cctx = P.in[I_CCTX];
    if (blockIdx.x < 96 && gridDim.x >= 96) {
        const int cgp = blockIdx.x % 12, rg = blockIdx.x / 12, col = cgp * 256 + lane * 4, r0 = rg * 128 + wave * 16;
        f32x4 acc[9];
#pragma unroll
        for (int v = 0; v < 9; ++v) acc[v] = (f32x4){0.f, 0.f, 0.f, 0.f};
        f32x4 w[16];
#pragma unroll
        for (int i = 0; i < 16; ++i) w[i] = *(const GAS f32x4*)((const GAS float*)w_mod + (size_t)(r0 + i) * 3072 + col);
#pragma unroll
        for (int i = 0; i < 16; ++i) {
#pragma unroll
            for (int v = 0; v < 9; ++v) { const float cv = (v == 0) ? cctx[r0 + i] : cc[(v - 1) * 1024 + r0 + i]; acc[v] += silu_f(cv) * w[i]; }
        }
        LAS f32x4* red = (LAS f32x4*)lds;
#pragma unroll
        for (int v = 0; v < 9; ++v) red[(wave * 9 + v) * 64 + lane] = acc[v];
        __syncthreads();
        for (int idx = wave * 64 + lane; idx < 9 * 64; idx += 512) {
            f32x4 s = red[idx];
#pragma unroll
            for (int w2 = 1; w2 < 8; ++w2) s += red[w2 * 576 + idx];
            const int v = idx >> 6, l = idx & 63, c2 = cgp * 256 + l * 4;
            if (rg == 0) s += *(const f32x4*)(b_mod + c2);
#pragma unroll
            for (int e = 0; e < 4; ++e) atomicAdd(mod + v * 3072 + c2 + e, s[e]);
        }
        __syncthreads();
    } else if (gridDim.x < 96) {
        for (int task = gw; task < 12 * 64; task += NGW) {
            const int cgp = task % 12, rs = task / 12, col = cgp * 256 + lane * 4;
            f32x4 acc[9];
#pragma unroll
            for (int v = 0; v < 9; ++v) acc[v] = (f32x4){0.f, 0.f, 0.f, 0.f};
            for (int i = rs * 16; i < rs * 16 + 16; ++i) { const f32x4 w = *(const GAS f32x4*)((const GAS float*)w_mod + (size_t)i * 3072 + col);
#pragma unroll
                for (int v = 0; v < 9; ++v) { const float cv = (v == 0) ? cctx[i] : cc[(v - 1) * 1024 + i]; acc[v] += silu_f(cv) * w; } }
            if (rs == 0) { const f32x4 b = *(const f32x4*)(b_mod + col);
#pragma unroll
                for (int v = 0; v < 9; ++v) acc[v] += b; }
#pragma unroll
            for (int v = 0; v < 9; ++v)
#pragma unroll
                for (int e = 0; e < 4; ++e) atomicAdd(mod + v * 3072 + col + e, acc[v][e]);
        }
    }
}

__device__ __forceinline__ void weight_copies(const Params& P, LAS unsigned char* lds, int gw, int NGW, int wave, int lane) {
    unsigned char* ws = P.ws;
    LAS float* scr = (LAS float*)(lds + wave * 16384);
    constexpr int I_1 = (D / 64) * (D_IN / 32), I_2 = (D / 64) * (D / 32);
    for (int it = gw; it < I_1 + I_2; it += NGW) {
        if (it < I_1) transpose_item(P.in[I_WIN], D, D_IN, (bf16*)(ws + WS_WIN), scr, it, lane);
        else transpose_item(P.in[I_WOUT], D, D, (bf16*)(ws + WS_WOUT), scr, it - I_1, lane);
    }
    { const float* w_s = P.in[I_WS]; bf16* wsb = (bf16*)(ws + WS_WSB);
      for (int i = gw * 64 + lane; i < 8 * 128 * 128 / 4; i += NGW * 64) { const f32x4 v = *(const f32x4*)(w_s + (size_t)i * 4); u32x2v o; o.x = pk2(v[0], v[1]); o.y = pk2(v[2], v[3]); *(u32x2v*)(wsb + (size_t)i * 4) = o; } }
}


__device__ __forceinline__ const GAS float* x_row(const Params& P, int m) { return (const GAS float*)(m < M_CTX ? P.in[I_XP] + (size_t)m * D : P.in[I_XS] + (size_t)(m - M_CTX) * D); }
__device__ __forceinline__ int mod_index(int m) { return m < M_CTX ? 0 : 1 + (m - M_CTX) / L_LAT; }

__device__ __forceinline__ void prenorm_rows(const Params& P, int m0, int nrows, int lane, const f32x4 (&gs)[4], const f32x4 (&sh)[4]) {
    f32x4 vn[4];
    { const GAS f32x4* xr = (const GAS f32x4*)x_row(P, m0) + lane;
#pragma unroll
      for (int j = 0; j < 4; ++j) vn[j] = __builtin_nontemporal_load(xr + 64 * j); }
#pragma unroll 1
    for (int r = 0; r < nrows; ++r) {
        const int m = m0 + r;
        f32x4 v[4];
#pragma unroll
        for (int j = 0; j < 4; ++j) v[j] = vn[j];
        if (r + 1 < nrows) { const GAS f32x4* xr = (const GAS f32x4*)x_row(P, m + 1) + lane;
#pragma unroll
            for (int j = 0; j < 4; ++j) vn[j] = __builtin_nontemporal_load(xr + 64 * j); }
        float ss = 0.f;
#pragma unroll
        for (int j = 0; j < 4; ++j) ss += (v[j].x * v[j].x + v[j].y * v[j].y) + (v[j].z * v[j].z + v[j].w * v[j].w);
        const float rstd = 1.0f / sqrtf(wave_sum(ss) * (1.0f / D) + NORM_EPS);
        GAS u32x2v* o8 = (GAS u32x2v*)((GAS bf16*)(P.ws + WS_H) + (size_t)m * D) + lane;
#pragma unroll
        for (int j = 0; j < 4; ++j) { const f32x4 o = v[j] * rstd * gs[j] + sh[j]; u32x2v w; w.x = pg8::cvt_pk_bf16(o.x, o.y); w.y = pg8::cvt_pk_bf16(o.z, o.w); o8[64 * j] = w; }
    }
}
__device__ __forceinline__ void prenorm_mod(const Params& P, int seg, int lane, f32x4 (&gs)[4], f32x4 (&sh)[4]) {
    const GAS float* mod = (const GAS float*)(P.ws + WS_MOD); const GAS float* ln_pre = (const GAS float*)P.in[I_LNPRE];
    const GAS float* shift = mod + seg * 3072; const GAS float* scale = shift + 1024;
#pragma unroll
    for (int j = 0; j < 4; ++j) { const int col = 4 * (lane + 64 * j); gs[j] = *(const GAS f32x4*)(ln_pre + col) * (1.0f + *(const GAS f32x4*)(scale + col)); sh[j] = *(const GAS f32x4*)(shift + col); }
}
__device__ __forceinline__ void phase1(const Params& P, int gw, int NGW, int lane) {
    const GAS float* mod = (const GAS float*)(P.ws + WS_MOD); const GAS float* ln_pre = (const GAS float*)P.in[I_LNPRE]; GAS bf16* H = (GAS bf16*)(P.ws + WS_H);
#pragma unroll 1
    for (int seg = 0; seg < 9; ++seg) {
        const int m_lo = (seg == 0) ? 0 : M_CTX + (seg - 1) * L_LAT, m_hi = (seg == 0) ? M_CTX : m_lo + L_LAT;
        const GAS float* shift = mod + seg * 3072; const GAS float* scale = shift + 1024;
        f32x4 gs[4], sh[4];
#pragma unroll
        for (int j = 0; j < 4; ++j) { const int col = 4 * (lane + 64 * j); gs[j] = *(const GAS f32x4*)(ln_pre + col) * (1.0f + *(const GAS f32x4*)(scale + col)); sh[j] = *(const GAS f32x4*)(shift + col); }
        for (int m = m_lo + gw; m < m_hi; m += NGW) {
            const GAS f32x4* xr = (const GAS f32x4*)x_row(P, m) + lane;
            f32x4 v[4]; float ss = 0.f;
#pragma unroll
            for (int j = 0; j < 4; ++j) { v[j] = xr[64 * j]; ss += (v[j].x * v[j].x + v[j].y * v[j].y) + (v[j].z * v[j].z + v[j].w * v[j].w); }
            const float rstd = 1.0f / sqrtf(wave_sum(ss) * (1.0f / D) + NORM_EPS);
            GAS u32x2v* o8 = (GAS u32x2v*)(H + (size_t)m * D) + lane;
#pragma unroll
            for (int j = 0; j < 4; ++j) { const f32x4 o = v[j] * rstd * gs[j] + sh[j]; u32x2v w; w.x = pk2(o.x, o.y); w.y = pk2(o.z, o.w); o8[64 * j] = w; }
        }
    }
}

constexpr int CH_RKV_LD = 200, CH_TW_LD = 72, CH_I1_LD = 72, CH_I2_LD = 40, CH_G_LD = 40;
constexpr int CH_RKV = 0, CH_TW = 26400, CH_AD = 35616, CH_WUPT = 44832, CH_AUPT = 54048, CH_IMG = 63264, CH_IMG_STRIDE = 30720;
constexpr int CH_GRAM_STRIDE = 17920;
constexpr int CH_HF = 124704, CH_N2 = 141088, CH_EC = 141344, CH_BPART = 141856, CH_KTAB = 142880, CH_HF2 = 143648, CH_END = 160032;
static_assert(2 * CH_GRAM_STRIDE <= CH_WUPT && CH_IMG + 2 * CH_IMG_STRIDE == CH_HF && CH_END <= LDS_BYTES - 64, "chain LDS map");

typedef unsigned short us4 __attribute__((ext_vector_type(4)));
#define MFMA16(a, b, c) __builtin_amdgcn_mfma_f32_16x16x32_bf16((a), (b), (c), 0, 0, 0)
__device__ __forceinline__ bf16x8 ldfrag(const LAS bf16* img, int ld, int row0, int k0, int lane) { return *(const LAS bf16x8*)(img + (row0 + (lane & 15)) * ld + k0 + 8 * (lane >> 4)); }
typedef float f32x2c __attribute__((ext_vector_type(2)));
typedef __bf16 bf16x2c __attribute__((ext_vector_type(2)));
__device__ __forceinline__ unsigned cvtpk(float lo, float hi) { f32x2c v; v.x = lo; v.y = hi; return __builtin_bit_cast(unsigned, __builtin_convertvector(v, bf16x2c)); }
__device__ __forceinline__ void st_nm(LAS bf16* img, int ld, int n0, int m0, f32x4 c, int lane) {
    u32x2v o; o.x = cvtpk(c[0], c[1]); o.y = cvtpk(c[2], c[3]); *(LAS u32x2v*)(img + (n0 + (lane & 15)) * ld + m0 + 4 * (lane >> 4)) = o; }
__device__ __forceinline__ void st_mn(LAS bf16* img, int ld, int m0, int n0, f32x4 c, int lane) {
#pragma unroll
    for (int e = 0; e < 4; e += 2) { const unsigned w = cvtpk(c[e], c[e + 1]); LAS bf16* p = img + (m0 + 4 * (lane >> 4) + e) * ld + n0 + (lane & 15); p[0] = (bf16)(w & 0xffffu); p[ld] = (bf16)(w >> 16); } }
__device__ __forceinline__ float fast_sigmoid(float x) { return __builtin_amdgcn_rcpf(1.0f + __builtin_amdgcn_exp2f(-1.44269504f * x)); }
__device__ __forceinline__ float fast_tanh(float x) { return 1.0f - 2.0f * __builtin_amdgcn_rcpf(1.0f + __builtin_amdgcn_exp2f(2.88539008f * x)); }
__device__ __forceinline__ float row16_sum(float v) { v += dpp_f<0xB1>(v); v += dpp_f<0x4E>(v); v += dpp_f<0x141>(v); v += dpp_f<0x140>(v); return v; }
__device__ __forceinline__ float oct_sum(float v) { v += dpp_f<0xB1>(v); v += dpp_f<0x4E>(v); v += dpp_f<0x141>(v); return v; }

typedef short bf16x4 __attribute__((ext_vector_type(4)));
#define MF16(a, b, c) __builtin_amdgcn_mfma_f32_16x16x16bf16_1k((a), (b), (c), 0, 0, 0)
__device__ __forceinline__ bf16x4 frag4(f32x4 c) { u32x2v o; o.x = cvtpk(c[0], c[1]); o.y = cvtpk(c[2], c[3]); return __builtin_bit_cast(bf16x4, o); }
__device__ __forceinline__ bf16x4 ldfrag4(const LAS bf16* img, int ld, int row0, int k0, int lane) { return *(const LAS bf16x4*)(img + (row0 + (lane & 15)) * ld + k0 + 4 * (lane >> 4)); }
typedef short s16x4c __attribute__((ext_vector_type(4)));
__device__ __forceinline__ bf16x8 ldfrag_tr(const LAS bf16* img, int ld, int col0, int k0, int lane) {
    const LAS bf16* p = img + (k0 + 8 * (lane >> 4) + ((lane & 15) >> 2)) * ld + col0 + 4 * (lane & 3);
    const s16x4c lo = __builtin_amdgcn_ds_read_tr16_b64_v4i16((LAS s16x4c*)p), hi = __builtin_amdgcn_ds_read_tr16_b64_v4i16((LAS s16x4c*)(p + 4 * ld));
    return (bf16x8){lo[0], lo[1], lo[2], lo[3], hi[0], hi[1], hi[2], hi[3]}; }
__device__ __forceinline__ bf16x4 ldfrag4_tr(const LAS bf16* img, int ld, int col0, int k0, int lane) {
    const LAS bf16* p = img + (k0 + 4 * (lane >> 4) + ((lane & 15) >> 2)) * ld + col0 + 4 * (lane & 3);
    return __builtin_bit_cast(bf16x4, __builtin_amdgcn_ds_read_tr16_b64_v4i16((LAS s16x4c*)p)); }
#define OPQ(v) asm volatile("" : "+v"(v))
struct RawRegs { u32x4v v[6]; };
__device__ __forceinline__ void chain_prefetch(RawRegs& R, const GAS bf16* proj, int m0, int L, int h, int dir, int ss, int tid, int p0) {
    OPQ(tid);
    const int qm = tid >> 3, pc = tid & 7, p = p0 + ss * 64 + qm, t = dir ? (L - 1 - p) : p;
    const GAS bf16* row = proj + (size_t)(m0 + t) * D_IN;
#pragma unroll
    for (int x = 0; x < 3; ++x) R.v[x] = *(const GAS u32x4v*)(row + x * 512 + h * 64 + pc * 8);
    R.v[4] = *(const GAS u32x4v*)(row + C_WD + dir * 64 + pc * 8);
    R.v[5] = *(const GAS u32x4v*)(row + C_AD + dir * 64 + pc * 8);
    u32x4v hv = (u32x4v){0u, 0u, 0u, 0u};
    if (tid < 48) { const int hi = tid >= 24, rem = hi ? tid - 24 : tid, x = rem >> 3, pc2 = rem & 7, ph = hi ? p0 + ss * 64 + 64 : p0 + ss * 64 - 1;
        if (ph >= 0 && ph < L) { const int th = dir ? (L - 1 - ph) : ph; hv = *(const GAS u32x4v*)(proj + (size_t)(m0 + th) * D_IN + x * 512 + h * 64 + pc2 * 8); } }
    R.v[3] = hv;
}
__device__ __forceinline__ void chain_stage_raw(const RawRegs& R, LAS unsigned char* lds, int tid) {
    OPQ(tid);
    const int qm = tid >> 3, pc = tid & 7;
#pragma unroll
    for (int x = 0; x < 3; ++x) *(LAS u32x4v*)(lds + CH_RKV + ((qm + 1) * CH_RKV_LD + x * 64 + pc * 8) * 2) = R.v[x];
    if (tid < 48) { const int hi = tid >= 24, rem = hi ? tid - 24 : tid, x = rem >> 3, pc2 = rem & 7;
        *(LAS u32x4v*)(lds + CH_RKV + ((hi ? 65 : 0) * CH_RKV_LD + x * 64 + pc2 * 8) * 2) = R.v[3]; }
    *(LAS u32x4v*)(lds + CH_TW + (qm * CH_TW_LD + pc * 8) * 2) = R.v[4];
    *(LAS u32x4v*)(lds + CH_AD + (qm * CH_TW_LD + pc * 8) * 2) = R.v[5];
}

__device__ __forceinline__ void do_chain(const Params& P, LAS unsigned char* lds, int m0, int L, int h, int dir, const float* s0, float* sfin, int p0, int npt, int mode, int chain) {
    const int tid = threadIdx.x, lane0 = tid & 63, wave = __builtin_amdgcn_readfirstlane(tid >> 6);
    const int grp = wave >> 2, cc = wave & 3;
#define STAGE_LANE() int ln_ = lane0; OPQ(ln_); const int lane = ln_, lr = lane & 15, lg = lane >> 4, c = 16 * cc + lr, vcol = c; (void)lr; (void)lg; (void)c; (void)vcol
    const GAS bf16* proj = (const GAS bf16*)(P.ws + WS_PROJ);
    GAS bf16* YD = (GAS bf16*)P.out; GAS float* BS = (GAS float*)(P.ws + WS_BS);
    const int nss = npt / 64;
    const int cj = h * 64 + 16 * cc + (lane0 & 15);
    const GAS float* ts_mu = (const GAS float*)P.in[I_TSMU];
    const float mlo_r = ts_mu[(dir ? 1536 : 0) + C_R + cj], mhi_r = ts_mu[(dir ? 0 : 1536) + C_R + cj];
    const float mlo_k = ts_mu[(dir ? 1536 : 0) + C_K + cj], mhi_k = ts_mu[(dir ? 0 : 1536) + C_K + cj];
    const float mlo_v = ts_mu[(dir ? 1536 : 0) + C_V + cj], mhi_v = ts_mu[(dir ? 0 : 1536) + C_V + cj];
    const float mc_r = 1.0f - mlo_r - mhi_r, mc_k = 1.0f - mlo_k - mhi_k, mc_v = 1.0f - mlo_v - mhi_v;
    const float w0c = -1.44269504f * ((const GAS float*)P.in[I_W0])[dir * 512 + cj], a0c = -1.44269504f * ((const GAS float*)P.in[I_A0])[dir * 512 + cj];
    const float kkc = ((const GAS float*)P.in[I_KK])[dir * 512 + cj], kac = ((const GAS float*)P.in[I_KA])[dir * 512 + cj], rkc = ((const GAS float*)P.in[I_RK])[dir * 512 + cj], kac1 = 1.0f - kac;
    LAS float* ktab = (LAS float*)(lds + CH_KTAB);
    if (tid < 64) { const int c8 = h * 64 + tid; ktab[tid] = ((const GAS float*)P.in[I_KK])[dir * 512 + c8]; ktab[64 + tid] = ts_mu[(dir ? 1536 : 0) + C_K + c8]; ktab[128 + tid] = ts_mu[(dir ? 0 : 1536) + C_K + c8]; }
    { LAS bf16* wupt = (LAS bf16*)(lds + CH_WUPT); LAS bf16* aupt = (LAS bf16*)(lds + CH_AUPT);
      const GAS float* wu = (const GAS float*)P.in[I_WUP] + (size_t)dir * 64 * 512 + h * 64; const GAS float* au = (const GAS float*)P.in[I_AUP] + (size_t)dir * 64 * 512 + h * 64;
#pragma unroll 1
      for (int kb = 0; kb < 2; ++kb) { float wv[4], av[4];
#pragma unroll
          for (int k = 0; k < 4; ++k) { const int idx = tid + 512 * (4 * kb + k), i = idx >> 6, c2 = idx & 63; wv[k] = wu[(size_t)i * 512 + c2]; av[k] = au[(size_t)i * 512 + c2]; }
#pragma unroll
          for (int k = 0; k < 4; ++k) { const int idx = tid + 512 * (4 * kb + k), i = idx >> 6, c2 = idx & 63; wupt[c2 * CH_TW_LD + i] = (bf16)f2bf(wv[k]); aupt[c2 * CH_TW_LD + i] = (bf16)f2bf(av[k]); } } }
    if (grp == 0) { STAGE_LANE(); LAS f32x4* hf = (LAS f32x4*)(lds + CH_HF) + cc * 256 + lane;
#pragma unroll
        for (int mt = 0; mt < 4; ++mt) hf[64 * mt] = s0 ? *(const f32x4*)(s0 + vcol * 64 + 16 * mt + 4 * lg) : (f32x4){0.f, 0.f, 0.f, 0.f};
        if (mode == 2) { LAS f32x4* hf2 = (LAS f32x4*)(lds + CH_HF2) + cc * 256 + lane;
#pragma unroll
            for (int mt = 0; mt < 4; ++mt) { f32x4 id;
#pragma unroll
                for (int e = 0; e < 4; ++e) id[e] = (mt == cc && lr == 4 * lg + e) ? 1.f : 0.f;
                hf2[64 * mt] = id; } }
    }
    RawRegs RR;
    chain_prefetch(RR, proj, m0, L, h, dir, 0, tid, p0);
    chain_stage_raw(RR, lds, tid);
    __syncthreads();
    LAS unsigned char* img = lds + CH_IMG + grp * CH_IMG_STRIDE;
    LAS bf16* I2_A = (LAS bf16*)(img), *I2_B = (LAS bf16*)(img + 5120), *I2_K = (LAS bf16*)(img + 10240), *I2_V = (LAS bf16*)(img + 15360), *I2_R = (LAS bf16*)(img + 20480), *I2_Q = (LAS bf16*)(img + 25600);
    LAS unsigned char* gram = lds + grp * CH_GRAM_STRIDE;
    LAS bf16* GX = (LAS bf16*)(gram), *GXT = (LAS bf16*)(gram + 2560), *GYT = (LAS bf16*)(gram + 5120), *GT = (LAS bf16*)(gram + 7680);
    LAS bf16* GLAK = (LAS bf16*)(gram + 10240), *GMRB = (LAS bf16*)(gram + 12800), *GMRK = (LAS bf16*)(gram + 15360);
    LAS float* n2s = (LAS float*)(lds + CH_N2); LAS float* ecs = (LAS float*)(lds + CH_EC); LAS float* bpart = (LAS float*)(lds + CH_BPART);
    const LAS bf16* rkv = (const LAS bf16*)(lds + CH_RKV);
    const f32x4 z4 = (f32x4){0.f, 0.f, 0.f, 0.f};

    for (int ss = 0; ss < nss; ++ss) {
        { STAGE_LANE(); const int tk = lane >> 3, cg = lane & 7, q = 8 * wave + tk + 1;
          const LAS bf16* kp = rkv + q * CH_RKV_LD + 64 + 8 * cg;
          const u32x4v lo = *(const LAS u32x4v*)(kp - CH_RKV_LD), mi = *(const LAS u32x4v*)kp, hi = *(const LAS u32x4v*)(kp + CH_RKV_LD);
          float s = 0.f;
#pragma unroll
          for (int hh2 = 0; hh2 < 2; ++hh2) { const f32x4 ckk = *(const LAS f32x4*)(ktab + 8 * cg + 4 * hh2), clo = *(const LAS f32x4*)(ktab + 64 + 8 * cg + 4 * hh2), chi = *(const LAS f32x4*)(ktab + 128 + 8 * cg + 4 * hh2);
#pragma unroll
              for (int e2 = 0; e2 < 4; ++e2) { const int e = 4 * hh2 + e2; const unsigned sh = (e & 1) ? 16u : 0u; const float kl = bf2f((lo[e >> 1] >> sh) & 0xffffu), kc = bf2f((mi[e >> 1] >> sh) & 0xffffu), kh = bf2f((hi[e >> 1] >> sh) & 0xffffu);
                  const float k = (kc + clo[e2] * (kl - kc) + chi[e2] * (kh - kc)) * ckk[e2]; s += k * k; } }
          s = oct_sum(s);
          if (cg == 0) n2s[8 * wave + tk] = __builtin_amdgcn_rsqf(s + 1e-12f); }
        f32x4 wl[2], al[2];
        { STAGE_LANE(); const LAS bf16* tw = (const LAS bf16*)(lds + CH_TW); const LAS bf16* ad = (const LAS bf16*)(lds + CH_AD);
          const LAS bf16* wupt = (const LAS bf16*)(lds + CH_WUPT); const LAS bf16* aupt = (const LAS bf16*)(lds + CH_AUPT);
#pragma unroll
          for (int tt = 0; tt < 2; ++tt) { wl[tt] = z4; al[tt] = z4;
#pragma unroll
              for (int ks = 0; ks < 2; ++ks) {
                  wl[tt] = MFMA16(ldfrag(tw, CH_TW_LD, 32 * grp + 16 * tt, 32 * ks, lane), ldfrag(wupt, CH_TW_LD, 16 * cc, 32 * ks, lane), wl[tt]);
                  al[tt] = MFMA16(ldfrag(ad, CH_TW_LD, 32 * grp + 16 * tt, 32 * ks, lane), ldfrag(aupt, CH_TW_LD, 16 * cc, 32 * ks, lane), al[tt]); } } }
        __syncthreads();
        { STAGE_LANE(); float lw[2][4];
#pragma unroll
          for (int tt = 0; tt < 2; ++tt)
#pragma unroll
              for (int e = 0; e < 4; ++e) lw[tt][e] = -0.87506130f * __builtin_amdgcn_rcpf(1.0f + __builtin_amdgcn_exp2f(__builtin_fmaf(wl[tt][e], -1.44269504f, w0c)));
          float gin[2][4], run[2];
#pragma unroll
          for (int tt = 0; tt < 2; ++tt) { gin[tt][0] = lw[tt][0]; gin[tt][1] = gin[tt][0] + lw[tt][1]; gin[tt][2] = gin[tt][1] + lw[tt][2]; gin[tt][3] = gin[tt][2] + lw[tt][3]; run[tt] = gin[tt][3]; }
          float off[2], tot0;
          { float r1 = run[0]; float t1 = __shfl_up(r1, 16); if (lg >= 1) r1 += t1; float t2 = __shfl_up(r1, 32); if (lg >= 2) r1 += t2; off[0] = r1 - run[0]; tot0 = __shfl(r1, 48 + lr); }
          { float r1 = run[1]; float t1 = __shfl_up(r1, 16); if (lg >= 1) r1 += t1; float t2 = __shfl_up(r1, 32); if (lg >= 2) r1 += t2; off[1] = r1 - run[1] + tot0;
            const float tot = __shfl(r1, 48 + lr) + tot0; if (lg == 0) ecs[grp * 64 + c] = __builtin_amdgcn_exp2f(tot); }
#pragma unroll
          for (int tt = 0; tt < 2; ++tt) {
              const int q0 = 32 * grp + 16 * tt + 4 * lg;
              float xr[6], xk[6], xv[6];
              { const LAS bf16* tp = rkv + (q0 + (lr >> 2)) * CH_RKV_LD + 16 * cc + 4 * (lr & 3);
#pragma unroll
                for (int x = 0; x < 3; ++x) { const s16x4c lo = __builtin_amdgcn_ds_read_tr16_b64_v4i16((LAS s16x4c*)(tp + 64 * x)), hi = __builtin_amdgcn_ds_read_tr16_b64_v4i16((LAS s16x4c*)(tp + 64 * x + 4 * CH_RKV_LD));
                    float* dst = (x == 0) ? xr : (x == 1) ? xk : xv;
#pragma unroll
                    for (int e = 0; e < 4; ++e) dst[e] = bf2f((unsigned)(unsigned short)lo[e]);
                    dst[4] = bf2f((unsigned)(unsigned short)hi[0]); dst[5] = bf2f((unsigned)(unsigned short)hi[1]); } }
              const f32x4 n2 = *(const LAS f32x4*)(n2s + 32 * grp + 16 * tt + 4 * lg);
              f32x4 fa, fb, fk, fr, fv; float exprev = 1.f;
#pragma unroll
              for (int e = 0; e < 4; ++e) {
                  const float r = mc_r * xr[e + 1] + mlo_r * xr[e] + mhi_r * xr[e + 2];
                  const float k = mc_k * xk[e + 1] + mlo_k * xk[e] + mhi_k * xk[e + 2];
                  const float v = mc_v * xv[e + 1] + mlo_v * xv[e] + mhi_v * xv[e + 2];
                  const float a = __builtin_amdgcn_rcpf(1.0f + __builtin_amdgcn_exp2f(__builtin_fmaf(al[tt][e], -1.44269504f, a0c)));
                  const float kk = k * kkc * n2[e];
                  const float kdv = k * __builtin_fmaf(a, kac, kac1);
                  const float g = gin[tt][e] + off[tt];
                  const float ex = __builtin_amdgcn_exp2f(g), ie = __builtin_amdgcn_exp2f(-g), ep = (e == 0) ? __builtin_amdgcn_exp2f(g - lw[tt][e]) : exprev; exprev = ex;
                  fa[e] = -kk * ep; fb[e] = kk * a * ie; fk[e] = kdv * ie; fr[e] = r * ex; fv[e] = v; }
              const f32x4 fq = fr * rkc;
              const int t0 = 16 * tt + 4 * lg;
              u32x2v oa, ob, ok, orr, ov, oq; oq.x = cvtpk(fq[0], fq[1]); oq.y = cvtpk(fq[2], fq[3]);
              oa.x = cvtpk(fa[0], fa[1]); oa.y = cvtpk(fa[2], fa[3]); ob.x = cvtpk(fb[0], fb[1]); ob.y = cvtpk(fb[2], fb[3]); ok.x = cvtpk(fk[0], fk[1]); ok.y = cvtpk(fk[2], fk[3]);
              orr.x = cvtpk(fr[0], fr[1]); orr.y = cvtpk(fr[2], fr[3]); ov.x = cvtpk(fv[0], fv[1]); ov.y = cvtpk(fv[2], fv[3]);
              *(LAS u32x2v*)(I2_A + c * CH_I2_LD + t0) = oa; *(LAS u32x2v*)(I2_B + c * CH_I2_LD + t0) = ob; *(LAS u32x2v*)(I2_K + c * CH_I2_LD + t0) = ok; *(LAS u32x2v*)(I2_V + c * CH_I2_LD + t0) = ov; *(LAS u32x2v*)(I2_R + c * CH_I2_LD + t0) = orr; *(LAS u32x2v*)(I2_Q + c * CH_I2_LD + t0) = oq;
          } }
        __syncthreads();
        f32x4 kv[4];
        { STAGE_LANE();
          if (cc != 0) { const bf16x8 vb = ldfrag(I2_V, CH_I2_LD, 16 * cc, 0, lane);
#pragma unroll
            for (int mt = 0; mt < 4; ++mt) kv[mt] = MFMA16(ldfrag(I2_K, CH_I2_LD, 16 * mt, 0, lane), vb, z4); }
          if (cc != 0) {
              const LAS bf16* GA = (cc < 2) ? I2_A : I2_R; const LAS bf16* GB = (cc & 1) ? I2_K : I2_B;
              f32x4 g00 = z4, g10 = z4, g11 = z4;
              bf16x8 fa[2][2], fb[2][2];
#pragma unroll
              for (int ks = 0; ks < 2; ++ks) { fa[ks][0] = ldfrag_tr(GA, CH_I2_LD, 0, 32 * ks, lane); fa[ks][1] = ldfrag_tr(GA, CH_I2_LD, 16, 32 * ks, lane); fb[ks][0] = ldfrag_tr(GB, CH_I2_LD, 0, 32 * ks, lane); fb[ks][1] = ldfrag_tr(GB, CH_I2_LD, 16, 32 * ks, lane); }
#pragma unroll
              for (int ks = 0; ks < 2; ++ks) { g00 = MFMA16(fa[ks][0], fb[ks][0], g00); g10 = MFMA16(fa[ks][1], fb[ks][0], g10); g11 = MFMA16(fa[ks][1], fb[ks][1], g11); }
              const bool strict = cc < 2;
#pragma unroll
              for (int e = 0; e < 4; ++e) { const int m = 4 * lg + e; const bool keep = strict ? (lr < m) : (lr <= m); g00[e] = keep ? g00[e] : 0.f; g11[e] = keep ? g11[e] : 0.f; }
              if (cc == 3) {
                  f32x4 d0 = z4, d1 = z4;
#pragma unroll
                  for (int ks = 0; ks < 2; ++ks) { d0 = MFMA16(ldfrag_tr(I2_Q, CH_I2_LD, 0, 32 * ks, lane), ldfrag_tr(I2_K, CH_I2_LD, 0, 32 * ks, lane), d0);
                      d1 = MFMA16(ldfrag_tr(I2_Q, CH_I2_LD, 16, 32 * ks, lane), ldfrag_tr(I2_K, CH_I2_LD, 16, 32 * ks, lane), d1); }
                  if ((lr >> 2) == lg) { const int e = lr & 3; const float b0 = (e == 0) ? d0[0] : (e == 1) ? d0[1] : (e == 2) ? d0[2] : d0[3], b1 = (e == 0) ? d1[0] : (e == 1) ? d1[1] : (e == 2) ? d1[2] : d1[3];
                      const int p = p0 + ss * 64 + 32 * grp + lr, t = dir ? (L - 1 - p) : p, t2 = dir ? (t - 16) : (t + 16);
                      BS[((size_t)dir * MT + m0 + t) * 8 + h] = b0; BS[((size_t)dir * MT + m0 + t2) * 8 + h] = b1; }
              }
              LAS bf16* dst = (cc == 1) ? GLAK : (cc == 2) ? GMRB : GMRK;
              st_mn(dst, CH_G_LD, 0, 0, g00, lane); st_mn(dst, CH_G_LD, 16, 0, g10, lane); st_mn(dst, CH_G_LD, 16, 16, g11, lane); st_mn(dst, CH_G_LD, 0, 16, z4, lane);
          } else {
              f32x4 x00 = z4, x11 = z4, t00 = z4, t01 = z4, t11 = z4;
              { bf16x8 fa[2][2], fb[2][2];
#pragma unroll
                for (int ks = 0; ks < 2; ++ks) { fa[ks][0] = ldfrag_tr(I2_A, CH_I2_LD, 0, 32 * ks, lane); fa[ks][1] = ldfrag_tr(I2_A, CH_I2_LD, 16, 32 * ks, lane); fb[ks][0] = ldfrag_tr(I2_B, CH_I2_LD, 0, 32 * ks, lane); fb[ks][1] = ldfrag_tr(I2_B, CH_I2_LD, 16, 32 * ks, lane); }
#pragma unroll
                for (int ks = 0; ks < 2; ++ks) { x00 = MFMA16(fa[ks][0], fb[ks][0], x00); x11 = MFMA16(fa[ks][1], fb[ks][1], x11);
                    t00 = MFMA16(fb[ks][0], fa[ks][0], t00); t01 = MFMA16(fb[ks][0], fa[ks][1], t01); t11 = MFMA16(fb[ks][1], fa[ks][1], t11); } }
              f32x4 y00, y10, y11, yt11;
#pragma unroll
              for (int e = 0; e < 4; ++e) { const int m = 4 * lg + e; x00[e] = (lr < m) ? x00[e] : 0.f; x11[e] = (lr < m) ? x11[e] : 0.f; t00[e] = (m < lr) ? t00[e] : 0.f; t11[e] = (m < lr) ? t11[e] : 0.f; y00[e] = (lr == m) ? 1.f : 0.f; }
              y11 = y00; yt11 = y00;
#pragma unroll 1
              for (int lev = 0; lev < 4; ++lev) {
                  const bf16x4 fx00 = frag4(x00), fx11 = frag4(x11), ft00 = frag4(t00), ft11 = frag4(t11), fy00 = frag4(y00), fy11 = frag4(y11);
                  y00 = MF16(ft00, fy00, y00); y11 = MF16(ft11, fy11, y11); yt11 = MF16(fy11, ft11, yt11);
                  if (lev < 3) { const f32x4 n00 = MF16(ft00, fx00, z4), n11 = MF16(ft11, fx11, z4), m00 = MF16(fx00, ft00, z4), m11 = MF16(fx11, ft11, z4);
                      x00 = n00; x11 = n11; t00 = m00; t11 = m11; }
              }
              { const f32x4 zz = MF16(frag4(t01), frag4(y00), z4);
                y10 = MF16(frag4(yt11), frag4(zz), z4); }
              st_mn(GT, CH_G_LD, 0, 0, y00, lane); st_mn(GT, CH_G_LD, 16, 0, y10, lane); st_mn(GT, CH_G_LD, 16, 16, y11, lane); st_mn(GT, CH_G_LD, 0, 16, z4, lane);
              { const bf16x8 vb = ldfrag(I2_V, CH_I2_LD, 16 * cc, 0, lane);
#pragma unroll
                for (int mt = 0; mt < 4; ++mt) kv[mt] = MFMA16(ldfrag(I2_K, CH_I2_LD, 16 * mt, 0, lane), vb, z4); }
          } }
        if (ss + 1 < nss) chain_prefetch(RR, proj, m0, L, h, dir, ss + 1, tid, p0);
        __syncthreads();
        f32x4 y0[2], u0[2]; bf16x4 apf[2][4];
        { STAGE_LANE(); const bf16x8 vb = ldfrag(I2_V, CH_I2_LD, 16 * cc, 0, lane);
          const f32x4 w0 = MFMA16(ldfrag(GLAK, CH_G_LD, 0, 0, lane), vb, z4), w1 = MFMA16(ldfrag(GLAK, CH_G_LD, 16, 0, lane), vb, z4);
          y0[0] = MFMA16(ldfrag(GMRK, CH_G_LD, 0, 0, lane), vb, z4); y0[1] = MFMA16(ldfrag(GMRK, CH_G_LD, 16, 0, lane), vb, z4);
          { const bf16x8 ta0 = ldfrag(GT, CH_G_LD, 0, 0, lane), ta1 = ldfrag(GT, CH_G_LD, 16, 0, lane);
#pragma unroll
            for (int mt = 0; mt < 4; ++mt) { const bf16x8 at = ldfrag(I2_A, CH_I2_LD, 16 * mt, 0, lane); apf[0][mt] = frag4(MFMA16(at, ta0, z4)); apf[1][mt] = frag4(MFMA16(at, ta1, z4)); } }
          const bf16x4 fw0 = frag4(w0), fw1 = frag4(w1);
          u0[0] = MF16(ldfrag4(GT, CH_G_LD, 0, 0, lane), fw0, z4);
          u0[1] = MF16(ldfrag4(GT, CH_G_LD, 16, 16, lane), fw1, MF16(ldfrag4(GT, CH_G_LD, 16, 0, lane), fw0, z4)); }
        { STAGE_LANE(); LAS f32x4* hf = (LAS f32x4*)(lds + CH_HF) + cc * 256 + lane;
          bf16x4 rf[2][4], bfr[4][2], mbf[3]; f32x4 ecv[4];
#pragma unroll
          for (int mt = 0; mt < 4; ++mt) {
              bfr[mt][0] = ldfrag4(I2_B, CH_I2_LD, 16 * mt, 0, lane); bfr[mt][1] = ldfrag4(I2_B, CH_I2_LD, 16 * mt, 16, lane); ecv[mt] = *(const LAS f32x4*)(ecs + grp * 64 + 16 * mt + 4 * lg); }
#define LOAD_PART_B() do { _Pragma("unroll") for (int mt = 0; mt < 4; ++mt) { rf[0][mt] = ldfrag4_tr(I2_R, CH_I2_LD, 0, 16 * mt, lane); rf[1][mt] = ldfrag4_tr(I2_R, CH_I2_LD, 16, 16 * mt, lane); } \
          mbf[0] = ldfrag4(GMRB, CH_G_LD, 0, 0, lane); mbf[1] = ldfrag4(GMRB, CH_G_LD, 16, 0, lane); mbf[2] = ldfrag4(GMRB, CH_G_LD, 16, 16, lane); } while (0)
          if (grp == 1) LOAD_PART_B();
          bf16x4 fH[4], fU0, fU1, fHP[4], fUP0, fUP1;
#pragma unroll
          for (int mt = 0; mt < 4; ++mt) fHP[mt] = (bf16x4){0, 0, 0, 0};
          fUP0 = fUP1 = (bf16x4){0, 0, 0, 0};
#pragma unroll 1
          for (int sg = 0; sg < 2; ++sg) {
              if (grp == sg) {
                  f32x4 hh[4];
#pragma unroll
                  for (int mt = 0; mt < 4; ++mt) { hh[mt] = hf[64 * mt]; fH[mt] = frag4(hh[mt]); }
                  f32x4 uu0 = u0[0], uu1 = u0[1];
#pragma unroll
                  for (int mt = 0; mt < 4; ++mt) { uu0 = MF16(apf[0][mt], fH[mt], uu0); uu1 = MF16(apf[1][mt], fH[mt], uu1); }
                  fU0 = frag4(uu0); fU1 = frag4(uu1);
#pragma unroll
                  for (int mt = 0; mt < 4; ++mt) { f32x4 acc = hh[mt] + kv[mt]; acc = MF16(bfr[mt][0], fU0, acc); acc = MF16(bfr[mt][1], fU1, acc); hf[64 * mt] = acc * ecv[mt]; }
                  if (mode == 2) {
                      LAS f32x4* hf2 = (LAS f32x4*)(lds + CH_HF2) + cc * 256 + lane; f32x4 hp[4];
#pragma unroll
                      for (int mt = 0; mt < 4; ++mt) { hp[mt] = hf2[64 * mt]; fHP[mt] = frag4(hp[mt]); }
                      f32x4 up0 = z4, up1 = z4;
#pragma unroll
                      for (int mt = 0; mt < 4; ++mt) { up0 = MF16(apf[0][mt], fHP[mt], up0); up1 = MF16(apf[1][mt], fHP[mt], up1); }
                      fUP0 = frag4(up0); fUP1 = frag4(up1);
#pragma unroll
                      for (int mt = 0; mt < 4; ++mt) { f32x4 acc = MF16(bfr[mt][0], fUP0, hp[mt]); acc = MF16(bfr[mt][1], fUP1, acc); hf2[64 * mt] = acc * ecv[mt]; }
                  }
              }
              __syncthreads();
              if (grp == sg) {
                  if (sg == 0) LOAD_PART_B();
                  f32x4 yy0 = y0[0], yy1 = y0[1];
#pragma unroll
                  for (int mt = 0; mt < 4; ++mt) { yy0 = MF16(rf[0][mt], fH[mt], yy0); yy1 = MF16(rf[1][mt], fH[mt], yy1); }
                  yy0 = MF16(mbf[0], fU0, yy0); yy1 = MF16(mbf[2], fU1, MF16(mbf[1], fU0, yy1));
#pragma unroll
                  for (int e = 0; e < 4; ++e) { const int p = p0 + ss * 64 + 32 * sg + 4 * lg + e, t = dir ? (L - 1 - p) : p, t2 = dir ? (t - 16) : (t + 16);
                      YD[((size_t)dir * MT + m0 + t) * 512 + h * 64 + vcol] = (bf16)f2bf(yy0[e]); YD[((size_t)dir * MT + m0 + t2) * 512 + h * 64 + vcol] = (bf16)f2bf(yy1[e]); }
                  if (mode == 2) {
                      f32x4 g0 = z4, g1 = z4;
#pragma unroll
                      for (int mt = 0; mt < 4; ++mt) { g0 = MF16(rf[0][mt], fHP[mt], g0); g1 = MF16(rf[1][mt], fHP[mt], g1); }
                      g0 = MF16(mbf[0], fUP0, g0); g1 = MF16(mbf[2], fUP1, MF16(mbf[1], fUP0, g1));
                      GAS bf16* G = (GAS bf16*)(P.ws + WS_G) + ((size_t)chain * 2048 + (ss * 64 + 32 * sg + 4 * lg)) * 64 + vcol;
#pragma unroll
                      for (int e = 0; e < 4; e += 2) { const unsigned w0 = cvtpk(g0[e], g0[e + 1]), w1 = cvtpk(g1[e], g1[e + 1]);
                          G[(size_t)e * 64] = (bf16)(w0 & 0xffffu); G[(size_t)(e + 1) * 64] = (bf16)(w0 >> 16); G[(size_t)(e + 16) * 64] = (bf16)(w1 & 0xffffu); G[(size_t)(e + 17) * 64] = (bf16)(w1 >> 16); }
                  }
              }
          }
#undef LOAD_PART_B
        }
        if (ss + 1 < nss) { chain_stage_raw(RR, lds, tid); __syncthreads(); }
    }
    if (grp == 1 && (sfin || mode == 1)) { STAGE_LANE(); const LAS f32x4* hf = (const LAS f32x4*)(lds + CH_HF) + cc * 256 + lane;
        if (mode == 1) { GAS bf16* hm = (GAS bf16*)(P.ws + WS_HMID) + (size_t)chain * 4096 + vcol * 64;
#pragma unroll
            for (int mt = 0; mt < 4; ++mt) { const f32x4 hv = hf[64 * mt]; u32x2v o; o.x = cvtpk(hv[0], hv[1]); o.y = cvtpk(hv[2], hv[3]); *(GAS u32x2v*)(hm + 16 * mt + 4 * lg) = o; } }
        else {
#pragma unroll
            for (int mt = 0; mt < 4; ++mt) *(f32x4*)(sfin + vcol * 64 + 16 * mt + 4 * lg) = hf[64 * mt]; }
    }
    __syncthreads();
#undef STAGE_LANE
}
constexpr int VN_LD = 520;
constexpr int GM_STG = 128 * VN_LD * 2;
static_assert(GM_STG + 8 * 2048 <= LDS_BYTES - 64, "gMLP LDS map");
typedef short s16x4 __attribute__((ext_vector_type(4)));
__device__ __forceinline__ s16x4 tr16(const LAS bf16* p) { return __builtin_amdgcn_ds_read_tr16_b64_v4i16((LAS s16x4*)p); }
__device__ __forceinline__ void do_gmlp(const Params& P, LAS unsigned char* lds, int unit) {
    const int tid = threadIdx.x, lane = tid & 63, wave = __builtin_amdgcn_readfirstlane(tid >> 6);
    const GAS bf16* proj = (const GAS bf16*)(P.ws + WS_PROJ); GAS bf16* MIX = (GAS bf16*)(P.ws + WS_H); const GAS bf16* wsb = (const GAS bf16*)(P.ws + WS_WSB);
    LAS bf16* vn = (LAS bf16*)lds;
    const int row0 = unit * 128;
    { const GAS float* g = (const GAS float*)P.in[I_SLG]; const GAS float* b = (const GAS float*)P.in[I_SLB];
      float gg[8], bb[8];
#pragma unroll
      for (int e = 0; e < 8; ++e) { gg[e] = g[lane * 8 + e]; bb[e] = b[lane * 8 + e]; }
      u32x4v rawv[16];
#pragma unroll
      for (int i = 0; i < 16; ++i) rawv[i] = *(const GAS u32x4v*)(proj + (size_t)(row0 + wave * 16 + i) * D_IN + C_VB + lane * 8);
#pragma unroll
      for (int i = 0; i < 16; ++i) { const int tok = wave * 16 + i; const u32x4v raw = rawv[i];
        float x[8]; x[0] = bf2f(raw.x & 0xffffu); x[1] = bf2f(raw.x >> 16); x[2] = bf2f(raw.y & 0xffffu); x[3] = bf2f(raw.y >> 16); x[4] = bf2f(raw.z & 0xffffu); x[5] = bf2f(raw.z >> 16); x[6] = bf2f(raw.w & 0xffffu); x[7] = bf2f(raw.w >> 16);
        float s = 0.f;
#pragma unroll
        for (int e = 0; e < 8; ++e) s += x[e];
        const float mean = wave_sum(s) * (1.0f / 512.0f); float q = 0.f;
#pragma unroll
        for (int e = 0; e < 8; ++e) { x[e] -= mean; q += x[e] * x[e]; }
        const float rstd = 1.0f / sqrtf(wave_sum(q) * (1.0f / 512.0f) + NORM_EPS);
        u32x4v o;
#pragma unroll
        for (int e = 0; e < 4; ++e) o[e] = cvtpk(x[2 * e] * rstd * gg[2 * e] + bb[2 * e], x[2 * e + 1] * rstd * gg[2 * e + 1] + bb[2 * e + 1]);
        *(LAS u32x4v*)(vn + tok * VN_LD + lane * 8) = o; } }
    __syncthreads();
    const int g = wave, fr = lane & 15, fq = lane >> 4;
    const GAS float* b_s = (const GAS float*)P.in[I_BSS];
    LAS bf16* stg = (LAS bf16*)(lds + GM_STG + wave * 2048);
    const LAS bf16* trbase = vn + (8 * fq + (fr >> 2)) * VN_LD + g * 64 + 4 * (fr & 3);
    const int pr_ = lane >> 2, cq = lane & 3, ch = g * 64 + 16 * cq;
    constexpr int GM_D = 3;
    bf16x8 bfr[4][4];
#pragma unroll
    for (int ks = 0; ks < 4; ++ks)
#pragma unroll
        for (int c = 0; c < 4; ++c) { const s16x4 lo = tr16(trbase + (32 * ks) * VN_LD + 16 * c), hi = tr16(trbase + (32 * ks + 4) * VN_LD + 16 * c);
            bfr[ks][c] = (bf16x8){lo[0], lo[1], lo[2], lo[3], hi[0], hi[1], hi[2], hi[3]}; }
    bf16x8 afr[GM_D][4]; u32x4v uu[GM_D][2], zz[GM_D][2]; float bsv[GM_D];
#define GM_LOAD_TILE(t_, sl_) do { const int p_ = (t_) * 16 + pr_; const GAS bf16* pr = proj + (size_t)(row0 + p_) * D_IN; \
        _Pragma("unroll") for (int ks = 0; ks < 4; ++ks) afr[sl_][ks] = *(const GAS bf16x8*)(wsb + (size_t)(g * 128 + (t_) * 16 + fr) * 128 + ks * 32 + 8 * fq); \
        uu[sl_][0] = *(const GAS u32x4v*)(pr + C_U + ch); uu[sl_][1] = *(const GAS u32x4v*)(pr + C_U + ch + 8); zz[sl_][0] = *(const GAS u32x4v*)(pr + C_ZB + ch); zz[sl_][1] = *(const GAS u32x4v*)(pr + C_ZB + ch + 8); \
        bsv[sl_] = b_s[g * 128 + p_]; } while (0)
#pragma unroll
    for (int t = 0; t < GM_D; ++t) GM_LOAD_TILE(t, t);
#pragma unroll
    for (int t = 0; t < 8; ++t) {
        constexpr int dummy = 0; (void)dummy;
        const int sl = t % GM_D;
        f32x4 acc[4];
#pragma unroll
        for (int c = 0; c < 4; ++c) acc[c] = (f32x4){0.f, 0.f, 0.f, 0.f};
#pragma unroll
        for (int ks = 0; ks < 4; ++ks)
#pragma unroll
            for (int c = 0; c < 4; ++c) acc[c] = __builtin_amdgcn_mfma_f32_16x16x32_bf16(afr[sl][ks], bfr[ks][c], acc[c], 0, 0, 0);
#pragma unroll
        for (int c = 0; c < 4; ++c)
#pragma unroll
            for (int e = 0; e < 4; e += 2) { const unsigned w = cvtpk(acc[c][e], acc[c][e + 1]); LAS bf16* sp = stg + (4 * fq + e) * 64 + 16 * c + fr; sp[0] = (bf16)(w & 0xffffu); sp[64] = (bf16)(w >> 16); }
        const u32x4v u0 = uu[sl][0], u1 = uu[sl][1], z0 = zz[sl][0], z1 = zz[sl][1]; const float bs1 = bsv[sl];
        const u32x4v s0 = *(const LAS u32x4v*)(stg + pr_ * 64 + 16 * cq), s1 = *(const LAS u32x4v*)(stg + pr_ * 64 + 16 * cq + 8);
        u32x4v o0, o1;
#pragma unroll
        for (int e = 0; e < 4; ++e) {
            o0[e] = cvtpk(bf2f(u0[e] & 0xffffu) * (bf2f(s0[e] & 0xffffu) + bs1) * silu_f(bf2f(z0[e] & 0xffffu)), bf2f(u0[e] >> 16) * (bf2f(s0[e] >> 16) + bs1) * silu_f(bf2f(z0[e] >> 16)));
            o1[e] = cvtpk(bf2f(u1[e] & 0xffffu) * (bf2f(s1[e] & 0xffffu) + bs1) * silu_f(bf2f(z1[e] & 0xffffu)), bf2f(u1[e] >> 16) * (bf2f(s1[e] >> 16) + bs1) * silu_f(bf2f(z1[e] >> 16))); }
        asm volatile("" ::: "memory");
        if (t + GM_D < 8) GM_LOAD_TILE(t + GM_D, sl);
        asm volatile("" ::: "memory");
        GAS bf16* op = MIX + (size_t)(row0 + t * 16 + pr_) * D + 512 + ch;
        __builtin_nontemporal_store(o0, (GAS u32x4v*)op); __builtin_nontemporal_store(o1, (GAS u32x4v*)(op + 8));
    }
#undef GM_LOAD_TILE
    __syncthreads();
}

#define XB_TMO      128
#define XB_XCNT(j)  (256  + 64 * (j))
#define XB_XSUB(j)  (1280 + 64 * (j))
#define XB_XGEN(j)  (2304 + 64 * (j))
#define XB_TOP      3328
#define XB_TOPGEN   3392
#define XCD_BAR_WORDS 3456
#define XB_SPIN_CAP (1u << 18)

__device__ __forceinline__ unsigned xb_ld(unsigned* p)              { return __hip_atomic_load(p, __ATOMIC_RELAXED, __HIP_MEMORY_SCOPE_AGENT); }
__device__ __forceinline__ unsigned xb_add(unsigned* p, unsigned v) { return __hip_atomic_fetch_add(p, v, __ATOMIC_RELAXED, __HIP_MEMORY_SCOPE_AGENT); }
__device__ __forceinline__ unsigned xb_xcc_id() { return (unsigned)__builtin_amdgcn_s_getreg((3 << 11) | 20) & 0xFu; }
#define XB_SPIN(cond, bar) do { unsigned _sp = 0; while (cond) { __builtin_amdgcn_s_sleep(1); \
    if ((++_sp & 255u) == 0u) { if (xb_ld(&(bar)[XB_TMO])) break; if (_sp > XB_SPIN_CAP) { atomicAdd(&(bar)[XB_TMO], 1u); break; } } } } while (0)

struct XcdBarrier {
    unsigned* bar; unsigned x;
    volatile LAS unsigned* st;
};

__device__ __forceinline__ XcdBarrier xcd_barrier_post(unsigned* bar, volatile LAS unsigned* st) {
    XcdBarrier b; b.bar = bar; b.x = xb_xcc_id(); b.st = st;
    if (threadIdx.x == 0) (void)xb_add(&bar[XB_XCNT(b.x)], 1u);
    return b;
}
__device__ __forceinline__ void xcd_barrier_complete(unsigned* bar, unsigned x, unsigned& nloc, unsigned& nx) {
    const unsigned G = gridDim.x * gridDim.y * gridDim.z;
    unsigned sum, cnt, mine, sp = 0u;
    for (;;) {
        sum = 0u; cnt = 0u; mine = 0u;
#pragma unroll
        for (unsigned j = 0; j < 16; ++j) { const unsigned c = xb_ld(&bar[XB_XCNT(j)]); sum += c; cnt += (c > 0u) ? 1u : 0u; mine = (j == x) ? c : mine; }
        if (sum == G) break;
        __builtin_amdgcn_s_sleep(1);
        if ((++sp & 255u) == 0u) { if (xb_ld(&bar[XB_TMO])) break; if (sp > XB_SPIN_CAP) { atomicAdd(&bar[XB_TMO], 1u); break; } }
    }
    nloc = mine > 0u ? mine : 1u; nx = cnt > 0u ? cnt : 1u;
}

__device__ __forceinline__ void xcd_barrier(const XcdBarrier& b) {
    asm volatile("s_waitcnt vmcnt(0)" ::: "memory");
    __syncthreads();
    if (threadIdx.x == 0) {
        unsigned* bar = b.bar;
        __builtin_amdgcn_s_waitcnt(0);
        unsigned nloc = b.st[0], nx = b.st[1];
        if (nloc == 0u) { xcd_barrier_complete(bar, b.x, nloc, nx); b.st[0] = nloc; b.st[1] = nx; }
        const unsigned old = xb_add(&bar[XB_XSUB(b.x)], 1u);
        const unsigned gen = old / nloc;
        if (old + 1u == (gen + 1u) * nloc) {
            __builtin_amdgcn_fence(__ATOMIC_RELEASE, "agent");
            asm volatile("s_waitcnt vmcnt(0)" ::: "memory");
            const unsigned og = xb_add(&bar[XB_TOP], 1u);
            const unsigned tg = og / nx;
            if (og + 1u == (tg + 1u) * nx) xb_add(&bar[XB_TOPGEN], 1u);
            else XB_SPIN(xb_ld(&bar[XB_TOPGEN]) == tg, bar);
            __builtin_amdgcn_fence(__ATOMIC_ACQUIRE, "agent");
            xb_add(&bar[XB_XGEN(b.x)], 1u);
            asm volatile("s_waitcnt vmcnt(0)" ::: "memory");
        } else {
            XB_SPIN(xb_ld(&bar[XB_XGEN(b.x)]) == gen, bar);
            __builtin_amdgcn_fence(__ATOMIC_ACQUIRE, "agent");
            asm volatile("s_waitcnt vmcnt(0)" ::: "memory");
        }
    }
    __syncthreads();
}

#define SP_LOC(k, j) (4096 + 640 * (k) + 32 * (j))
#define SP_TOP(k)    (4096 + 640 * (k) + 512)
__device__ __forceinline__ void split_arrive(const XcdBarrier& b, int k) {
    const unsigned nloc = b.st[0];
    const unsigned old = xb_add(&b.bar[SP_LOC(k, b.x)], 1u);
    if (old + 1u == nloc) { __builtin_amdgcn_fence(__ATOMIC_RELEASE, "agent"); asm volatile("s_waitcnt vmcnt(0)" ::: "memory"); (void)xb_add(&b.bar[SP_TOP(k)], 1u); }
}
__device__ __forceinline__ void split_arrive_all(const XcdBarrier& b, int k) {
    asm volatile("s_waitcnt vmcnt(0)" ::: "memory"); __syncthreads();
    if (threadIdx.x == 0) split_arrive(b, k);
}
__device__ __forceinline__ void split_wait(const XcdBarrier& b, int k) {
    if (threadIdx.x == 0) { const unsigned nx = b.st[1]; unsigned* bar = b.bar; XB_SPIN(xb_ld(&bar[SP_TOP(k)]) < nx, bar);
        __builtin_amdgcn_fence(__ATOMIC_ACQUIRE, "agent"); asm volatile("s_waitcnt vmcnt(0)" ::: "memory"); }
    __syncthreads();
}

__device__ __forceinline__ int queue_pull(unsigned char* ws, size_t qoff, volatile LAS int* qslot) {
    if (threadIdx.x == 0) *qslot = (int)__hip_atomic_fetch_add((unsigned*)(ws + qoff), 1u, __ATOMIC_RELAXED, __HIP_MEMORY_SCOPE_AGENT);
    __syncthreads();
    const int t = *qslot;
    __syncthreads();
    return t;
}
__device__ __forceinline__ void phase3(const Params& P, LAS unsigned char* lds, const XcdBarrier& xb) {
    const int G = gridDim.x, bid = blockIdx.x;
    const bool bal = (G == 256);
    volatile LAS int* qslot = (volatile LAS int*)(lds + LDS_BYTES - 32);
    if (bal) {
        { const int b = bid & 7, q = (bid >> 3) & 15, h = q >> 1, dir = q & 1;
          split_wait(xb, 0);
          const bool fh = bid < 128;
          do_chain(P, lds, M_CTX + b * L_LAT, L_LAT, h, dir, fh ? (dir ? P.in[I_SB] : P.in[I_SF]) + (size_t)(b * 8 + h) * 4096 : nullptr, nullptr, fh ? 0 : 2048, 2048, fh ? 1 : 2, b * 16 + q); }
        split_arrive_all(xb, 7);
        split_wait(xb, 1);
        int q2 = -1;
        for (int first = 1;; first = 0) {
            int qq;
            if (first) { if (threadIdx.x == 0) *qslot = (int)__hip_atomic_fetch_add((unsigned*)(P.ws + CW_QUEUE), 2u, __ATOMIC_RELAXED, __HIP_MEMORY_SCOPE_AGENT); __syncthreads(); qq = *qslot; q2 = qq + 1; __syncthreads(); }
            else if (q2 >= 0) { qq = q2; q2 = -1; }
            else qq = queue_pull(P.ws, CW_QUEUE, qslot);
            if (qq >= 832) break;
            const int grp = qq / 5, rr = qq - 5 * grp, gu = (qq >= 640) ? (qq - 512) : ((rr == 4) ? grp : -1);
            if (gu >= 0) { do_gmlp(P, lds, gu); continue; }
            const int cc = grp * 4 + rr, b = cc >> 4, h = (cc >> 1) & 7, dir = cc & 1;
            do_chain(P, lds, b * L_CTX, L_CTX, h, dir, nullptr, P.out + (size_t)MT * D + (size_t)dir * STATE_ELEMS + (size_t)(b * 8 + h) * 4096, 0, L_CTX, 0, 0);
        }
        split_arrive_all(xb, 8);
        return;
    }
    for (int it = 0; it < (640 + G - 1) / G; ++it) {
        int m0, L, h, dir, p0, npt, mode, chain; const float* s0; float* sfin;
        {
            const int c = bid + it * G; if (c >= 640) continue;
            chain = 0; p0 = 0; mode = 0;
            if (c < 128) { const int b = c >> 4; h = (c >> 1) & 7; dir = c & 1; m0 = M_CTX + b * L_LAT; L = L_LAT; npt = L_LAT;
                s0 = (dir ? P.in[I_SB] : P.in[I_SF]) + (size_t)(b * 8 + h) * 4096; sfin = nullptr; }
            else { const int cc = c - 128, b = cc >> 4; h = (cc >> 1) & 7; dir = cc & 1; m0 = b * L_CTX; L = L_CTX; npt = L_CTX;
                s0 = nullptr; sfin = P.out + (size_t)MT * D + (size_t)dir * STATE_ELEMS + (size_t)(b * 8 + h) * 4096; }
        }
        do_chain(P, lds, m0, L, h, dir, s0, sfin, p0, npt, mode, chain);
    }
    if (!bal) { for (int u = bid; u < 320; u += G) do_gmlp(P, lds, u); }
}

__device__ __forceinline__ void phase35(const Params& P, LAS unsigned char* lds, int gw, int NGW, int wave, int lane) {
    if (gridDim.x != 256) return;
    const GAS bf16* Gm = (const GAS bf16*)(P.ws + WS_G); const GAS bf16* HM = (const GAS bf16*)(P.ws + WS_HMID); GAS bf16* CORR = (GAS bf16*)(P.ws + WS_CORR);
    const int lr = lane & 15, lg = lane >> 4;
    LAS bf16* stg = (LAS bf16*)(lds + wave * 2304);
    const int chain = gw >> 4, b = chain >> 4, h = (chain >> 1) & 7, dir = chain & 1;
    bf16x8 hb[4][2];
#pragma unroll
    for (int nt = 0; nt < 4; ++nt) { const GAS bf16* hp = HM + (size_t)chain * 4096 + (16 * nt + lr) * 64 + 8 * lg; hb[nt][0] = *(const GAS bf16x8*)hp; hb[nt][1] = *(const GAS bf16x8*)(hp + 32); }
    const GAS bf16* gp = Gm + ((size_t)chain * 2048 + (gw & 15) * 128 + lr) * 64 + 8 * lg;
    bf16x8 a0 = *(const GAS bf16x8*)gp, a1 = *(const GAS bf16x8*)(gp + 32);
#pragma unroll 1
    for (int i = 0; i < 8; ++i) {
        const bf16x8 c0 = a0, c1 = a1;
        if (i < 7) { a0 = *(const GAS bf16x8*)(gp + (size_t)(i + 1) * 1024); a1 = *(const GAS bf16x8*)(gp + (size_t)(i + 1) * 1024 + 32); }
#pragma unroll
        for (int nt = 0; nt < 4; ++nt) { f32x4 acc = MFMA16(c0, hb[nt][0], ((f32x4){0.f, 0.f, 0.f, 0.f})); acc = MFMA16(c1, hb[nt][1], acc);
            const unsigned w0 = cvtpk(acc[0], acc[1]), w1 = cvtpk(acc[2], acc[3]); LAS bf16* sp = stg + (4 * lg) * 72 + 16 * nt + lr;
            sp[0] = (bf16)(w0 & 0xffffu); sp[72] = (bf16)(w0 >> 16); sp[144] = (bf16)(w1 & 0xffffu); sp[216] = (bf16)(w1 >> 16); }
        const int tr = lane >> 2, vq = lane & 3, p = 2048 + ((gw & 15) * 8 + i) * 16 + tr, t = dir ? (L_LAT - 1 - p) : p;
        const u32x4v o0 = *(const LAS u32x4v*)(stg + tr * 72 + 16 * vq), o1 = *(const LAS u32x4v*)(stg + tr * 72 + 16 * vq + 8);
        GAS bf16* cp = CORR + ((size_t)(b * L_LAT + t)) * 512 + h * 64 + 16 * vq;
        *(GAS u32x4v*)cp = o0; *(GAS u32x4v*)(cp + 8) = o1;
    }
}

__device__ __forceinline__ void phase4(const Params& P, int gw, int NGW, int lane, int m_lo, int m_hi) {
    const GAS bf16* proj = (const GAS bf16*)(P.ws + WS_PROJ); GAS bf16* MIX = (GAS bf16*)(P.ws + WS_H); const GAS bf16* YD = (const GAS bf16*)P.out; const GAS float* BS = (const GAS float*)(P.ws + WS_BS);
    const GAS float* ts_mu = (const GAS float*)P.in[I_TSMU]; const GAS float* gn_w = (const GAS float*)P.in[I_GNW]; const GAS float* gn_b = (const GAS float*)P.in[I_GNB];
    const int ch = 8 * lane, hd = lane >> 3;
    float m0v[8], m1v[8], gw8[8], gb8[8];
#pragma unroll
    for (int e = 0; e < 8; ++e) { m0v[e] = ts_mu[C_V + ch + e]; m1v[e] = ts_mu[1536 + C_V + ch + e]; gw8[e] = gn_w[ch + e]; gb8[e] = gn_b[ch + e]; }
    for (int m = m_lo + gw; m < m_hi; m += NGW) {
        const int t = (m < M_CTX) ? (m & (L_CTX - 1)) : ((m - M_CTX) & (L_LAT - 1)), L = (m < M_CTX) ? L_CTX : L_LAT;
        const u32x4v yf = *(const GAS u32x4v*)(YD + (size_t)m * 512 + ch), yb = *(const GAS u32x4v*)(YD + ((size_t)MT + m) * 512 + ch);
        const GAS bf16* pr = proj + (size_t)m * D_IN;
        const u32x4v vc = *(const GAS u32x4v*)(pr + C_V + ch), za = *(const GAS u32x4v*)(pr + C_ZA + ch);
        u32x4v vp = (u32x4v){0u, 0u, 0u, 0u}, vn = (u32x4v){0u, 0u, 0u, 0u};
        if (t > 0) vp = *(const GAS u32x4v*)(pr + C_V + ch - D_IN);
        if (t < L - 1) vn = *(const GAS u32x4v*)(pr + C_V + ch + D_IN);
        const float bon = BS[(size_t)m * 8 + hd] + BS[((size_t)MT + m) * 8 + hd];
        u32x4v cr = (u32x4v){0u, 0u, 0u, 0u};
        if (m >= M_CTX && gridDim.x == 256) cr = *(const GAS u32x4v*)((const GAS bf16*)(P.ws + WS_CORR) + (size_t)(m - M_CTX) * 512 + ch);
        float y[8];
#pragma unroll
        for (int e = 0; e < 8; ++e) { const unsigned sh = (e & 1) ? 16u : 0u; y[e] = bf2f((yf[e >> 1] >> sh) & 0xffffu) + bf2f((yb[e >> 1] >> sh) & 0xffffu); }
        float s = 0.f;
#pragma unroll
        for (int e = 0; e < 8; ++e) { y[e] += bf2f((cr[e >> 1] >> ((e & 1) ? 16u : 0u)) & 0xffffu); s += y[e]; }
        const float mean = oct_sum(s) * (1.0f / 64.0f); float q = 0.f;
#pragma unroll
        for (int e = 0; e < 8; ++e) { y[e] -= mean; q += y[e] * y[e]; }
        const float rstd = 1.0f / sqrtf(oct_sum(q) * (1.0f / 64.0f) + GN_EPS);
        u32x4v o;
#pragma unroll
        for (int e2 = 0; e2 < 4; ++e2) { float r2[2];
#pragma unroll
            for (int hh = 0; hh < 2; ++hh) { const int e = 2 * e2 + hh; const unsigned sh = hh ? 16u : 0u;
                const float c0 = bf2f((vc[e2] >> sh) & 0xffffu), p0 = bf2f((vp[e2] >> sh) & 0xffffu), n0 = bf2f((vn[e2] >> sh) & 0xffffu), z = bf2f((za[e2] >> sh) & 0xffffu);
                const float v = c0 + m0v[e] * (p0 - c0) + m1v[e] * (n0 - c0);
                r2[hh] = (y[e] * rstd * gw8[e] + gb8[e] + bon * v) * silu_f(z); }
            o[e2] = cvtpk(r2[0], r2[1]); }
        *(GAS u32x4v*)(MIX + (size_t)m * D + ch) = o;
    }
}

__device__ __forceinline__ void phase45(const Params& P, LAS unsigned char* lds, const XcdBarrier& xb, int gw, int NGW, int wave, int lane) {
    split_wait(xb, 7);
    const GAS bf16* Gm = (const GAS bf16*)(P.ws + WS_G); const GAS bf16* HM = (const GAS bf16*)(P.ws + WS_HMID);
    const GAS bf16* proj = (const GAS bf16*)(P.ws + WS_PROJ); GAS bf16* MIX = (GAS bf16*)(P.ws + WS_H); const GAS bf16* YD = (const GAS bf16*)P.out; const GAS float* BS = (const GAS float*)(P.ws + WS_BS);
    const GAS float* ts_mu = (const GAS float*)P.in[I_TSMU]; const GAS float* gn_w = (const GAS float*)P.in[I_GNW]; const GAS float* gn_b = (const GAS float*)P.in[I_GNB];
    const int lr = lane & 15, lg = lane >> 4;
    LAS bf16* stg = (LAS bf16*)(lds + wave * 16640);
    const int tile = gw, b = tile >> 8, t0 = (tile & 255) * 16, dirs = (t0 >= 2048) ? 0 : 1;
    const int grow0 = (dirs ? (L_LAT - 1 - t0 - 15) : t0) - 2048;
#pragma unroll 1
    for (int hp2 = 0; hp2 < 4; ++hp2) {
        bf16x8 ga[2][2], hb[2][4][2];
#pragma unroll
        for (int q = 0; q < 2; ++q) { const int chain = b * 16 + (2 * hp2 + q) * 2 + dirs;
            const GAS bf16* gp = Gm + ((size_t)chain * 2048 + grow0 + lr) * 64 + 8 * lg; ga[q][0] = *(const GAS bf16x8*)gp; ga[q][1] = *(const GAS bf16x8*)(gp + 32);
#pragma unroll
            for (int nt = 0; nt < 4; ++nt) { const GAS bf16* hp = HM + (size_t)chain * 4096 + (16 * nt + lr) * 64 + 8 * lg; hb[q][nt][0] = *(const GAS bf16x8*)hp; hb[q][nt][1] = *(const GAS bf16x8*)(hp + 32); } }
#pragma unroll
        for (int q = 0; q < 2; ++q)
#pragma unroll
            for (int nt = 0; nt < 4; ++nt) { f32x4 acc = MFMA16(ga[q][0], hb[q][nt][0], ((f32x4){0.f, 0.f, 0.f, 0.f})); acc = MFMA16(ga[q][1], hb[q][nt][1], acc);
                const unsigned w0 = cvtpk(acc[0], acc[1]), w1 = cvtpk(acc[2], acc[3]); LAS bf16* sp = stg + (4 * lg) * 520 + (2 * hp2 + q) * 64 + 16 * nt + lr;
                sp[0] = (bf16)(w0 & 0xffffu); sp[520] = (bf16)(w0 >> 16); sp[1040] = (bf16)(w1 & 0xffffu); sp[1560] = (bf16)(w1 >> 16); }
    }
    const int ch = 8 * lane, hd = lane >> 3;
    float m0v[8], m1v[8], gw8[8], gb8[8];
#pragma unroll
    for (int e = 0; e < 8; ++e) { m0v[e] = ts_mu[C_V + ch + e]; m1v[e] = ts_mu[1536 + C_V + ch + e]; gw8[e] = gn_w[ch + e]; gb8[e] = gn_b[ch + e]; }
    const u32x4v zero4 = (u32x4v){0u, 0u, 0u, 0u};
    const GAS bf16* prow0 = proj + (size_t)(M_CTX + b * L_LAT + t0) * D_IN;
    u32x4v vprev = (t0 > 0) ? *(const GAS u32x4v*)(prow0 + C_V + ch - D_IN) : zero4, vcur = *(const GAS u32x4v*)(prow0 + C_V + ch), vnext = *(const GAS u32x4v*)(prow0 + C_V + ch + D_IN);
    u32x4v yf_n, yb_n, za_n; float bs0_n, bs1_n;
    { const int m = M_CTX + b * L_LAT + t0; yf_n = *(const GAS u32x4v*)(YD + (size_t)m * 512 + ch); yb_n = *(const GAS u32x4v*)(YD + ((size_t)MT + m) * 512 + ch); za_n = *(const GAS u32x4v*)(prow0 + C_ZA + ch);
      bs0_n = BS[(size_t)m * 8 + hd]; bs1_n = BS[((size_t)MT + m) * 8 + hd]; }
#pragma unroll 1
    for (int r = 0; r < 16; ++r) {
        const int t = t0 + r, m = M_CTX + b * L_LAT + t, pl = dirs ? (15 - r) : r;
        const u32x4v yf = yf_n, yb = yb_n, za = za_n, vc = vcur, vp = vprev, vn = vnext; const float bon = bs0_n + bs1_n;
        u32x4v vnn = zero4;
        if (r < 15) { const int m1 = m + 1; const GAS bf16* pr1 = proj + (size_t)m1 * D_IN;
            yf_n = *(const GAS u32x4v*)(YD + (size_t)m1 * 512 + ch); yb_n = *(const GAS u32x4v*)(YD + ((size_t)MT + m1) * 512 + ch); za_n = *(const GAS u32x4v*)(pr1 + C_ZA + ch);
            bs0_n = BS[(size_t)m1 * 8 + hd]; bs1_n = BS[((size_t)MT + m1) * 8 + hd];
            if (t + 2 < L_LAT) vnn = *(const GAS u32x4v*)(pr1 + C_V + ch + D_IN); }
        const u32x4v cr = *(const LAS u32x4v*)(stg + pl * 520 + ch);
        float y[8]; float s = 0.f;
#pragma unroll
        for (int e = 0; e < 8; ++e) { const unsigned sh = (e & 1) ? 16u : 0u; y[e] = bf2f((yf[e >> 1] >> sh) & 0xffffu) + bf2f((yb[e >> 1] >> sh) & 0xffffu) + bf2f((cr[e >> 1] >> sh) & 0xffffu); s += y[e]; }
        const float mean = oct_sum(s) * (1.0f / 64.0f); float q = 0.f;
#pragma unroll
        for (int e = 0; e < 8; ++e) { y[e] -= mean; q += y[e] * y[e]; }
        const float rstd = 1.0f / sqrtf(oct_sum(q) * (1.0f / 64.0f) + GN_EPS);
        u32x4v o;
#pragma unroll
        for (int e2 = 0; e2 < 4; ++e2) { float r2[2];
#pragma unroll
            for (int hh = 0; hh < 2; ++hh) { const int e = 2 * e2 + hh; const unsigned sh = hh ? 16u : 0u;
                const float c0 = bf2f((vc[e2] >> sh) & 0xffffu), p0 = bf2f((vp[e2] >> sh) & 0xffffu), n0 = bf2f((vn[e2] >> sh) & 0xffffu), z = bf2f((za[e2] >> sh) & 0xffffu);
                const float v = c0 + m0v[e] * (p0 - c0) + m1v[e] * (n0 - c0);
                r2[hh] = (y[e] * rstd * gw8[e] + gb8[e] + bon * v) * silu_f(z); }
            o[e2] = cvtpk(r2[0], r2[1]); }
        *(GAS u32x4v*)(MIX + (size_t)m * D + ch) = o;
        vprev = vcur; vcur = vnext; vnext = vnn;
    }
    split_arrive_all(xb, 9);
    split_wait(xb, 8);
    phase4(P, gw, NGW, lane, 0, M_CTX);
    split_arrive_all(xb, 10);
}

__device__ __forceinline__ void phase6(const Params& P, int gw, int NGW, int lane) {
    const GAS float* mod = (const GAS float*)(P.ws + WS_MOD); const GAS float* ln_post = (const GAS float*)P.in[I_LNPOST]; const GAS bf16* OB = (const GAS bf16*)(P.ws + WS_OUTB);
#pragma unroll 1
    for (int seg = 0; seg < 9; ++seg) {
        const int m_lo = (seg == 0) ? 0 : M_CTX + (seg - 1) * L_LAT, m_hi = (seg == 0) ? M_CTX : m_lo + L_LAT;
        const GAS float* gate = mod + seg * 3072 + 2048;
        f32x4 wg[4];
#pragma unroll
        for (int j = 0; j < 4; ++j) { const int col = 4 * (lane + 64 * j); wg[j] = *(const GAS f32x4*)(ln_post + col) * *(const GAS f32x4*)(gate + col); }
        for (int m = m_lo + gw; m < m_hi; m += NGW) {
            const GAS f32x4* xr = (const GAS f32x4*)x_row(P, m) + lane; GAS f32x4* orow = (GAS f32x4*)(P.out + (size_t)m * D) + lane;
            const GAS u32x2v* ob = (const GAS u32x2v*)(OB + (size_t)m * D) + lane;
            f32x4 o[4], xv[4]; float ss = 0.f;
#pragma unroll
            for (int j = 0; j < 4; ++j) { const u32x2v r = ob[64 * j]; xv[j] = xr[64 * j]; o[j][0] = bf2f(r.x & 0xffffu); o[j][1] = bf2f(r.x >> 16); o[j][2] = bf2f(r.y & 0xffffu); o[j][3] = bf2f(r.y >> 16);
                ss += (o[j][0] * o[j][0] + o[j][1] * o[j][1]) + (o[j][2] * o[j][2] + o[j][3] * o[j][3]); }
            const float rstd = 1.0f / sqrtf(wave_sum(ss) * (1.0f / D) + NORM_EPS);
#pragma unroll
            for (int j = 0; j < 4; ++j) orow[64 * j] = xv[j] + o[j] * rstd * wg[j];
        }
    }
}

__device__ __forceinline__ void phase0_dyn(const Params& P, LAS unsigned char* lds, const XcdBarrier& xb, int gw, int NGW, int wave, int lane) {
    typedef float f32x2 __attribute__((ext_vector_type(2)));
    float* mod = (float*)(P.ws + WS_MOD);
    const float* w_mod = P.in[I_WMOD]; const float* b_mod = P.in[I_BMOD]; const float* cc = P.in[I_C]; const float* cctx = P.in[I_CCTX];
    const int cgp = blockIdx.x & 31, rg = blockIdx.x >> 5, col = cgp * 96 + 2 * (lane < 48 ? lane : 0), r0 = rg * 128 + wave * 16;
    f32x2 acc[9];
#pragma unroll
    for (int v = 0; v < 9; ++v) acc[v] = (f32x2){0.f, 0.f};
    f32x2 w[16];
#pragma unroll
    for (int i = 0; i < 16; ++i) w[i] = *(const GAS f32x2*)((const GAS float*)w_mod + (size_t)(r0 + i) * 3072 + col);
#pragma unroll
    for (int i = 0; i < 16; ++i) {
#pragma unroll
        for (int v = 0; v < 9; ++v) { const float cv = (v == 0) ? cctx[r0 + i] : cc[(v - 1) * 1024 + r0 + i]; acc[v] += silu_f(cv) * w[i]; }
    }
    LAS f32x2* red = (LAS f32x2*)lds;
#pragma unroll
    for (int v = 0; v < 9; ++v) red[(wave * 9 + v) * 64 + lane] = acc[v];
    __syncthreads();
    { const int idx = threadIdx.x;
      if (idx < 9 * 48) { const int v = idx / 48, l = idx - 48 * v; f32x2 s = red[v * 64 + l];
#pragma unroll
        for (int w2 = 1; w2 < 8; ++w2) s += red[(w2 * 9 + v) * 64 + l];
        const int c2 = cgp * 96 + 2 * l;
        if (rg == 0) s += *(const f32x2*)(b_mod + c2);
        atomicAdd(mod + v * 3072 + c2, s[0]); atomicAdd(mod + v * 3072 + c2 + 1, s[1]); } }
    if (threadIdx.x == 0 && xb.st[0] == 0u) { unsigned nloc, nx; xcd_barrier_complete(xb.bar, xb.x, nloc, nx); xb.st[0] = nloc; xb.st[1] = nx; }
    split_arrive_all(xb, 11);
    weight_copies(P, lds, gw, NGW, wave, lane);
    split_wait(xb, 11);
}

__device__ __forceinline__ void phase1_dyn(const Params& P, const XcdBarrier& xb, int wave, int lane) {
    const int c = blockIdx.x, x = c & 7, i = c >> 3;
    f32x4 gs[4], sh[4];
    prenorm_mod(P, 1 + x, lane, gs, sh);
    const int m1 = M_CTX + L_LAT * x + 64 * i + 8 * wave;
    prenorm_rows(P, m1, 8, lane, gs, sh);
    split_arrive_all(xb, 4);
    if (i & 1) { prenorm_rows(P, m1 + 2048, 8, lane, gs, sh); prenorm_rows(P, m1 - 64 + 2048 + 6, 2, lane, gs, sh); }
    else prenorm_rows(P, m1 + 2048, 6, lane, gs, sh);
    split_arrive_all(xb, 5);
    prenorm_mod(P, 0, lane, gs, sh);
    const int m0 = 1024 * x + 32 * i + 4 * wave;
    prenorm_rows(P, m0, 4, lane, gs, sh);
    split_arrive_all(xb, 6);
}

struct Gemm1Order {
    int G, c; pg8::StaticOrder so;
    __device__ __forceinline__ void init(int G_, int c_) { G = G_; c = c_; so.init(MT, D_IN, G_, c_); }
    __device__ __forceinline__ bool next(int i, pg8::Unit& u) const {
        if (G != 256) return so.next(i, u);
        const int j = 32 * i + (c >> 3), x = c & 7; if (j >= 300) return false;
        if (j < 240) { const int grp = j / 60, idx = j - 60 * grp; u.pm = 32 + 16 * x + 4 * grp + (idx & 3); u.pn = idx >> 2; }
        else { const int jj = j - 240; u.pm = 4 * x + (jj & 3); u.pn = jj >> 2; }
        return true;
    }
    __device__ __forceinline__ void a_ready(const pg8::Unit&) const {}
    __device__ __forceinline__ void done(const pg8::Unit&, int ui) const {
        if (G == 256 && ui == 7) { asm volatile("s_waitcnt vmcnt(0)" ::: "memory"); __builtin_amdgcn_s_barrier();
            if (threadIdx.x == 0) split_arrive(xb, 0); }
        if (G == 256 && ui == 1) split_wait(xb, 5);
        if (G == 256 && ui == 5) split_wait(xb, 6);
    }
    XcdBarrier xb;
};

struct Gemm2Order {
    int G, c; pg8::StaticOrder so; XcdBarrier xb;
    __device__ __forceinline__ void init(int G_, int c_) { G = G_; c = c_; so.init(MT, D, G_, c_); }
    __device__ __forceinline__ bool next(int i, pg8::Unit& u) const {
        if (G != 256) return so.next(i, u);
        const int j = 32 * i + (c >> 3), x = c & 7; if (j >= 80) return false;
        if (j < 64) { u.pm = 32 + 16 * x + 8 * (j >> 5) + (j & 7); u.pn = (j & 31) >> 3; }
        else { const int jj = j - 64; u.pm = 4 * x + (jj & 3); u.pn = jj >> 2; }
        return true;
    }
    __device__ __forceinline__ void a_ready(const pg8::Unit&) const {}
    __device__ __forceinline__ void done(const pg8::Unit&, int ui) const {
        if (G == 256 && ui == 1) { asm volatile("s_waitcnt vmcnt(0)" ::: "memory"); __builtin_amdgcn_s_barrier();
            if (threadIdx.x == 0) split_arrive(xb, 2); }
        if (G == 256 && ui == 0) split_wait(xb, 10);
    }
};

__device__ __forceinline__ void phase6_dyn(const Params& P, LAS unsigned char* lds, const XcdBarrier& xb, int wave, int lane) {
    const GAS float* mod = (const GAS float*)(P.ws + WS_MOD); const GAS float* ln_post = (const GAS float*)P.in[I_LNPOST]; const GAS bf16* OB = (const GAS bf16*)(P.ws + WS_OUTB);
    volatile LAS int* qs = (volatile LAS int*)(lds + LDS_BYTES - 64);
    unsigned* qctr = (unsigned*)(P.ws + CW_QUEUE + 512);
    split_wait(xb, 2);
    if (threadIdx.x == 0) qs[0] = (int)__hip_atomic_fetch_add(qctr, 1u, __ATOMIC_RELAXED, __HIP_MEMORY_SCOPE_AGENT);
    __syncthreads();
    int cur = qs[0], par = 1, seg_cur = -1; bool late_ok = false;
    f32x4 wg[4];
    while (cur < 2560) {
        unsigned nxt = 0u;
        if (threadIdx.x == 0) nxt = __hip_atomic_fetch_add(qctr, 1u, __ATOMIC_RELAXED, __HIP_MEMORY_SCOPE_AGENT);
        if (cur >= 2048 && !late_ok) { split_wait(xb, 3); late_ok = true; }
        int pm;
        if (cur < 2048) pm = 32 + (cur >> 4); else pm = (cur - 2048) >> 4;
        const int m = pm * 256 + (cur & 15) * 16 + wave * 2, seg = (m < M_CTX) ? 0 : 1 + ((m - M_CTX) >> 12);
        f32x4 o[2][4], xv[2][4];
#pragma unroll
        for (int rr = 0; rr < 2; ++rr) { const GAS f32x4* xr = (const GAS f32x4*)x_row(P, m + rr) + lane; const GAS u32x2v* ob = (const GAS u32x2v*)(OB + (size_t)(m + rr) * D) + lane;
#pragma unroll
            for (int j = 0; j < 4; ++j) { const u32x2v r = ob[64 * j]; xv[rr][j] = xr[64 * j]; o[rr][j][0] = bf2f(r.x & 0xffffu); o[rr][j][1] = bf2f(r.x >> 16); o[rr][j][2] = bf2f(r.y & 0xffffu); o[rr][j][3] = bf2f(r.y >> 16); } }
        if (seg != seg_cur) { seg_cur = seg; const GAS float* gate = mod + seg * 3072 + 2048;
#pragma unroll
            for (int j = 0; j < 4; ++j) { const int col = 4 * (lane + 64 * j); wg[j] = *(const GAS f32x4*)(ln_post + col) * *(const GAS f32x4*)(gate + col); } }
#pragma unroll
        for (int rr = 0; rr < 2; ++rr) { float ss = 0.f;
#pragma unroll
            for (int j = 0; j < 4; ++j) ss += (o[rr][j][0] * o[rr][j][0] + o[rr][j][1] * o[rr][j][1]) + (o[rr][j][2] * o[rr][j][2] + o[rr][j][3] * o[rr][j][3]);
            const float rstd = 1.0f / sqrtf(wave_sum(ss) * (1.0f / D) + NORM_EPS);
            GAS f32x4* orow = (GAS f32x4*)(P.out + (size_t)(m + rr) * D) + lane;
#pragma unroll
            for (int j = 0; j < 4; ++j) orow[64 * j] = xv[rr][j] + o[rr][j] * rstd * wg[j]; }
        if (threadIdx.x == 0) qs[par] = (int)nxt;
        __syncthreads();
        cur = qs[par]; par ^= 1;
    }
}

constexpr int N_PHASES = 8;
__global__ void __launch_bounds__(NTHREADS, 2) fwd_kernel(Params P) {
    extern __shared__ __attribute__((aligned(16))) unsigned char lds_raw[];
    LAS unsigned char* lds = (LAS unsigned char*)lds_raw;
    const int tid = threadIdx.x, lane = tid & 63, wave = __builtin_amdgcn_readfirstlane(tid >> 6);
    const int G = gridDim.x, gw = blockIdx.x * NWAVES + wave, NGW = G * NWAVES;
    const int lo = P.ph_lo, hi = P.ph_hi;
    volatile LAS unsigned* bst = (volatile LAS unsigned*)(lds + LDS_BYTES - 16);
    if (tid < 2) bst[tid] = 0u;
    __syncthreads();
    XcdBarrier bar = xcd_barrier_post((unsigned*)P.ws, bst);
#define IN(k) (lo <= (k) && (k) < hi)
#define SEAM(k) do { if (IN(k) && IN((k) + 1)) xcd_barrier(bar); } while (0)
#define PP(name) const Params* name = (const Params*)__builtin_amdgcn_kernarg_segment_ptr(); asm volatile("" : "+s"(name))
    if (IN(0)) { PP(q);
        if (G == 256) phase0_dyn(*q, lds, bar, gw, NGW, wave, lane);
        else { phase0(*q, lds, gw, NGW, wave, lane);
            if (G > 96) { if ((int)blockIdx.x >= 96) weight_copies(*q, lds, gw - 96 * NWAVES, NGW - 96 * NWAVES, wave, lane); }
            else weight_copies(*q, lds, gw, NGW, wave, lane); } }
    if (G != 256) SEAM(0);
    { PP(q); TS(q->ws, 0); }
    if (IN(1)) { PP(q); if (G == 256) phase1_dyn(*q, bar, wave, lane); else phase1(*q, gw, NGW, lane); }
    if (G != 256) SEAM(1); else split_wait(bar, 4);
    if (IN(2)) { PP(q); unsigned char* ws = q->ws; TS(ws, 1);
        pg8::Gemm g{(const pg8::bf16_t*)(ws + WS_H), (const pg8::bf16_t*)(ws + WS_WIN), MT, D_IN, D}; Gemm1Order S; S.init(G, (int)blockIdx.x); S.xb = bar;
        pg8::EpiBf16 E{(pg8::bf16_t*)(ws + WS_PROJ), D_IN, C_WD / 256};
        pg8::gemm_phase<pg8::EpiBf16, Gemm1Order, true, true>(lds, g, S, E);
        TS(ws, 2);
        if (G == 256 && tid == 0) split_arrive(bar, 1); }
    if (G != 256) SEAM(2);
    if (IN(3)) { PP(q); phase3(*q, lds, bar); TS(q->ws, 5); }
    if (G != 256) SEAM(3);
    { PP(q); TS(q->ws, 6); }
    if (G == 256) { if (IN(4)) { PP(q); phase45(*q, lds, bar, gw, NGW, wave, lane); TS(q->ws, 7); } }
    else { if (IN(4)) { PP(q); phase35(*q, lds, gw, NGW, wave, lane); }
        SEAM(4);
        if (IN(5)) { PP(q); phase4(*q, gw, NGW, lane, 0, MT); } }
    if (G != 256) SEAM(5); else split_wait(bar, 9);
    if (IN(6)) { PP(q); unsigned char* ws = q->ws; TS(ws, 8);
        pg8::Gemm g{(const pg8::bf16_t*)(ws + WS_H), (const pg8::bf16_t*)(ws + WS_WOUT), MT, D, D}; Gemm2Order S; S.init(G, (int)blockIdx.x); S.xb = bar;
        pg8::EpiBf16 E{(pg8::bf16_t*)(ws + WS_OUTB), D, -1};
        pg8::gemm_phase<pg8::EpiBf16, Gemm2Order, true, true>(lds, g, S, E); TS(ws, 9);
        if (G == 256 && tid == 0) split_arrive(bar, 3); }
    if (G != 256) SEAM(6);
    { PP(q); TS(q->ws, 10); }
    if (IN(7)) { PP(q); if (G == 256) phase6_dyn(*q, lds, bar, wave, lane); else phase6(*q, gw, NGW, lane);
#ifdef PROBE_KA
        { const unsigned* ts = (const unsigned*)(q->ws + CW_TS); unsigned t0 = 0xffffffffu;
          for (int b = 0; b < 256; ++b) t0 = min(t0, ts[b * 16]);
          float acc = (PROBE_RED == 1) ? 1e30f : 0.f; int n = 0;
          for (int b = 0; b < 256; ++b) { const bool in = (PROBE_SUB == 0) || (PROBE_SUB == 1 && b < 96) || (PROBE_SUB == 2 && b >= 96) || (PROBE_SUB == 3 && b >= 96 && b < 128) || (PROBE_SUB == 4 && b >= 128) || (PROBE_SUB == 5 && ((b >> 3) & 1) == 0) || (PROBE_SUB == 6 && ((b >> 3) & 1) == 1);
              if (!in) continue; const float v = (float)(int)(ts[b * 16 + PROBE_KA] - ((PROBE_KB < 0) ? t0 : ts[b * 16 + PROBE_KB]));
              acc = (PROBE_RED == 0) ? fmaxf(acc, v) : (PROBE_RED == 1) ? fminf(acc, v) : acc + v; ++n; }
          if (PROBE_RED == 2) acc /= (float)n;
          const float f = 1.0f + acc * PROBE_SCALE;
          float* nb = q->out + (size_t)MT * D + STATE_ELEMS;
          for (size_t i = (size_t)gw * 64 + lane; i < STATE_ELEMS; i += (size_t)NGW * 64) nb[i] *= f; }
#endif
    }
#undef PP
#undef IN
#undef SEAM
}

#ifndef N_LAUNCHES
#define N_LAUNCHES 1
#endif
extern "C" void kernel_launch(void* const* d_in, const int* in_sizes, int n_in, void* d_out, int out_size, void* d_ws, size_t ws_size, hipStream_t stream) {
    static int grid = 0;
    if (grid == 0) {
        if (n_in != 26 || ws_size < WS_END) { fprintf(stderr, "kernel_launch: unexpected n_in %d / ws_size %zu (need %zu)\n", n_in, ws_size, (size_t)WS_END); grid = -1; return; }
        int dev = 0, cus = 0, per_cu = 0;
        hipGetDevice(&dev); hipDeviceGetAttribute(&cus, hipDeviceAttributeMultiprocessorCount, dev);
        if (hipFuncSetAttribute((const void*)fwd_kernel, hipFuncAttributeMaxDynamicSharedMemorySize, LDS_BYTES) != hipSuccess) { fprintf(stderr, "kernel_launch: hipFuncSetAttribute failed\n"); grid = -1; return; }
        if (hipOccupancyMaxActiveBlocksPerMultiprocessor(&per_cu, (const void*)fwd_kernel, NTHREADS, LDS_BYTES) != hipSuccess || per_cu < 1) { fprintf(stderr, "kernel_launch: occupancy query says %d\n", per_cu); per_cu = 1; }
        (void)hipGetLastError();
        grid = cus * 1;
        fprintf(stderr, "kernel_launch: cus %d per_cu %d grid %d\n", cus, per_cu, grid);
    }
    if (grid < 0) return;
    hipMemsetAsync((char*)d_ws + WS_CTL, 0, CTL_ZERO_BYTES, stream);
    Params p{};
    for (int i = 0; i < 26; ++i) p.in[i] = (const float*)d_in[i];
    p.out = (float*)d_out; p.ws = (unsigned char*)d_ws;
    if (N_LAUNCHES == 1) {
        p.ph_lo = 0; p.ph_hi = N_PHASES;
        hipLaunchKernelGGL(fwd_kernel, dim3(grid), dim3(NTHREADS), LDS_BYTES, stream, p);
    } else {
        for (int ph = 0; ph < N_PHASES; ++ph) { p.ph_lo = ph; p.ph_hi = ph + 1; hipLaunchKernelGGL(fwd_kernel, dim3(grid), dim3(NTHREADS), LDS_BYTES, stream, p); }
    }
}
```
